# Optimizing an MI355X kernel written in HIP

```python
import jax, jax.numpy as jnp
from jax import lax
import numpy as np

D_MODEL = 1024
BATCH = 2
SEQ = 8192
DEPTH = 2

N_MIXERS = 2
GRID_W = 64
EPS = 1e-6

ATT_HEADS = 8
ATT_KV_HEADS = 2
ATT_HEAD_DIM = 128
ATT_GROUP = ATT_HEADS // ATT_KV_HEADS
ATT_Q_BLOCK = 128
ROPE_THETA = 10000.0
ATT_Q_W = ATT_HEADS * ATT_HEAD_DIM
ATT_KV_W = ATT_KV_HEADS * ATT_HEAD_DIM
ATT_IN_W = 2 * ATT_Q_W + 2 * ATT_KV_W

GDN_QK_HEADS = 8
GDN_V_HEADS = 16
GDN_DK = 128
GDN_DV = 128
GDN_CONV = 5
GDN_CHUNK = 64
GDN_QK_W = GDN_QK_HEADS * GDN_DK
GDN_V_W = GDN_V_HEADS * GDN_DV
GDN_CONV_W = 2 * GDN_QK_W + GDN_V_W
GDN_IN_W = GDN_CONV_W + GDN_V_W + 4 * GDN_V_HEADS

D_FF = 2816
FFN_CONV = 3

kernel_name = "hybrid_axial_gqa_gated_deltanet_convffn_encoder"


def rmsnorm(x, g):
    xf = x.astype(jnp.float32)
    y = xf * lax.rsqrt(jnp.mean(xf * xf, axis=-1, keepdims=True) + EPS)
    return (y * g.astype(jnp.float32)).astype(x.dtype)


def l2norm(x):
    return x * lax.rsqrt(jnp.sum(x * x, axis=-1, keepdims=True) + EPS)


def depthwise_conv_centred(x, w, b):
    K = w.shape[0]
    S = x.shape[1]
    pad = K // 2
    xp = jnp.pad(x, ((0, 0), (pad, pad), (0, 0)))
    y = xp[:, 0:S] * w[0]
    for t in range(1, K):
        y = y + xp[:, t:t + S] * w[t]
    return y + b


def axial_rope_tables(S):
    rows = S // GRID_W
    row = jnp.repeat(jnp.arange(rows), GRID_W).astype(jnp.float32)
    col = jnp.tile(jnp.arange(GRID_W), rows).astype(jnp.float32)
    half = ATT_HEAD_DIM // 2
    n_freq = half // 2
    inv_freq = ROPE_THETA ** (-(jnp.arange(n_freq, dtype=jnp.float32) * 2.0 / half))
    ang_r = row[:, None] * inv_freq[None, :]
    ang_c = col[:, None] * inv_freq[None, :]
    return (jnp.cos(ang_r), jnp.sin(ang_r), jnp.cos(ang_c), jnp.sin(ang_c))


def _rotate(z, cos, sin):
    n = cos.shape[-1]
    z1, z2 = z[..., :n], z[..., n:]
    c = cos[None, :, None, :]
    s = sin[None, :, None, :]
    return jnp.concatenate([z1 * c - z2 * s, z1 * s + z2 * c], axis=-1)


def apply_axial_rope(x, rope):
    cos_r, sin_r, cos_c, sin_c = rope
    half = ATT_HEAD_DIM // 2
    return jnp.concatenate([_rotate(x[..., :half], cos_r, sin_r),
                            _rotate(x[..., half:], cos_c, sin_c)], axis=-1)


def attention_mixer(h, w_in, q_norm, k_norm, w_out, rope):
    B, S, _ = h.shape
    proj = h @ w_in
    q, k, v, gate = jnp.split(proj, [ATT_Q_W, ATT_Q_W + ATT_KV_W, ATT_Q_W + 2 * ATT_KV_W], axis=-1)
    q = q.reshape(B, S, ATT_HEADS, ATT_HEAD_DIM)
    k = k.reshape(B, S, ATT_KV_HEADS, ATT_HEAD_DIM)
    v = v.reshape(B, S, ATT_KV_HEADS, ATT_HEAD_DIM).astype(jnp.float32)
    q = apply_axial_rope(rmsnorm(q, q_norm).astype(jnp.float32), rope) * (ATT_HEAD_DIM ** -0.5)
    k = apply_axial_rope(rmsnorm(k, k_norm).astype(jnp.float32), rope)
    nb = S // ATT_Q_BLOCK
    qb = q.reshape(B, nb, ATT_Q_BLOCK, ATT_KV_HEADS, ATT_GROUP, ATT_HEAD_DIM)
    qb = jnp.moveaxis(qb, 1, 0)

    def block(q_blk):
        s = jnp.einsum('bqkgd,bskd->bkgqs', q_blk, k)
        p = jax.nn.softmax(s, axis=-1)
        return jnp.einsum('bkgqs,bskd->bqkgd', p, v)

    o = lax.map(block, qb)
    o = jnp.moveaxis(o, 0, 1).reshape(B, S, ATT_Q_W)
    o = o * jax.nn.sigmoid(gate.astype(jnp.float32))
    return o.astype(h.dtype) @ w_out


def chunk_gated_delta_rule(q, k, v, g, beta):
    B, S, H, dk = q.shape
    dv = v.shape[-1]
    C = GDN_CHUNK
    N = S // C

    def chunks(t):
        t = t.reshape((B, N, C, H) + t.shape[3:])
        return jnp.moveaxis(t, 3, 1)

    q, k, v, g, beta = chunks(q), chunks(k), chunks(v), chunks(g), chunks(beta)
    gc = jnp.cumsum(g, axis=-1)
    idx = jnp.arange(C)
    incl = idx[:, None] >= idx[None, :]
    strict = idx[:, None] > idx[None, :]
    decay = jnp.exp(jnp.where(incl, gc[..., :, None] - gc[..., None, :], -jnp.inf))
    kb = k * beta[..., None]
    L = jnp.einsum('bhncd,bhnsd->bhncs', kb, k) * decay * strict.astype(jnp.float32)
    unit_lower = L + jnp.eye(C, dtype=jnp.float32)
    rhs = jnp.concatenate([v * beta[..., None], kb * jnp.exp(gc)[..., None]], axis=-1)
    sol = lax.linalg.triangular_solve(unit_lower, rhs, left_side=True, lower=True,
                                      unit_diagonal=True)
    u, w = sol[..., :dv], sol[..., dv:]
    attn = jnp.einsum('bhncd,bhnsd->bhncs', q, k) * decay
    q_dec = q * jnp.exp(gc)[..., None]
    k_dec = k * jnp.exp(gc[..., -1:] - gc)[..., None]
    g_last = jnp.exp(gc[..., -1])

    xs = tuple(jnp.moveaxis(t, 2, 0) for t in (u, w, attn, q_dec, k_dec, g_last))

    def step(state, inp):
        u_i, w_i, a_i, qd_i, kd_i, gl_i = inp
        v_new = u_i - jnp.einsum('bhck,bhkv->bhcv', w_i, state)
        o_i = jnp.einsum('bhck,bhkv->bhcv', qd_i, state) + jnp.einsum('bhcs,bhsv->bhcv', a_i, v_new)
        state = state * gl_i[..., None, None] + jnp.einsum('bhck,bhcv->bhkv', kd_i, v_new)
        return state, o_i

    state0 = jnp.zeros((B, H, dk, dv), jnp.float32)
    _, o = lax.scan(step, state0, xs)
    return jnp.transpose(o, (1, 0, 3, 2, 4)).reshape(B, S, H, dv)


def gated_deltanet_mixer(h, w_in, conv_w, conv_b, a_log, dt_bias, o_norm, w_out):
    B, S, _ = h.shape
    proj = h @ w_in
    qkv, z, ab = jnp.split(proj, [GDN_CONV_W, GDN_CONV_W + GDN_V_W], axis=-1)
    qkv = jax.nn.silu(depthwise_conv_centred(qkv, conv_w, conv_b)).astype(jnp.float32)
    q, k, v = jnp.split(qkv, [GDN_QK_W, 2 * GDN_QK_W], axis=-1)
    rep = GDN_V_HEADS // GDN_QK_HEADS
    q = jnp.repeat(l2norm(q.reshape(B, S, GDN_QK_HEADS, GDN_DK)) * (GDN_DK ** -0.5), rep, axis=2)
    k = jnp.repeat(l2norm(k.reshape(B, S, GDN_QK_HEADS, GDN_DK)), rep, axis=2)
    v = v.reshape(B, S, GDN_V_HEADS, GDN_DV)
    ab = ab.astype(jnp.float32).reshape(B, S, 2, 2, GDN_V_HEADS)
    a, b = ab[:, :, :, 0], ab[:, :, :, 1]
    g = -jnp.exp(a_log.astype(jnp.float32)) * jax.nn.softplus(a + dt_bias.astype(jnp.float32))
    beta = jax.nn.sigmoid(b)
    o_fwd = chunk_gated_delta_rule(q, k, v, g[:, :, 0], beta[:, :, 0])
    flip = lambda t: jnp.flip(t, axis=1)
    o_bwd = flip(chunk_gated_delta_rule(flip(q), flip(k), flip(v),
                                        flip(g[:, :, 1]), flip(beta[:, :, 1])))
    o = rmsnorm(o_fwd + o_bwd, o_norm) * jax.nn.silu(
        z.astype(jnp.float32).reshape(B, S, GDN_V_HEADS, GDN_DV))
    return o.reshape(B, S, GDN_V_W).astype(h.dtype) @ w_out


def conv_ffn(h, w_up, conv_w, conv_b, w_down):
    u = depthwise_conv_centred(h @ w_up, conv_w, conv_b)
    a, b = jnp.split(u, 2, axis=-1)
    return (jax.nn.silu(a) * b) @ w_down


def setup_inputs(seed: int = 0) -> dict:
    key = jax.random.key(seed)
    ks = jax.random.split(key, 24)
    n_attn = (DEPTH + N_MIXERS - 1) // N_MIXERS
    n_gdn = DEPTH // N_MIXERS
    f32 = jnp.float32

    def w(k, shape, fan_in):
        return jax.random.normal(k, shape, f32) * (fan_in ** -0.5)

    def gain(k, shape):
        return 1.0 + 0.02 * jax.random.normal(k, shape, f32)

    a_log = jnp.log(jax.random.uniform(ks[12], (n_gdn, 2, GDN_V_HEADS), f32, 1.0, 16.0))
    dt = jnp.exp(jax.random.uniform(ks[13], (n_gdn, 2, GDN_V_HEADS), f32,
                                    float(np.log(1e-3)), float(np.log(1e-1))))
    dt_bias = dt + jnp.log(-jnp.expm1(-dt))
    return {
        "x": jax.random.normal(ks[0], (BATCH, SEQ, D_MODEL), f32),
        "norm_mix": gain(ks[1], (DEPTH, D_MODEL)),
        "norm_ffn": gain(ks[2], (DEPTH, D_MODEL)),
        "norm_final": gain(ks[3], (D_MODEL,)),
        "attn_w_in": w(ks[4], (n_attn, D_MODEL, ATT_IN_W), D_MODEL),
        "attn_q_norm": gain(ks[5], (n_attn, ATT_HEAD_DIM)),
        "attn_k_norm": gain(ks[6], (n_attn, ATT_HEAD_DIM)),
        "attn_w_out": w(ks[7], (n_attn, ATT_Q_W, D_MODEL), ATT_Q_W),
        "gdn_w_in": w(ks[8], (n_gdn, D_MODEL, GDN_IN_W), D_MODEL),
        "gdn_conv_w": w(ks[9], (n_gdn, GDN_CONV, GDN_CONV_W), GDN_CONV),
        "gdn_conv_b": 0.02 * jax.random.normal(ks[10], (n_gdn, GDN_CONV_W), f32),
        "gdn_a_log": a_log,
        "gdn_dt_bias": dt_bias,
        "gdn_o_norm": gain(ks[14], (n_gdn, GDN_DV)),
        "gdn_w_out": w(ks[15], (n_gdn, GDN_V_W, D_MODEL), GDN_V_W),
        "ffn_w_up": w(ks[16], (DEPTH, D_MODEL, 2 * D_FF), D_MODEL),
        "ffn_conv_w": w(ks[17], (DEPTH, FFN_CONV, 2 * D_FF), FFN_CONV),
        "ffn_conv_b": 0.02 * jax.random.normal(ks[18], (DEPTH, 2 * D_FF), f32),
        "ffn_w_down": w(ks[19], (DEPTH, D_FF, D_MODEL), D_FF),
    }


def reference(x, norm_mix, norm_ffn, norm_final, attn_w_in, attn_q_norm, attn_k_norm,
              attn_w_out, gdn_w_in, gdn_conv_w, gdn_conv_b, gdn_a_log, gdn_dt_bias,
              gdn_o_norm, gdn_w_out, ffn_w_up, ffn_conv_w, ffn_conv_b, ffn_w_down):
    S = x.shape[1]
    rope = axial_rope_tables(S)
    h = x
    for i in range(DEPTH):
        j = i // N_MIXERS
        y = rmsnorm(h, norm_mix[i])
        if i % N_MIXERS == 0:
            h = h + attention_mixer(y, attn_w_in[j], attn_q_norm[j], attn_k_norm[j],
                                    attn_w_out[j], rope)
        else:
            h = h + gated_deltanet_mixer(y, gdn_w_in[j], gdn_conv_w[j], gdn_conv_b[j],
                                         gdn_a_log[j], gdn_dt_bias[j], gdn_o_norm[j],
                                         gdn_w_out[j])
        h = h + conv_ffn(rmsnorm(h, norm_ffn[i]), ffn_w_up[i], ffn_conv_w[i],
                         ffn_conv_b[i], ffn_w_down[i])
    return rmsnorm(h, norm_final)
```

```cpp
#include <hip/hip_runtime.h>
#include <hip/hip_cooperative_groups.h>
#include <hip/hip_bf16.h>
#include <cstdio>
#include <cstdint>
#include <cmath>
namespace cg = cooperative_groups;
#define MK_MULTI 0

__device__ __forceinline__ int mk_tid() { int t = threadIdx.x; asm volatile("" : "+v"(t)); return t; }
namespace pg8 {
#define PG8_LAS __attribute__((address_space(3)))
typedef unsigned short bf16_t;
typedef short bf16x8 __attribute__((ext_vector_type(8)));
typedef float f32x4 __attribute__((ext_vector_type(4)));
typedef unsigned u32x4 __attribute__((ext_vector_type(4)));
constexpr int BM = 256, BK = 64, HALF = 128, HTB = HALF * BK * 2  , STAGE_BYTES = 8 * HTB, NXCD = 8, WGM = 8;

__host__ __device__ __forceinline__ int lds_byte(int r, int c) { const int st = (r >> 4) * 2 + (c >> 5), rr = r & 15, cc = c & 31, ob = rr * 64 + cc * 2; return st * 1024 + (ob ^ (((ob >> 9) & 1) << 5)); }
__host__ __device__ __forceinline__ void stage_rc(int b, int& R, int& C) { const int st = b / 1024, sb = b % 1024, swz = sb ^ (((sb >> 9) & 1) << 5); R = (st >> 1) * 16 + swz / 64; C = (st & 1) * 32 + (swz % 64) / 2; }
__host__ __device__ __forceinline__ int perm32(int rho) { const int n = rho >> 4, i = rho & 15; return 8 * (i >> 2) + 4 * n + (i & 3); }

struct Unit { int pm, pn; };
struct Gemm { const bf16_t* A; const bf16_t* Bt; int M, N, K; };

struct StaticOrder {
    int nM, nN, nwg, G, c;
    __host__ __device__ void init(int M, int N, int G_, int c_) { nM = M / BM; nN = N / BM; nwg = nM * nN; G = G_; c = c_; }
    __host__ __device__ bool next(int i, Unit& u) const {
        const long L = (long)i * G + c; if (L >= nwg) return false;
        int wgid = (int)L; { const int q = nwg / NXCD, r = nwg % NXCD, xcd = wgid % NXCD, off = wgid / NXCD; wgid = (xcd < r ? xcd * (q + 1) : r * (q + 1) + (xcd - r) * q) + off; }
        const int nig = WGM * nN, gid = wgid / nig, fm = gid * WGM, gsz = (nM - fm) < WGM ? (nM - fm) : WGM;
        u.pm = fm + ((wgid % nig) % gsz); u.pn = (wgid % nig) / gsz; return true;
    }
    __device__ __forceinline__ void a_ready(const Unit&) const {}
    __device__ __forceinline__ void done(const Unit&) const {}
};


typedef float f32x2 __attribute__((ext_vector_type(2)));
typedef __bf16 bf16x2_t __attribute__((ext_vector_type(2)));
__device__ __forceinline__ unsigned cvt_pk_bf16(float lo, float hi) { f32x2 v = {lo, hi}; bf16x2_t r = __builtin_convertvector(v, bf16x2_t); return __builtin_bit_cast(unsigned, r); }

struct EpiBf16 {
    static constexpr bool PERM = true, AFTER_DRAIN = false;
    bf16_t* O; int ldc;
    __device__ __forceinline__ void operator()(const f32x4 (&acc)[2][2][4][2], const Unit& u, int wr, int wc, int fr, int fq) const {
        const int row0 = u.pm * BM + wr * 64 + fr; const int col0 = u.pn * BM + wc * 32 + 8 * fq;
#pragma unroll
        for (int ai = 0; ai < 2; ++ai)
#pragma unroll
            for (int m = 0; m < 4; ++m) { bf16_t* rowp = O + (size_t)(row0 + ai * HALF + m * 16) * ldc + col0;
#pragma unroll
                for (int bj = 0; bj < 2; ++bj) { const f32x4 v0 = acc[ai][bj][m][0], v1 = acc[ai][bj][m][1];
                    u32x4 w; w.x = cvt_pk_bf16(v0[0], v0[1]); w.y = cvt_pk_bf16(v0[2], v0[3]); w.z = cvt_pk_bf16(v1[0], v1[1]); w.w = cvt_pk_bf16(v1[2], v1[3]);
                    *(u32x4*)(rowp + bj * HALF) = w; } }
    }
};
struct EpiF32 {
    static constexpr bool PERM = true, AFTER_DRAIN = false;
    float* O; int ldc;
    __device__ __forceinline__ void operator()(const f32x4 (&acc)[2][2][4][2], const Unit& u, int wr, int wc, int fr, int fq) const {
        const int row0 = u.pm * BM + wr * 64 + fr; const int col0 = u.pn * BM + wc * 32 + 8 * fq;
#pragma unroll
        for (int ai = 0; ai < 2; ++ai)
#pragma unroll
            for (int m = 0; m < 4; ++m) { float* rowp = O + (size_t)(row0 + ai * HALF + m * 16) * ldc + col0;
#pragma unroll
                for (int bj = 0; bj < 2; ++bj) { *(f32x4*)(rowp + bj * HALF) = acc[ai][bj][m][0]; *(f32x4*)(rowp + bj * HALF + 4) = acc[ai][bj][m][1]; } }
    }
};
struct EpiRes {
    static constexpr bool PERM = false, AFTER_DRAIN = false;
    const float* base; float* out; int ldc;
    __device__ __forceinline__ void operator()(const f32x4 (&acc)[2][2][4][2], const Unit& u, int wr, int wc, int fr, int fq) const {
        const int row0 = u.pm * BM + wr * 64 + fr; const int col0 = u.pn * BM + wc * 32 + 4 * fq;
#pragma unroll
        for (int ai = 0; ai < 2; ++ai)
#pragma unroll
            for (int m = 0; m < 4; ++m) { const size_t off = (size_t)(row0 + ai * HALF + m * 16) * ldc + col0;
#pragma unroll
                for (int bj = 0; bj < 2; ++bj)
#pragma unroll
                    for (int n = 0; n < 2; ++n) { const f32x4 b = *(const f32x4*)(base + off + bj * HALF + n * 16); *(f32x4*)(out + off + bj * HALF + n * 16) = b + acc[ai][bj][m][n]; } }
    }
};

struct EpiGate {
    static constexpr bool PERM = true, AFTER_DRAIN = false;
    const bf16_t* OF; const bf16_t* OB; bf16_t* GO; const float* gain; PG8_LAS float* tab;
    __device__ __forceinline__ void operator()(const f32x4 (&acc)[2][2][4][2], const Unit& u, int wr, int wc, int fr, int fq) const {
        const int tid = mk_tid();
        {
            const int row = tid >> 1, hd = tid & 1; const size_t off = (size_t)(u.pm * BM + row) * 2048 + u.pn * BM + hd * HALF;
            float ss = 0.f;
#pragma unroll 4
            for (int j = 0; j < 16; ++j) { const u32x4 a = *(const u32x4*)(OF + off + 8 * j), b = *(const u32x4*)(OB + off + 8 * j);
#pragma unroll
                for (int q = 0; q < 4; ++q) { const float lo = __uint_as_float(a[q] << 16) + __uint_as_float(b[q] << 16), hi = __uint_as_float(a[q] & 0xffff0000u) + __uint_as_float(b[q] & 0xffff0000u); ss += lo * lo + hi * hi; } }
            tab[row * 2 + hd] = rsqrtf(ss * (1.f / 128.f) + 1e-6f);
        }
        asm volatile("s_waitcnt lgkmcnt(0)" ::: "memory"); __builtin_amdgcn_s_barrier(); asm volatile("" ::: "memory");
        const int row0 = wr * 64 + fr; const int colw = wc * 32 + 8 * fq;
        f32x4 g0 = *(const f32x4*)(gain + colw), g1 = *(const f32x4*)(gain + colw + 4);
#pragma unroll
        for (int ai = 0; ai < 2; ++ai)
#pragma unroll
            for (int m = 0; m < 4; ++m) { const int rt = row0 + ai * HALF + m * 16;
#pragma unroll
                for (int bj = 0; bj < 2; ++bj) { const size_t off = (size_t)(u.pm * BM + rt) * 1024 + u.pn * BM + bj * HALF + colw, offo = off + (size_t)(u.pm * BM + rt) * 1024;
                    const float rs = tab[rt * 2 + bj];
                    const u32x4 a = *(const u32x4*)(OF + offo), b = *(const u32x4*)(OB + offo);
                    const f32x4 z0 = acc[ai][bj][m][0], z1 = acc[ai][bj][m][1];
                    float o[8];
#pragma unroll
                    for (int q = 0; q < 4; ++q) { o[2 * q] = __uint_as_float(a[q] << 16) + __uint_as_float(b[q] << 16); o[2 * q + 1] = __uint_as_float(a[q] & 0xffff0000u) + __uint_as_float(b[q] & 0xffff0000u); }
#pragma unroll
                    for (int e = 0; e < 4; ++e) { o[e] = o[e] * rs * g0[e] * (z0[e] / (1.f + __expf(-z0[e]))); o[4 + e] = o[4 + e] * rs * g1[e] * (z1[e] / (1.f + __expf(-z1[e]))); }
                    u32x4 w; w.x = cvt_pk_bf16(o[0], o[1]); w.y = cvt_pk_bf16(o[2], o[3]); w.z = cvt_pk_bf16(o[4], o[5]); w.w = cvt_pk_bf16(o[6], o[7]);
                    *(u32x4*)(GO + off) = w; }
                asm volatile("" ::: "memory"); }
        asm volatile("s_waitcnt lgkmcnt(0)" ::: "memory"); __builtin_amdgcn_s_barrier(); asm volatile("" ::: "memory");
    }
};

typedef unsigned u32x2 __attribute__((ext_vector_type(2)));
__device__ __forceinline__ float dpp_ror1(float v)  { return __int_as_float(__builtin_amdgcn_update_dpp(0, __float_as_int(v), 0x121, 0xF, 0xF, false)); }
__device__ __forceinline__ float dpp_ror15(float v) { return __int_as_float(__builtin_amdgcn_update_dpp(0, __float_as_int(v), 0x12F, 0xF, 0xF, false)); }
struct EpiFfn {
    static constexpr bool PERM = true, AFTER_DRAIN = false;
    bf16_t* ACT; float* EDGE; const float* cw; const float* cb; int chan0; PG8_LAS float* bt;
    __device__ __forceinline__ void operator()(const f32x4 (&acc)[2][2][4][2], const Unit& u, int wr, int wc, int fr, int fq) const {
        const int chl = wc * 32 + 8 * fq;
        const int cha = chan0 + u.pn * 128 + chl, chb = 2816 + cha;
        PG8_LAS float* wt = bt + 2048;
        { const int t = mk_tid(); if (t < 256) { const int ch = (t < 128) ? (chan0 + u.pn * 128 + t) : (2816 + chan0 + u.pn * 128 + (t - 128));
            wt[t] = cw[ch]; wt[256 + t] = cw[5632 + ch]; wt[512 + t] = cw[2 * 5632 + ch]; wt[768 + t] = cb[ch]; } }
#pragma unroll
        for (int ai = 0; ai < 2; ++ai) { const int beta = 2 * ai + wr;
#pragma unroll
            for (int bj = 0; bj < 2; ++bj)
#pragma unroll
                for (int n = 0; n < 2; ++n) { const int col = 128 * bj + chl + 4 * n;
                    if (fr == 0)  *(PG8_LAS f32x4*)(bt + (2 * beta) * 256 + col) = acc[ai][bj][0][n];
                    if (fr == 15) *(PG8_LAS f32x4*)(bt + (2 * beta + 1) * 256 + col) = acc[ai][bj][3][n];
                    float* eg = EDGE + (size_t)((u.pm * 22 + u.pn) * 4) * 256 + col;
                    if (beta == 0 && fr < 2)  *(f32x4*)(eg + fr * 256) = acc[ai][bj][0][n];
                    if (beta == 3 && fr >= 14) *(f32x4*)(eg + (fr - 12) * 256) = acc[ai][bj][3][n]; } }
        asm volatile("s_waitcnt lgkmcnt(0)" ::: "memory"); __builtin_amdgcn_s_barrier(); asm volatile("" ::: "memory");
#pragma unroll
        for (int n = 0; n < 2; ++n) {
            f32x4 tp[2][4];
#pragma unroll
            for (int bj = 0; bj < 2; ++bj)
#pragma unroll
                for (int s = 0; s < 4; ++s) tp[bj][s] = *(const PG8_LAS f32x4*)(wt + s * 256 + 128 * bj + chl + 4 * n);
#pragma unroll
            for (int ai = 0; ai < 2; ++ai) { const int beta = 2 * ai + wr;
#pragma unroll
                for (int m = 0; m < 4; ++m) {
                    const int trow = 128 * ai + 64 * wr + 16 * m + fr;
                    f32x4 yy[2];
#pragma unroll
                    for (int bj = 0; bj < 2; ++bj) {
                        const f32x4 cur = acc[ai][bj][m][n]; f32x4 pv, nx;
                        const int col = 128 * bj + chl + 4 * n;
                        f32x4 pe, ne;
                        if (m > 0) { const f32x4 t = acc[ai][bj][m > 0 ? m - 1 : 0][n]; pe = (f32x4){dpp_ror1(t[0]), dpp_ror1(t[1]), dpp_ror1(t[2]), dpp_ror1(t[3])}; }
                        else pe = (beta > 0) ? *(const PG8_LAS f32x4*)(bt + (2 * (beta - 1) + 1) * 256 + col) : (f32x4){0.f, 0.f, 0.f, 0.f};
                        if (m < 3) { const f32x4 t = acc[ai][bj][m < 3 ? m + 1 : 3][n]; ne = (f32x4){dpp_ror15(t[0]), dpp_ror15(t[1]), dpp_ror15(t[2]), dpp_ror15(t[3])}; }
                        else ne = (beta < 3) ? *(const PG8_LAS f32x4*)(bt + (2 * (beta + 1)) * 256 + col) : (f32x4){0.f, 0.f, 0.f, 0.f};
#pragma unroll
                        for (int e = 0; e < 4; ++e) {
                            pv[e] = __int_as_float(__builtin_amdgcn_update_dpp(__float_as_int(pe[e]), __float_as_int(cur[e]), 0x111, 0xF, 0xF, false));
                            nx[e] = __int_as_float(__builtin_amdgcn_update_dpp(__float_as_int(ne[e]), __float_as_int(cur[e]), 0x101, 0xF, 0xF, false)); }
                        yy[bj] = tp[bj][0] * pv + tp[bj][1] * cur + tp[bj][2] * nx + tp[bj][3];
                    }
                    float o[4];
#pragma unroll
                    for (int e = 0; e < 4; ++e) o[e] = yy[0][e] * __builtin_amdgcn_rcpf(1.f + __expf(-yy[0][e])) * yy[1][e];
                    if (trow != 0 && trow != 255) { u32x2 w; w.x = cvt_pk_bf16(o[0], o[1]); w.y = cvt_pk_bf16(o[2], o[3]);
                        *(u32x2*)(ACT + (size_t)(u.pm * BM + trow) * 2816 + cha + 4 * n) = w; }
                } }
        }
        asm volatile("s_waitcnt lgkmcnt(0)" ::: "memory"); __builtin_amdgcn_s_barrier(); asm volatile("" ::: "memory");
    }
};

template <class Epi, class Sched, bool ALIGN_EPI = false, bool SP2 = false>
__device__ __forceinline__ void gemm_phase(PG8_LAS unsigned char* lds, const Gemm g, const Sched& S, const Epi& E) {
    const int tid = mk_tid(), wid = __builtin_amdgcn_readfirstlane(tid >> 6), lane = tid & 63, wr = wid >> 2, wc = wid & 3, fr = lane & 15, fq = lane >> 4;
    const int K = g.K, nt = K / BK;
    unsigned voffA[2], voffB[2];
#pragma unroll
    for (int i = 0; i < 2; ++i) { int R, C; stage_rc(tid * 16 + i * 8192, R, C); const int Rb = Epi::PERM ? ((R & ~31) + perm32(R & 31)) : R;
        voffA[i] = (unsigned)(R * K + C) * 2u; voffB[i] = (unsigned)(Rb * K + C) * 2u; }
    const size_t kstep = (size_t)(BK * 2);
    const size_t hstep = (size_t)HALF * K * 2;
    const size_t tstep = 2 * hstep;
    const unsigned ldsw = (unsigned)wid * 1024u;
    const int aoff = lds_byte(wr * 64 + fr, fq * 8), boff = lds_byte(wc * 32 + fr, fq * 8);
#define PG8_SA(b, h) (((b) * 2 + (h)) * HTB)
#define PG8_SB(b, h) ((4 + (b) * 2 + (h)) * HTB)
#define PG8_STAGE(bufoff, gbase, voff) do { _Pragma("unroll") for (int _i = 0; _i < 2; ++_i) \
        __builtin_amdgcn_global_load_lds((const unsigned*)((const char*)(gbase) + (voff)[_i]), (PG8_LAS unsigned*)(lds + (bufoff) + ldsw + _i * 8192), 16, 0, 0); } while (0)
#define PG8_LDA(dst, b, h) do { _Pragma("unroll") for (int m = 0; m < 4; ++m) _Pragma("unroll") for (int k = 0; k < 2; ++k) dst[m][k] = *(const PG8_LAS bf16x8*)(lds + PG8_SA(b, h) + aoff + m * 2048 + k * 1024); } while (0)
#define PG8_LDB(dst, b, h) do { _Pragma("unroll") for (int n = 0; n < 2; ++n) _Pragma("unroll") for (int k = 0; k < 2; ++k) dst[n][k] = *(const PG8_LAS bf16x8*)(lds + PG8_SB(b, h) + boff + n * 2048 + k * 1024); } while (0)
#define PG8_MMA(ai, bj, At, Bt) do { __builtin_amdgcn_s_setprio(1); _Pragma("unroll") for (int m = 0; m < 4; ++m) _Pragma("unroll") for (int n = 0; n < 2; ++n) _Pragma("unroll") for (int k = 0; k < 2; ++k) \
        acc[ai][bj][m][n] = __builtin_amdgcn_mfma_f32_16x16x32_bf16(Bt[n][k], At[m][k], acc[ai][bj][m][n], 0, 0, 0); __builtin_amdgcn_s_setprio(0); } while (0)
#define PG8_WAIT_V(n) asm volatile("s_waitcnt vmcnt(" #n ")" ::: "memory")
#define PG8_WAIT_L(n) asm volatile("s_waitcnt lgkmcnt(" #n ")" ::: "memory")
#define PG8_BAR __builtin_amdgcn_s_barrier()
#define PG8_SCHED __builtin_amdgcn_sched_barrier(0)
    Unit cur, nxt; int ui = 0;
    if (!S.next(0, cur)) return;
    f32x4 acc[2][2][4][2];
    float zr_ = 0.f; asm volatile("" : "+v"(zr_));
#pragma unroll
    for (int a = 0; a < 2; ++a)
#pragma unroll
        for (int b = 0; b < 2; ++b)
#pragma unroll
            for (int m = 0; m < 4; ++m)
#pragma unroll
                for (int n = 0; n < 2; ++n) acc[a][b][m][n] = (f32x4){zr_, zr_, zr_, zr_};
    bf16x8 At[4][2], B0[2][2], B1[2][2];
    const char* cA = (const char*)g.A + (size_t)cur.pm * tstep; const char* cB = (const char*)g.Bt + (size_t)cur.pn * tstep;
    S.a_ready(cur);
    if constexpr (SP2) {
        PG8_STAGE(PG8_SB(0, 0), cB, voffB); PG8_STAGE(PG8_SB(0, 1), cB + hstep, voffB); PG8_STAGE(PG8_SA(0, 0), cA, voffA); PG8_STAGE(PG8_SA(0, 1), cA + hstep, voffA);
        if (wr == 1) PG8_BAR;
        PG8_WAIT_V(2); PG8_BAR;
        PG8_STAGE(PG8_SB(1, 0), cB + kstep, voffB); PG8_STAGE(PG8_SA(1, 0), cA + kstep, voffA); PG8_STAGE(PG8_SB(1, 1), cB + hstep + kstep, voffB);
        PG8_WAIT_V(6); PG8_BAR;
    } else {
        PG8_STAGE(PG8_SB(0, 0), cB, voffB); PG8_STAGE(PG8_SA(0, 0), cA, voffA); PG8_STAGE(PG8_SB(0, 1), cB + hstep, voffB); PG8_STAGE(PG8_SA(0, 1), cA + hstep, voffA);
        if (wr == 1) PG8_BAR;
        PG8_WAIT_V(4); PG8_BAR;
        PG8_STAGE(PG8_SB(1, 0), cB + kstep, voffB); PG8_STAGE(PG8_SA(1, 0), cA + kstep, voffA); PG8_STAGE(PG8_SB(1, 1), cB + hstep + kstep, voffB);
        PG8_WAIT_V(6); PG8_BAR;
    }
    for (;;) {
        const bool has_next = S.next(ui + 1, nxt);
        const char* nA = has_next ? (const char*)g.A + (size_t)nxt.pm * tstep : cA; const char* nB = has_next ? (const char*)g.Bt + (size_t)nxt.pn * tstep : cB;
        for (int t = 0; t < nt; t += 2) {
            const bool last = (t == nt - 2);
            const char* a1 = cA + (size_t)(t + 1) * kstep;
            const char* a2 = last ? nA : cA + (size_t)(t + 2) * kstep; const char* b2 = last ? nB : cB + (size_t)(t + 2) * kstep;
            const char* a3 = a2 + kstep; const char* b3 = b2 + kstep;
            if (last && has_next) S.a_ready(nxt);
            if constexpr (SP2) {
            PG8_LDB(B0, 0, 0); PG8_LDB(B1, 0, 1); PG8_SCHED; PG8_LDA(At, 0, 0); PG8_STAGE(PG8_SA(1, 1), a1 + hstep, voffA);
            PG8_WAIT_V(8); PG8_WAIT_L(0); PG8_BAR; PG8_MMA(0, 0, At, B0); PG8_MMA(0, 1, At, B1); PG8_BAR; PG8_SCHED;
            PG8_LDA(At, 0, 1); PG8_STAGE(PG8_SB(0, 0), b2, voffB); PG8_STAGE(PG8_SB(0, 1), b2 + hstep, voffB); PG8_STAGE(PG8_SA(0, 0), a2, voffA);
            PG8_WAIT_V(8); PG8_WAIT_L(0); PG8_BAR; PG8_MMA(1, 0, At, B0); PG8_MMA(1, 1, At, B1); PG8_BAR; PG8_SCHED;
            PG8_LDB(B0, 1, 0); PG8_LDB(B1, 1, 1); PG8_SCHED; PG8_LDA(At, 1, 0); PG8_STAGE(PG8_SA(0, 1), a2 + hstep, voffA);
            PG8_WAIT_V(8); PG8_WAIT_L(0); PG8_BAR; PG8_MMA(0, 0, At, B0); PG8_MMA(0, 1, At, B1); PG8_BAR; PG8_SCHED;
            PG8_LDA(At, 1, 1); PG8_STAGE(PG8_SB(1, 0), b3, voffB); PG8_STAGE(PG8_SB(1, 1), b3 + hstep, voffB); PG8_STAGE(PG8_SA(1, 0), a3, voffA);
            PG8_WAIT_V(8); PG8_WAIT_L(0); PG8_BAR; PG8_MMA(1, 0, At, B0); PG8_MMA(1, 1, At, B1); PG8_BAR; PG8_SCHED;
            } else {
            PG8_LDB(B0, 0, 0); PG8_SCHED; PG8_LDA(At, 0, 0); PG8_STAGE(PG8_SA(1, 1), a1 + hstep, voffA);
            PG8_WAIT_L(8); PG8_BAR; PG8_WAIT_L(0); PG8_MMA(0, 0, At, B0); PG8_BAR; PG8_SCHED;
            PG8_LDB(B1, 0, 1); PG8_STAGE(PG8_SB(0, 0), b2, voffB);
            PG8_BAR; PG8_WAIT_L(0); PG8_MMA(0, 1, At, B1); PG8_BAR;
            PG8_LDA(At, 0, 1); PG8_STAGE(PG8_SA(0, 0), a2, voffA);
            PG8_BAR; PG8_WAIT_L(0); PG8_MMA(1, 0, At, B0); PG8_BAR; PG8_SCHED;
            PG8_STAGE(PG8_SB(0, 1), b2 + hstep, voffB);
            PG8_WAIT_V(6); PG8_BAR; PG8_MMA(1, 1, At, B1); PG8_BAR;
            PG8_LDB(B0, 1, 0); PG8_SCHED; PG8_LDA(At, 1, 0); PG8_STAGE(PG8_SA(0, 1), a2 + hstep, voffA);
            PG8_WAIT_L(8); PG8_BAR; PG8_WAIT_L(0); PG8_MMA(0, 0, At, B0); PG8_BAR; PG8_SCHED;
            PG8_LDB(B1, 1, 1); PG8_STAGE(PG8_SB(1, 0), b3, voffB);
            PG8_BAR; PG8_WAIT_L(0); PG8_MMA(0, 1, At, B1); PG8_BAR;
            PG8_LDA(At, 1, 1); PG8_STAGE(PG8_SA(1, 0), a3, voffA);
            PG8_BAR; PG8_WAIT_L(0); PG8_MMA(1, 0, At, B0); PG8_BAR; PG8_SCHED;
            PG8_STAGE(PG8_SB(1, 1), b3 + hstep, voffB);
            PG8_WAIT_V(6); PG8_BAR; PG8_MMA(1, 1, At, B1); PG8_BAR;
            }
        }
        if constexpr (ALIGN_EPI) { if (wr == 0) PG8_BAR; }
        if constexpr (!Epi::AFTER_DRAIN) { E(acc, cur, wr, wc, fr, fq); S.done(cur); }
        if (!has_next) break;
#pragma unroll
        for (int a = 0; a < 2; ++a)
#pragma unroll
            for (int b = 0; b < 2; ++b)
#pragma unroll
                for (int m = 0; m < 4; ++m)
#pragma unroll
                    for (int n = 0; n < 2; ++n) acc[a][b][m][n] = (f32x4){zr_, zr_, zr_, zr_};
        cur = nxt; cA = nA; cB = nB; ++ui;
        if constexpr (ALIGN_EPI) { if (wr == 1) PG8_BAR; }
    }
    PG8_WAIT_V(0);
    if constexpr (!ALIGN_EPI) { if (wr == 0) PG8_BAR; }
    PG8_BAR;
    if constexpr (Epi::AFTER_DRAIN) { E.fused(acc, cur, wr, wc, fr, fq, lds, wid, lane); S.done(cur); }
#undef PG8_SA
#undef PG8_SB
#undef PG8_STAGE
#undef PG8_LDA
#undef PG8_LDB
#undef PG8_MMA
#undef PG8_WAIT_V
#undef PG8_WAIT_L
#undef PG8_BAR
#undef PG8_SCHED
}
}

namespace attn {
using bf16 = __hip_bfloat16;
constexpr int   D = 128, NW = 8, QBLK = 32, KVBLK = 64;
constexpr float SCALE = 0.088388347648318440f;
constexpr float THR = 8.f;
constexpr int SDEPTH = 2;
constexpr int LDQ = 2560, LDK = 2560, LDO = 1024;
constexpr size_t SHM_V = KVBLK * D * 2, SHM_K = KVBLK * D * 2, SHM_ATTN = 2 * SHM_V + 2 * SHM_K + NW * 64 * 4;
using bf16x8 = __attribute__((ext_vector_type(8))) short;
using s16x4  = __attribute__((ext_vector_type(4))) short;
using f32x16 = __attribute__((ext_vector_type(16))) float;
using f32x8  = __attribute__((ext_vector_type(8))) float;
using u32x4  = __attribute__((ext_vector_type(4))) unsigned;
#define KSWZ(row, colB) ((row) * 256 + ((colB) ^ (((row) & 7) << 4)))
#define SBAR() __builtin_amdgcn_sched_barrier(0)
__device__ __forceinline__ int crow(int r, int hi) { return (r & 3) + 8 * (r >> 2) + 4 * hi; }
__device__ __forceinline__ unsigned cvtpk(float lo, float hi) {
  unsigned r; asm volatile("v_cvt_pk_bf16_f32 %0, %1, %2" : "=v"(r) : "v"(lo), "v"(hi)); return r;
}
template <typename TIn> struct Stage;
template <> struct Stage<bf16>  { using T = bf16x8;
  __device__ static __forceinline__ T ld8(const bf16* p) { return *reinterpret_cast<const bf16x8*>(p); }
  __device__ static __forceinline__ bf16x8 tobf(T x) { return x; } };
template <> struct Stage<float> { using T = f32x8;
  __device__ static __forceinline__ T ld8(const float* p) { return *reinterpret_cast<const f32x8*>(p); }
  __device__ static __forceinline__ bf16x8 tobf(T x) {
    u32x4 w = {cvtpk(x[0], x[1]), cvtpk(x[2], x[3]), cvtpk(x[4], x[5]), cvtpk(x[6], x[7])}; return *reinterpret_cast<bf16x8*>(&w); } };

__device__ __forceinline__ void partialSM(f32x16& p0, f32x16& p1, float& m_reg, float& mn, float& alpha) {
  constexpr float C = SCALE * 1.4426950408889634f;
  float pmax = p0[0]; for (int r = 1; r < 16; ++r) pmax = fmaxf(pmax, p0[r]); for (int r = 0; r < 16; ++r) pmax = fmaxf(pmax, p1[r]);
  { auto rr = __builtin_amdgcn_permlane32_swap(__float_as_uint(pmax), __float_as_uint(pmax), false, false);
    pmax = fmaxf(__uint_as_float(rr[0]), __uint_as_float(rr[1])); }
  if (__builtin_expect(__all(pmax - m_reg <= THR / SCALE), 1)) { mn = m_reg; alpha = 1.f; }
  else { mn = fmaxf(m_reg, pmax); alpha = __builtin_amdgcn_exp2f((m_reg - mn) * C); m_reg = mn; }
  float mnC = -mn * C;
  for (int r = 0; r < 16; ++r) p0[r] = fmaf(p0[r], C, mnC); for (int r = 0; r < 16; ++r) p1[r] = fmaf(p1[r], C, mnC);
  for (int r = 0; r < 16; ++r) p0[r] = __builtin_amdgcn_exp2f(p0[r]);
}
__device__ __forceinline__ void finishSM(f32x16& p0, f32x16& p1, float alpha, float& l_reg, bf16x8& pa0, bf16x8& pa1, bf16x8& pa2, bf16x8& pa3) {
  for (int r = 0; r < 16; ++r) p1[r] = __builtin_amdgcn_exp2f(p1[r]);
  float ps = 0; for (int r = 0; r < 16; ++r) ps += p0[r]; for (int r = 0; r < 16; ++r) ps += p1[r];
  { auto rr = __builtin_amdgcn_permlane32_swap(__float_as_uint(ps), __float_as_uint(ps), false, false);
    ps = __uint_as_float(rr[0]) + __uint_as_float(rr[1]); }
  l_reg = l_reg * alpha + ps;
#define PK4(P, BASE, OUT) do { unsigned a0 = cvtpk(P[BASE + 0], P[BASE + 1]), a1 = cvtpk(P[BASE + 2], P[BASE + 3]);   \
    unsigned b0 = cvtpk(P[BASE + 4], P[BASE + 5]), b1 = cvtpk(P[BASE + 6], P[BASE + 7]);                              \
    auto r0 = __builtin_amdgcn_permlane32_swap(a0, b0, false, false); auto r1 = __builtin_amdgcn_permlane32_swap(a1, b1, false, false); \
    u32x4 w = {r0[0], r1[0], r0[1], r1[1]}; OUT = *reinterpret_cast<bf16x8*>(&w); } while (0)
  PK4(p0, 0, pa0); PK4(p0, 8, pa1); PK4(p1, 0, pa2); PK4(p1, 8, pa3);
#undef PK4
}
__device__ __forceinline__ void qkt(f32x16& p0, f32x16& p1, const bf16* Ks, const bf16x8* qr, int r32, int hi) {
  p0 = f32x16{}; p1 = f32x16{};
  for (int d0 = 0; d0 < 8; ++d0) { int cb = (d0 * 16 + hi * 8) * 2;
    bf16x8 b0 = *reinterpret_cast<const bf16x8*>((const char*)Ks + KSWZ(r32, cb));
    bf16x8 b1 = *reinterpret_cast<const bf16x8*>((const char*)Ks + KSWZ(32 + r32, cb));
    p0 = __builtin_amdgcn_mfma_f32_32x32x16_bf16(b0, qr[d0], p0, 0, 0, 0);
    p1 = __builtin_amdgcn_mfma_f32_32x32x16_bf16(b1, qr[d0], p1, 0, 0, 0); }
}
__device__ __forceinline__ int v_st(int k, int c) { const int kk = (k & ~0xC) | ((k & 4) << 1) | ((k & 8) >> 1); return ((kk >> 3) * 4 + (c >> 5)) * 512 + ((kk & 7) * 32 + (c & 31)) * 2; }
__device__ __forceinline__ int v_rd_base(int lane) { return ((lane & 3) << 3) | (((lane >> 2) & 3) << 6) | (((lane >> 4) & 1) << 5) | (((lane >> 5) & 1) << 8); }
constexpr int v_rd_off(int d0, int ks, int half) { return d0 * 512 + ks * 4096 + half * 2048; }
template <int OFF> __device__ __forceinline__ s16x4 tr_read(int vb) {
  s16x4 r; asm volatile("ds_read_b64_tr_b16 %0, %1 offset:%2" : "=&v"(r) : "v"(vb), "i"(OFF) : "memory"); return r;
}
template <int D0> __device__ __forceinline__ void pv_one(f32x16& od, int vb, bf16x8 pa0, bf16x8 pa1, bf16x8 pa2, bf16x8 pa3) {
  const s16x4 l0 = tr_read<v_rd_off(D0, 0, 0)>(vb), h0 = tr_read<v_rd_off(D0, 0, 1)>(vb), l1 = tr_read<v_rd_off(D0, 1, 0)>(vb), h1 = tr_read<v_rd_off(D0, 1, 1)>(vb);
  const s16x4 l2 = tr_read<v_rd_off(D0, 2, 0)>(vb), h2 = tr_read<v_rd_off(D0, 2, 1)>(vb), l3 = tr_read<v_rd_off(D0, 3, 0)>(vb), h3 = tr_read<v_rd_off(D0, 3, 1)>(vb);
  asm volatile("s_waitcnt lgkmcnt(0)" ::: "memory"); SBAR();
#define PK(L, H) (bf16x8){L[0], L[1], L[2], L[3], H[0], H[1], H[2], H[3]}
  od = __builtin_amdgcn_mfma_f32_32x32x16_bf16(pa0, PK(l0, h0), od, 0, 0, 0);
  od = __builtin_amdgcn_mfma_f32_32x32x16_bf16(pa1, PK(l1, h1), od, 0, 0, 0);
  od = __builtin_amdgcn_mfma_f32_32x32x16_bf16(pa2, PK(l2, h2), od, 0, 0, 0);
  od = __builtin_amdgcn_mfma_f32_32x32x16_bf16(pa3, PK(l3, h3), od, 0, 0, 0);
#undef PK
}
__device__ __forceinline__ void pv_d0(f32x16* o, int vb, bf16x8 pa0, bf16x8 pa1, bf16x8 pa2, bf16x8 pa3) {
  pv_one<0>(o[0], vb, pa0, pa1, pa2, pa3); pv_one<1>(o[1], vb, pa0, pa1, pa2, pa3); pv_one<2>(o[2], vb, pa0, pa1, pa2, pa3); pv_one<3>(o[3], vb, pa0, pa1, pa2, pa3);
}

__device__ __forceinline__ void attn_dense_body(const bf16* __restrict__ Qb, const bf16* __restrict__ Kh, const bf16* __restrict__ Vh,
                                                const unsigned short* __restrict__ Gb, unsigned short* __restrict__ Ob, int seq, char* lds) {
  using TQ = bf16; using St = Stage<bf16>; using SQ = Stage<TQ>;
  const int tid = mk_tid(), wid = __builtin_amdgcn_readfirstlane(tid >> 6), lane = tid & 63, r32 = lane & 31, hi = lane >> 5;
  bf16* V_lds = (bf16*)lds; bf16* K_lds = (bf16*)(lds + 2 * SHM_V);
  float* ws = (float*)(lds + 2 * SHM_V + 2 * SHM_K) + wid * 64; float* li_l = ws; float* al_l = ws + 32;
  float m_reg = -1e30f, l_reg = 0; f32x16 o[4] = {}; bf16x8 qr[8];
  const TQ* Qw = Qb + (long)(wid * QBLK + r32) * LDQ + hi * 8;
#pragma unroll
  for (int d0 = 0; d0 < 8; ++d0) qr[d0] = SQ::tobf(SQ::ld8(Qw + d0 * 16));
  const int sr = tid >> 4, sc = (tid & 15) * 8, vst0 = v_st(sr, sc), vst1 = v_st(32 + sr, sc);
  const int vb0 = (int)(uintptr_t)V_lds + v_rd_base(lane);
  struct { typename St::T vs0, vs1, ks0, ks1; } sr_[SDEPTH];
#define SLOAD(i, k0) do { sr_[i].vs0 = St::ld8(&Vh[(long)((k0) + sr) * LDK + sc]); sr_[i].vs1 = St::ld8(&Vh[(long)((k0) + 32 + sr) * LDK + sc]); \
    sr_[i].ks0 = St::ld8(&Kh[(long)((k0) + sr) * LDK + sc]); sr_[i].ks1 = St::ld8(&Kh[(long)((k0) + 32 + sr) * LDK + sc]); } while (0)
#define SWRITE(b, i) do { *(bf16x8*)((char*)V_lds + (b) * SHM_V + vst0) = St::tobf(sr_[i].vs0);          \
    *(bf16x8*)((char*)V_lds + (b) * SHM_V + vst1) = St::tobf(sr_[i].vs1); int kc = sc * 2;               \
    *(bf16x8*)((char*)K_lds + (b) * SHM_K + KSWZ(sr, kc)) = St::tobf(sr_[i].ks0);                       \
    *(bf16x8*)((char*)K_lds + (b) * SHM_K + KSWZ(32 + sr, kc)) = St::tobf(sr_[i].ks1); } while (0)
#define SWAIT() do { if constexpr (SDEPTH == 2) asm volatile("s_waitcnt vmcnt(4)" ::: "memory"); else asm volatile("s_waitcnt vmcnt(0)" ::: "memory"); } while (0)
#define RESC(a) do { if (__any((a) < 1.f)) { if (hi == 0) al_l[r32] = (a); asm volatile("s_waitcnt lgkmcnt(0)" ::: "memory"); \
    for (int d = 0; d < 4; ++d) for (int r = 0; r < 16; ++r) o[d][r] *= al_l[crow(r, hi)]; } } while (0)
  f32x16 pA0, pA1, pB0, pB1; float mnA, mnB, alA, alB; bf16x8 pa0, pa1, pa2, pa3; const int NT = seq / KVBLK;
  constexpr int SE = 0, SO = SDEPTH - 1;
  SLOAD(SE, 0); asm volatile("s_waitcnt vmcnt(0)" ::: "memory"); SWRITE(0, SE); __syncthreads();
  qkt(pA0, pA1, K_lds, qr, r32, hi); partialSM(pA0, pA1, m_reg, mnA, alA);
  SLOAD(SO, KVBLK); if constexpr (SDEPTH == 2) { if (2 < NT) SLOAD(SE, 2 * KVBLK); }
  SWAIT(); SWRITE(1, SO); __syncthreads();
  for (int j = 1; j + 1 < NT; j += 2) {
    SBAR(); qkt(pB0, pB1, (bf16*)((char*)K_lds + SHM_K), qr, r32, hi);
    finishSM(pA0, pA1, alA, l_reg, pa0, pa1, pa2, pa3); SBAR();
    SLOAD(SO, (j + SDEPTH) * KVBLK); SBAR();
    pv_d0(o, vb0, pa0, pa1, pa2, pa3); partialSM(pB0, pB1, m_reg, mnB, alB);
    __syncthreads(); SWAIT(); SWRITE(0, SE);
    RESC(alB); __syncthreads();
    SBAR(); qkt(pA0, pA1, K_lds, qr, r32, hi);
    finishSM(pB0, pB1, alB, l_reg, pa0, pa1, pa2, pa3); SBAR();
    if (SDEPTH == 1 || j + 3 < NT) SLOAD(SE, (j + 1 + SDEPTH) * KVBLK); SBAR();
    pv_d0(o, vb0 + (int)SHM_V, pa0, pa1, pa2, pa3); partialSM(pA0, pA1, m_reg, mnA, alA);
    __syncthreads(); SWAIT(); SWRITE(1, SO);
    RESC(alA); __syncthreads();
  }
  SBAR(); qkt(pB0, pB1, (bf16*)((char*)K_lds + SHM_K), qr, r32, hi);
  finishSM(pA0, pA1, alA, l_reg, pa0, pa1, pa2, pa3); SBAR();
  pv_d0(o, vb0, pa0, pa1, pa2, pa3); partialSM(pB0, pB1, m_reg, mnB, alB);
  __syncthreads(); RESC(alB);
  finishSM(pB0, pB1, alB, l_reg, pa0, pa1, pa2, pa3); SBAR();
  pv_d0(o, vb0 + (int)SHM_V, pa0, pa1, pa2, pa3);
  if (hi == 0) li_l[r32] = l_reg; asm volatile("s_waitcnt lgkmcnt(0)" ::: "memory");
  float rli[16];
#pragma unroll
  for (int r = 0; r < 16; ++r) rli[r] = __builtin_amdgcn_rcpf(li_l[crow(r, hi)]);
  unsigned short* Ow = Ob + (long)(wid * QBLK) * LDO; const unsigned short* Gw = Gb + (long)(wid * QBLK) * LDQ;
  int lane_e = lane, r32_e = r32, hi_e = hi; asm volatile("" : "+v"(lane_e), "+v"(r32_e), "+v"(hi_e));
  unsigned short* stg = (unsigned short*)(lds + 69632 + wid * 8704);
#pragma unroll
  for (int r = 0; r < 16; ++r) { int orow = crow(r, hi_e);
#pragma unroll
    for (int d0 = 0; d0 < 4; ++d0) { unsigned u = __float_as_uint(o[d0][r] * rli[r]); u = (u + 0x7fffu + ((u >> 16) & 1u)) >> 16; stg[orow * 136 + d0 * 32 + r32_e] = (unsigned short)u; } }
  asm volatile("s_waitcnt lgkmcnt(0)" ::: "memory");
#pragma unroll 2
  for (int i = 0; i < 8; ++i) { const int idx = i * 64 + lane_e, row = idx >> 4, ch = idx & 15;
    const u32x4 x = *reinterpret_cast<const u32x4*>(stg + row * 136 + 8 * ch);
    const u32x4 g = *reinterpret_cast<const u32x4*>(Gw + (long)row * LDQ + 8 * ch);
    u32x4 w;
#pragma unroll
    for (int q = 0; q < 4; ++q) { const float x0 = __uint_as_float(x[q] << 16), x1 = __uint_as_float(x[q] & 0xffff0000u), g0 = __uint_as_float(g[q] << 16), g1 = __uint_as_float(g[q] & 0xffff0000u);
      const float y0 = x0 / (1.f + __expf(-g0)), y1 = x1 / (1.f + __expf(-g1));
      unsigned u0 = __float_as_uint(y0), u1 = __float_as_uint(y1); u0 = (u0 + 0x7fffu + ((u0 >> 16) & 1u)) >> 16; u1 = (u1 + 0x7fffu + ((u1 >> 16) & 1u)) >> 16; w[q] = u0 | (u1 << 16); }
    *reinterpret_cast<u32x4*>(Ow + (long)row * LDO + 8 * ch) = w; }
  __syncthreads();
#undef SLOAD
#undef SWRITE
#undef SWAIT
#undef RESC
}

#undef KSWZ
#undef SBAR
}

#define LAS __attribute__((address_space(3)))
typedef unsigned short bf16_t;
typedef short bf16x8 __attribute__((ext_vector_type(8)));
typedef float f32x4 __attribute__((ext_vector_type(4)));
typedef float f32x16 __attribute__((ext_vector_type(16)));
typedef unsigned u32x4 __attribute__((ext_vector_type(4)));
typedef unsigned u32x2 __attribute__((ext_vector_type(2)));

constexpr int NWAVES = 8, NTHR = 512;
constexpr int T_TOK = 16384, SEQ = 8192, DM = 1024;
constexpr float EPS = 1e-6f;
constexpr int LDS_BYTES = 147456;
constexpr size_t MiB = 1u << 20;
constexpr size_t WS_BAR = 512 * 1024;
constexpr size_t WS_TAB = 0;
constexpr size_t WS_W0_IN = 1 * MiB, WS_W0_OUT = 6 * MiB;
constexpr size_t WS_WA = 1 * MiB, WS_WZ = 9 * MiB, WS_WAB = 13 * MiB, WS_WO = 14 * MiB;
constexpr size_t WS_WUP = 18 * MiB, WS_WDOWN = 29 * MiB;
constexpr size_t WS_XN = 35 * MiB;
constexpr size_t WS_PROJ = 67 * MiB, WS_AO = 147 * MiB;
constexpr size_t WS_RAWF = 67 * MiB, WS_ACT = 155 * MiB;
constexpr size_t WS_AB = 18 * MiB  , WS_RAWG = 71 * MiB, WS_OF = 71 * MiB, WS_OB = 71 * MiB + 2048;
constexpr size_t WS_QG = 135 * MiB, WS_KG = 151 * MiB, WS_VG = 167 * MiB, WS_KT = 199 * MiB, WS_TPK = 215 * MiB, WS_APK = 231 * MiB;
constexpr size_t WS_EDGE = 249 * MiB  ;
constexpr size_t WS_GC = 247 * MiB, WS_BETA = 248 * MiB, WS_Z = 135 * MiB, WS_GO = 167 * MiB, WS_END = 255 * MiB;

__device__ __forceinline__ unsigned f2bf(float f) { unsigned u = __float_as_uint(f); return (u + 0x7fffu + ((u >> 16) & 1u)) >> 16; }
__device__ __forceinline__ unsigned pk2(float lo, float hi) { return f2bf(lo) | (f2bf(hi) << 16); }
__device__ __forceinline__ float bf2f(unsigned short h) { return __uint_as_float(((unsigned)h) << 16); }
__device__ __forceinline__ float bflo(unsigned w) { return __uint_as_float(w << 16); }
__device__ __forceinline__ float bfhi(unsigned w) { return __uint_as_float(w & 0xffff0000u); }
__device__ __forceinline__ float wave_sum(float v) {
#pragma unroll
    for (int o = 1; o < 64; o <<= 1) v += __shfl_xor(v, o);
    return v;
}
__device__ __forceinline__ float silu_f(float x) { return x * __builtin_amdgcn_rcpf(1.f + __expf(-x)); }
__device__ __forceinline__ float sigm_f(float x) { return __builtin_amdgcn_rcpf(1.f + __expf(-x)); }
#define LDS_WAIT() asm volatile("s_waitcnt lgkmcnt(0)" ::: "memory")

struct Args { const float* in[19]; float* out; unsigned char* ws; int ph_lo, ph_hi; };
struct Ctx {
    const __attribute__((address_space(4))) Args* a; float* out; unsigned char* ws; LAS unsigned char* lds; char* ldsg;
    int tid, lane, wave, G, bid;
};

#define GAS __attribute__((address_space(1)))
#define INP(C, i) ((const float*)(const GAS float*)(C).a->in[i])
__device__ __forceinline__ void transpose_seg(const float* W, int ldw, int k0, int c0, int Kc, int Nc, bf16_t* dst, int ldd, LAS float* scr, int gw, int NGW, int lane) {
    const int nblk = Nc / 32, nitems = (Kc / 64) * nblk;
    for (int it = gw; it < nitems; it += NGW) {
        const int kb = it / nblk, nb = it % nblk, kk0 = 64 * kb, n0 = 32 * nb;
        float wv[32];
#pragma unroll
        for (int i = 0; i < 32; ++i) { const int kk = 2 * i + (lane >> 5); wv[i] = W[(size_t)(k0 + kk0 + kk) * ldw + c0 + n0 + (lane & 31)]; }
#pragma unroll
        for (int i = 0; i < 32; ++i) { const int kk = 2 * i + (lane >> 5); scr[kk * 33 + (lane & 31)] = wv[i]; }
        LDS_WAIT(); asm volatile("" ::: "memory");
        const int c = lane & 7;
#pragma unroll
        for (int j = 0; j < 4; ++j) { const int n = (lane >> 3) + 8 * j; const LAS float* s = scr + (8 * c) * 33 + n;
            u32x4 o; o.x = pk2(s[0 * 33], s[1 * 33]); o.y = pk2(s[2 * 33], s[3 * 33]); o.z = pk2(s[4 * 33], s[5 * 33]); o.w = pk2(s[6 * 33], s[7 * 33]);
            *(u32x4*)(dst + (size_t)(n0 + n) * ldd + kk0 + 8 * c) = o; }
        LDS_WAIT(); asm volatile("" ::: "memory");
    }
}
__device__ __forceinline__ void rms_rows_bf16(const float* src, const float* gain, bf16_t* dst, int gw, int NGW, int lane) {
    f32x4 g[4];
#pragma unroll
    for (int j = 0; j < 4; ++j) g[j] = ((const f32x4*)gain)[lane + 64 * j];
    for (int m = gw; m < T_TOK; m += NGW) {
        const f32x4* xr = (const f32x4*)(src + (size_t)m * DM) + lane; f32x4 v[4]; float s = 0.f;
#pragma unroll
        for (int j = 0; j < 4; ++j) { v[j] = xr[64 * j]; s += (v[j].x * v[j].x + v[j].y * v[j].y) + (v[j].z * v[j].z + v[j].w * v[j].w); }
        const float rs = rsqrtf(wave_sum(s) * (1.f / DM) + EPS);
        u32x2* o8 = (u32x2*)(dst + (size_t)m * DM) + lane;
#pragma unroll
        for (int j = 0; j < 4; ++j) { u32x2 w; w.x = pk2(v[j].x * rs * g[j].x, v[j].y * rs * g[j].y); w.y = pk2(v[j].z * rs * g[j].z, v[j].w * rs * g[j].w); o8[64 * j] = w; }
    }
}
__device__ __forceinline__ void rms_rows_f32_inplace(float* buf, const float* gain, int gw, int NGW, int lane) {
    f32x4 g[4];
#pragma unroll
    for (int j = 0; j < 4; ++j) g[j] = ((const f32x4*)gain)[lane + 64 * j];
    for (int m = gw; m < T_TOK; m += NGW) {
        f32x4* xr = (f32x4*)(buf + (size_t)m * DM) + lane; f32x4 v[4]; float s = 0.f;
#pragma unroll
        for (int j = 0; j < 4; ++j) { v[j] = xr[64 * j]; s += (v[j].x * v[j].x + v[j].y * v[j].y) + (v[j].z * v[j].z + v[j].w * v[j].w); }
        const float rs = rsqrtf(wave_sum(s) * (1.f / DM) + EPS);
#pragma unroll
        for (int j = 0; j < 4; ++j) xr[64 * j] = v[j] * rs * g[j];
    }
}

__device__ __forceinline__ void ph_convert_ffn(const Ctx& C, int layer, int gw, int NGW) {
    LAS float* scr = (LAS float*)(C.lds + C.wave * 16384);
    unsigned char* ws = C.ws;
    const float* wup = INP(C, 15) + (size_t)layer * 1024 * 5632;
    for (int it = gw; it < 44 * 64; it += NGW) {
        const int seg = it >> 6, r = it & 63, ab = seg & 1, j = seg >> 1;
        transpose_seg(wup, 5632, 0, (ab ? 2816 : 0) + 128 * j, 1024, 128, (bf16_t*)(ws + WS_WUP) + (size_t)(256 * j + 128 * ab) * 1024, 1024, scr, r, 64, C.lane);
    }
    transpose_seg(INP(C, 18) + (size_t)layer * 2816 * 1024, 1024, 0, 0, 2816, 1024, (bf16_t*)(ws + WS_WDOWN), 2816, scr, gw, NGW, C.lane);
}
__device__ __forceinline__ void ph_convert_mixer(const Ctx& C, int layer, int gw, int NGW) {
    LAS float* scr = (LAS float*)(C.lds + C.wave * 16384);
    const int gt = gw * 64 + C.lane, NGT = NGW * 64;
    unsigned char* ws = C.ws;
    if (layer == 0) {
        transpose_seg(INP(C, 4), 2560, 0, 0, 1024, 2560, (bf16_t*)(ws + WS_W0_IN), 1024, scr, gw, NGW, C.lane);
        transpose_seg(INP(C, 7), 1024, 0, 0, 1024, 1024, (bf16_t*)(ws + WS_W0_OUT), 1024, scr, gw, NGW, C.lane);
        float* tab = (float*)(ws + WS_TAB);
        for (int i = gt; i < (128 + 64) * 32; i += NGT) {
            const int f = i & 31, pos = i >> 5;
            const float inv = powf(10000.0f, -(float)f * (2.0f / 64.0f));
            const float p = (pos < 128) ? (float)pos : (float)(pos - 128);
            const float ang = p * inv; float sn, cs; sincosf(ang, &sn, &cs);
            if (pos < 128) { tab[pos * 32 + f] = cs; tab[4096 + pos * 32 + f] = sn; }
            else { tab[8192 + (pos - 128) * 32 + f] = cs; tab[8192 + 2048 + (pos - 128) * 32 + f] = sn; }
        }
    } else {
        const float* wi = INP(C, 8);
        for (int p = 0; p < 2; ++p) {
            bf16_t* wa = (bf16_t*)(ws + WS_WA) + (size_t)p * 2048 * 1024;
            transpose_seg(wi, 6208, 0, 512 * p, 1024, 512, wa, 1024, scr, gw, NGW, C.lane);
            transpose_seg(wi, 6208, 0, 1024 + 512 * p, 1024, 512, wa + (size_t)512 * 1024, 1024, scr, gw, NGW, C.lane);
            transpose_seg(wi, 6208, 0, 2048 + 1024 * p, 1024, 1024, wa + (size_t)1024 * 1024, 1024, scr, gw, NGW, C.lane);
            transpose_seg(wi, 6208, 0, 4096 + 1024 * p, 1024, 1024, (bf16_t*)(ws + WS_WZ) + (size_t)p * 1024 * 1024, 1024, scr, gw, NGW, C.lane);
            transpose_seg(INP(C, 14), 1024, 1024 * p, 0, 1024, 1024, (bf16_t*)(ws + WS_WO) + (size_t)p * 1024 * 1024, 1024, scr, gw, NGW, C.lane);
        }
        transpose_seg(wi, 6208, 0, 6144, 1024, 64, (bf16_t*)(ws + WS_WAB), 1024, scr, gw, NGW, C.lane);
        { u32x4* z = (u32x4*)((bf16_t*)(ws + WS_WAB) + (size_t)64 * 1024);
          unsigned z0 = 0u; asm volatile("" : "+v"(z0));
          for (int i = gt; i < 192 * 1024 / 8; i += NGT) z[i] = (u32x4){z0, z0, z0, z0}; }
    }
}
__device__ __forceinline__ bool side_job(const Ctx& C, int& gw, int& NGW) {
    const int h = C.G >> 1;
    if (C.G < 16) { gw = C.bid * NWAVES + C.wave; NGW = C.G * NWAVES; return true; }
    if (C.bid < h) return false;
    gw = (C.bid - h) * NWAVES + C.wave; NGW = (C.G - h) * NWAVES; return true;
}

__device__ __forceinline__ void ph_attn_post(const Ctx& C) {
    const int gw = C.bid * NWAVES + C.wave, NGW = C.G * NWAVES, lane = C.lane;
    bf16_t* P = (bf16_t*)(C.ws + WS_PROJ); const float* tab = (const float*)(C.ws + WS_TAB);
    const int f = lane & 31, i1 = (lane < 32) ? f : 64 + f, i2 = i1 + 32;
    const float gq1 = INP(C, 5)[i1], gq2 = INP(C, 5)[i2], gk1 = INP(C, 6)[i1], gk2 = INP(C, 6)[i2];
    for (int it0 = gw; it0 < T_TOK * 10; it0 += 4 * NGW) {
        bf16_t* pp[4]; float x1[4], x2[4]; int hh4[4], t4[4];
#pragma unroll
        for (int u = 0; u < 4; ++u) { const int it = it0 + u * NGW; const int row = it / 10, hh = it - row * 10;
            const int col0 = hh < 8 ? hh * 128 : 1024 + (hh - 8) * 128;
            pp[u] = P + (size_t)row * 2560 + col0; hh4[u] = hh; t4[u] = row & (SEQ - 1);
            x1[u] = bf2f(pp[u][i1]); x2[u] = bf2f(pp[u][i2]); }
#pragma unroll
        for (int u = 0; u < 4; ++u) {
            const float rs = rsqrtf(wave_sum(x1[u] * x1[u] + x2[u] * x2[u]) * (1.f / 128.f) + EPS);
            const float y1 = x1[u] * rs * (hh4[u] < 8 ? gq1 : gk1), y2 = x2[u] * rs * (hh4[u] < 8 ? gq2 : gk2);
            float cs, sn;
            if (lane < 32) { const int pos = t4[u] >> 6; cs = tab[pos * 32 + f]; sn = tab[4096 + pos * 32 + f]; }
            else { const int pos = t4[u] & 63; cs = tab[8192 + pos * 32 + f]; sn = tab[8192 + 2048 + pos * 32 + f]; }
            x1[u] = y1 * cs - y2 * sn; x2[u] = y1 * sn + y2 * cs;
        }
#pragma unroll
        for (int u = 0; u < 4; ++u) { pp[u][i1] = (bf16_t)f2bf(x1[u]); pp[u][i2] = (bf16_t)f2bf(x2[u]); }
    }
}

__device__ __forceinline__ void ph_attention(const Ctx& C) {
    const bf16_t* P = (const bf16_t*)(C.ws + WS_PROJ); bf16_t* AO = (bf16_t*)(C.ws + WS_AO);
    for (int u = C.bid; u < 512; u += C.G) {
        const int qb = u & 31, h = (u >> 5) & 7, b = u >> 8;
        const size_t row0 = (size_t)b * SEQ + qb * 256, rowb = (size_t)b * SEQ;
        attn::attn_dense_body((const attn::bf16*)(P + row0 * 2560 + h * 128), (const attn::bf16*)(P + rowb * 2560 + 1024 + (h >> 2) * 128),
                              (const attn::bf16*)(P + rowb * 2560 + 1280 + (h >> 2) * 128), P + row0 * 2560 + 1536 + h * 128, AO + row0 * 1024 + h * 128, SEQ, C.ldsg);
    }
}

__device__ __forceinline__ void ph_ffn_gate(const Ctx& C, int layer, int p) {
    const bf16_t* R = (const bf16_t*)(C.ws + WS_RAWF); bf16_t* A = (bf16_t*)(C.ws + WS_ACT);
    const float* cw = INP(C, 16) + (size_t)layer * 3 * 5632; const float* cb = INP(C, 17) + (size_t)layer * 5632;
    for (int task = C.bid * NTHR + C.tid; task < 1024 * 176; task += C.G * NTHR) {
        const int cg = task % 176, rb = task / 176, r0 = rb * 16, t0 = r0 & (SEQ - 1);
        const int ca = 1408 * p + 8 * cg, cbn = 2816 + ca;
        float wa[3][8], wb[3][8], ba[8], bb[8];
#pragma unroll
        for (int s = 0; s < 3; ++s)
#pragma unroll
            for (int e = 0; e < 8; ++e) { wa[s][e] = cw[s * 5632 + ca + e]; wb[s][e] = cw[s * 5632 + cbn + e]; }
#pragma unroll
        for (int e = 0; e < 8; ++e) { ba[e] = cb[ca + e]; bb[e] = cb[cbn + e]; }
        const bf16_t* ra = R + (size_t)r0 * 2816 + 8 * cg; const bf16_t* rbp = ra + 1408;
        const u32x4 zero = {0u, 0u, 0u, 0u};
        u32x4 a0 = (t0 > 0) ? *(const u32x4*)(ra - 2816) : zero, b0 = (t0 > 0) ? *(const u32x4*)(rbp - 2816) : zero;
        u32x4 a1 = *(const u32x4*)ra, b1 = *(const u32x4*)rbp;
#pragma unroll 4
        for (int r = 0; r < 16; ++r) {
            const bool has = (t0 + r + 1) < SEQ;
            const u32x4 a2 = has ? *(const u32x4*)(ra + (size_t)(r + 1) * 2816) : zero, b2 = has ? *(const u32x4*)(rbp + (size_t)(r + 1) * 2816) : zero;
            float o[8];
#pragma unroll
            for (int q = 0; q < 4; ++q) {
                const float ua0 = wa[0][2 * q] * bflo(a0[q]) + wa[1][2 * q] * bflo(a1[q]) + wa[2][2 * q] * bflo(a2[q]) + ba[2 * q];
                const float ua1 = wa[0][2 * q + 1] * bfhi(a0[q]) + wa[1][2 * q + 1] * bfhi(a1[q]) + wa[2][2 * q + 1] * bfhi(a2[q]) + ba[2 * q + 1];
                const float ub0 = wb[0][2 * q] * bflo(b0[q]) + wb[1][2 * q] * bflo(b1[q]) + wb[2][2 * q] * bflo(b2[q]) + bb[2 * q];
                const float ub1 = wb[0][2 * q + 1] * bfhi(b0[q]) + wb[1][2 * q + 1] * bfhi(b1[q]) + wb[2][2 * q + 1] * bfhi(b2[q]) + bb[2 * q + 1];
                o[2 * q] = silu_f(ua0) * ub0; o[2 * q + 1] = silu_f(ua1) * ub1;
            }
            u32x4 w; w.x = pk2(o[0], o[1]); w.y = pk2(o[2], o[3]); w.z = pk2(o[4], o[5]); w.w = pk2(o[6], o[7]);
            *(u32x4*)(A + (size_t)(r0 + r) * 2816 + ca) = w;
            a0 = a1; a1 = a2; b0 = b1; b1 = b2;
        }
    }
}


__device__ __forceinline__ void ph_ffn_fixup(const Ctx& C, int layer) {
    const float* E = (const float*)(C.ws + WS_EDGE); bf16_t* A = (bf16_t*)(C.ws + WS_ACT);
    const float* cw = INP(C, 16) + (size_t)layer * 3 * 5632; const float* cb = INP(C, 17) + (size_t)layer * 5632;
    for (int it = C.bid * NTHR + C.tid; it < 64 * 2 * 22 * 16; it += C.G * NTHR) {
        const int cg = it & 15, j = (it >> 4) % 22, rest = (it >> 4) / 22, which = rest & 1, pm = rest >> 1;
        const int chl = 8 * cg, cha = 128 * j + chl, chb = 2816 + cha;
        const float* e0 = E + (size_t)((pm * 22 + j) * 4) * 256;
        const float *pr, *cu, *nx; bool zp = false, zn = false;
        if (which == 0) { zp = (pm & 31) == 0; pr = E + (size_t)(((pm > 0 ? pm - 1 : 0) * 22 + j) * 4 + 3) * 256; cu = e0; nx = e0 + 256; }
        else { pr = e0 + 2 * 256; cu = e0 + 3 * 256; zn = (pm & 31) == 31; nx = E + (size_t)(((pm < 63 ? pm + 1 : 63) * 22 + j) * 4) * 256; }
        float o[8];
#pragma unroll
        for (int e = 0; e < 8; ++e) {
            const float pa = zp ? 0.f : pr[chl + e], ca = cu[chl + e], na = zn ? 0.f : nx[chl + e];
            const float pb = zp ? 0.f : pr[128 + chl + e], cbv = cu[128 + chl + e], nb = zn ? 0.f : nx[128 + chl + e];
            const float ya = cw[cha + e] * pa + cw[5632 + cha + e] * ca + cw[2 * 5632 + cha + e] * na + cb[cha + e];
            const float yb = cw[chb + e] * pb + cw[5632 + chb + e] * cbv + cw[2 * 5632 + chb + e] * nb + cb[chb + e];
            o[e] = silu_f(ya) * yb;
        }
        u32x4 w; w.x = pk2(o[0], o[1]); w.y = pk2(o[2], o[3]); w.z = pk2(o[4], o[5]); w.w = pk2(o[6], o[7]);
        *(u32x4*)(A + (size_t)(pm * 256 + (which ? 255 : 0)) * 2816 + cha) = w;
    }
}

__device__ __forceinline__ void ph_gdn_gate(const Ctx& C) {
    const int gw = C.bid * NWAVES + C.wave, NGW = C.G * NWAVES, lane = C.lane;
    const unsigned* OF = (const unsigned*)(C.ws + WS_OF); const unsigned* OB = (const unsigned*)(C.ws + WS_OB);
    const unsigned* Z = (const unsigned*)(C.ws + WS_Z); unsigned* GO = (unsigned*)(C.ws + WS_GO);
    const float g0 = INP(C, 13)[2 * lane], g1 = INP(C, 13)[2 * lane + 1];
    for (int it0 = gw; it0 < T_TOK * 8; it0 += 4 * NGW) {
        unsigned a[4], b[4], z[4];
#pragma unroll
        for (int u = 0; u < 4; ++u) { const size_t idx = (size_t)(it0 + u * NGW) * 64 + lane; a[u] = OF[idx]; b[u] = OB[idx]; z[u] = Z[idx]; }
#pragma unroll
        for (int u = 0; u < 4; ++u) {
            const float o0 = bflo(a[u]) + bflo(b[u]), o1 = bfhi(a[u]) + bfhi(b[u]);
            const float rs = rsqrtf(wave_sum(o0 * o0 + o1 * o1) * (1.f / 128.f) + EPS);
            const float z0 = bflo(z[u]), z1 = bfhi(z[u]);
            GO[(size_t)(it0 + u * NGW) * 64 + lane] = pk2(o0 * rs * g0 * silu_f(z0), o1 * rs * g1 * silu_f(z1));
        }
    }
}

#define XB_TMO      128
#define XB_XCNT(j)  (256  + 64 * (j))
#define XB_XSUB(j)  (1280 + 64 * (j))
#define XB_XGEN(j)  (2304 + 64 * (j))
#define XB_TOP      3328
#define XB_TOPGEN   3392
#define XCD_BAR_WORDS 3456
#define XB_SPIN_CAP (1u << 18)

__device__ __forceinline__ unsigned xb_ld(unsigned* p)              { return __hip_atomic_load(p, __ATOMIC_RELAXED, __HIP_MEMORY_SCOPE_AGENT); }
__device__ __forceinline__ unsigned xb_add(unsigned* p, unsigned v) { return __hip_atomic_fetch_add(p, v, __ATOMIC_RELAXED, __HIP_MEMORY_SCOPE_AGENT); }
__device__ __forceinline__ unsigned xb_xcc_id() { return (unsigned)__builtin_amdgcn_s_getreg((3 << 11) | 20) & 0xFu; }
#define XB_SPIN(cond, bar) do { unsigned _sp = 0; while (cond) { __builtin_amdgcn_s_sleep(1); \
    if ((++_sp & 255u) == 0u) { if (xb_ld(&(bar)[XB_TMO])) break; if (_sp > XB_SPIN_CAP) { atomicAdd(&(bar)[XB_TMO], 1u); break; } } } } while (0)

struct XcdBarrier {
    unsigned* bar; unsigned x;
    volatile LAS unsigned* st;
};

__device__ __forceinline__ XcdBarrier xcd_barrier_post(unsigned* bar, volatile LAS unsigned* st) {
    XcdBarrier b; b.bar = bar; b.x = xb_xcc_id(); b.st = st;
    if (threadIdx.x == 0) (void)xb_add(&bar[XB_XCNT(b.x)], 1u);
    return b;
}
__device__ __forceinline__ void xcd_barrier_complete(unsigned* bar, unsigned x, unsigned& nloc, unsigned& nx) {
    const unsigned G = gridDim.x * gridDim.y * gridDim.z;
    unsigned sum, cnt, mine, sp = 0u;
    for (;;) {
        sum = 0u; cnt = 0u; mine = 0u;
#pragma unroll
        for (unsigned j = 0; j < 16; ++j) { const unsigned c = xb_ld(&bar[XB_XCNT(j)]); sum += c; cnt += (c > 0u) ? 1u : 0u; mine = (j == x) ? c : mine; }
        if (sum == G) break;
        __builtin_amdgcn_s_sleep(1);
        if ((++sp & 255u) == 0u) { if (xb_ld(&bar[XB_TMO])) break; if (sp > XB_SPIN_CAP) { atomicAdd(&bar[XB_TMO], 1u); break; } }
    }
    nloc = mine > 0u ? mine : 1u; nx = cnt > 0u ? cnt : 1u;
}

__device__ __forceinline__ void xcd_barrier(const XcdBarrier& b) {
    asm volatile("s_waitcnt vmcnt(0)" ::: "memory");
    __syncthreads();
    if (threadIdx.x == 0) {
        unsigned* bar = b.bar;
        __builtin_amdgcn_s_waitcnt(0);
        unsigned nloc = b.st[0], nx = b.st[1];
        if (nloc == 0u) { xcd_barrier_complete(bar, b.x, nloc, nx); b.st[0] = nloc; b.st[1] = nx; }
        const unsigned old = xb_add(&bar[XB_XSUB(b.x)], 1u);
        const unsigned gen = old / nloc;
        if (old + 1u == (gen + 1u) * nloc) {
            __builtin_amdgcn_fence(__ATOMIC_RELEASE, "agent");
            asm volatile("s_waitcnt vmcnt(0)" ::: "memory");
            const unsigned og = xb_add(&bar[XB_TOP], 1u);
            const unsigned tg = og / nx;
            if (og + 1u == (tg + 1u) * nx) xb_add(&bar[XB_TOPGEN], 1u);
            else XB_SPIN(xb_ld(&bar[XB_TOPGEN]) == tg, bar);
            __builtin_amdgcn_fence(__ATOMIC_ACQUIRE, "agent");
            xb_add(&bar[XB_XGEN(b.x)], 1u);
            asm volatile("s_waitcnt vmcnt(0)" ::: "memory");
        } else {
            XB_SPIN(xb_ld(&bar[XB_XGEN(b.x)]) == gen, bar);
            __builtin_amdgcn_fence(__ATOMIC_ACQUIRE, "agent");
            asm volatile("s_waitcnt vmcnt(0)" ::: "memory");
        }
    }
    __syncthreads();
}

__device__ __forceinline__ int crow16(int r, int hi) { return (r & 3) + 8 * (r >> 2) + 4 * hi; }
__device__ __forceinline__ unsigned cvtpk2(float lo, float hi) { return pg8::cvt_pk_bf16(lo, hi); }
#define PK4S(P, BASE, OUT) do { unsigned a0_ = cvtpk2(P[BASE + 0], P[BASE + 1]), a1_ = cvtpk2(P[BASE + 2], P[BASE + 3]);   \
    unsigned b0_ = cvtpk2(P[BASE + 4], P[BASE + 5]), b1_ = cvtpk2(P[BASE + 6], P[BASE + 7]);                              \
    auto r0_ = __builtin_amdgcn_permlane32_swap(a0_, b0_, false, false); auto r1_ = __builtin_amdgcn_permlane32_swap(a1_, b1_, false, false); \
    u32x4 w_ = {r0_[0], r1_[0], r0_[1], r1_[1]}; OUT = *reinterpret_cast<bf16x8*>(&w_); } while (0)

__device__ __forceinline__ void ph_ab_small(const Ctx& C) {
    const bf16_t* XN = (const bf16_t*)(C.ws + WS_XN); const bf16_t* WB = (const bf16_t*)(C.ws + WS_WAB); float* AB = (float*)(C.ws + WS_AB);
    const int lane = C.lane, w = C.wave, mt = w & 1, nt = (w >> 1) & 1, kh = w >> 2, r32 = lane & 31, hi = lane >> 5;
    LAS float* red = (LAS float*)C.lds;
    for (int slab = C.bid; slab < T_TOK / 64; slab += C.G) {
        const bf16_t* ap = XN + (size_t)(slab * 64 + 32 * mt + r32) * 1024 + 512 * kh + 8 * hi;
        const bf16_t* bp = WB + (size_t)(32 * nt + r32) * 1024 + 512 * kh + 8 * hi;
        f32x16 acc = {};
#pragma unroll 8
        for (int ks = 0; ks < 32; ++ks) {
            const bf16x8 a = *(const bf16x8*)(ap + 16 * ks), b = *(const bf16x8*)(bp + 16 * ks);
            acc = __builtin_amdgcn_mfma_f32_32x32x16_bf16(a, b, acc, 0, 0, 0);
        }
        if (kh == 1) {
#pragma unroll
            for (int r = 0; r < 16; ++r) red[((w & 3) * 16 + r) * 64 + lane] = acc[r];
        }
        __syncthreads();
        if (kh == 0) {
#pragma unroll
            for (int r = 0; r < 16; ++r) AB[(size_t)(slab * 64 + 32 * mt + crow16(r, hi)) * 256 + 32 * nt + r32] = acc[r] + red[((w & 3) * 16 + r) * 64 + lane];
        }
        __syncthreads();
    }
}
constexpr int GDN_KS = 48;
__device__ __forceinline__ void ph_gdn_prep(const Ctx& C, int p, int mode) {
    const int tid = C.tid, lane = C.lane, wave = C.wave;
    unsigned char* ws = C.ws;
    const bf16_t* RAW = (const bf16_t*)(ws + WS_RAWG);
    bf16_t* QG = (bf16_t*)(ws + WS_QG); bf16_t* KG = (bf16_t*)(ws + WS_KG); bf16_t* VG = (bf16_t*)(ws + WS_VG); bf16_t* KT = (bf16_t*)(ws + WS_KT);
    bf16_t* TPK = (bf16_t*)(ws + WS_TPK); bf16_t* APK = (bf16_t*)(ws + WS_APK);
    float* GC = (float*)(ws + WS_GC); float* BETA = (float*)(ws + WS_BETA); const float* AB = (const float*)(ws + WS_AB);
    const float* cw = INP(C, 9); const float* cb = INP(C, 10);
    LAS bf16_t* qs = (LAS bf16_t*)(C.lds); LAS bf16_t* ks = (LAS bf16_t*)(C.lds + 17408);
    LAS float* KKs = (LAS float*)(C.lds + 34816); LAS float* QKs = (LAS float*)(C.lds + 51456);
    LAS float* Ls = (LAS float*)(C.lds + 68096);
    const int per = mode ? (126 - 2 * GDN_KS) : 2 * (GDN_KS + 1), ntask = 8 * per;
    for (int task = mode ? C.bid - 128 : C.bid; task < ntask; task += mode ? C.G - 128 : C.G) {
        const int ci = task % per, grp = task / per, hql = grp & 3, b = grp >> 2;
        const int chunk = mode ? GDN_KS + 1 + ci : (ci <= GDN_KS ? ci : 126 - 2 * GDN_KS + ci);
        const int row0 = b * SEQ + chunk * 64;
#ifndef PREP_REP_A
#define PREP_REP_A 1
#endif
#ifndef PREP_REP_C
#define PREP_REP_C 1
#endif
#pragma unroll 1
        for (int repa = 0; repa < PREP_REP_A; ++repa) {
            const int cgp = tid & 63, rg = wave, lc = 8 * cgp;
            int rcol, chan; int kind;
            if (lc < 128) { kind = 0; rcol = 128 * hql + lc; chan = (4 * p + hql) * 128 + lc; }
            else if (lc < 256) { kind = 1; rcol = 512 + 128 * hql + (lc - 128); chan = 1024 + (4 * p + hql) * 128 + (lc - 128); }
            else { kind = 2; rcol = 1024 + 256 * hql + (lc - 256); chan = 2048 + (8 * p + 2 * hql) * 128 + (lc - 256); }
            float w5[5][8], bs[8];
#pragma unroll
            for (int s = 0; s < 5; ++s)
#pragma unroll
                for (int e = 0; e < 8; ++e) w5[s][e] = cw[s * 4096 + chan + e];
#pragma unroll
            for (int e = 0; e < 8; ++e) bs[e] = cb[chan + e];
            {
                const int tl0 = chunk * 64 + 8 * rg - 2;
                u32x4 win[12];
#pragma unroll
                for (int j = 0; j < 12; ++j) { const int tl = tl0 + j; win[j] = (u32x4){0u, 0u, 0u, 0u};
                    if (tl >= 0 && tl < SEQ) win[j] = *(const u32x4*)(RAW + (size_t)(b * SEQ + tl) * 2048 + rcol); }
#pragma unroll
                for (int r = 0; r < 8; ++r) {
                    float o[8];
#pragma unroll
                    for (int e = 0; e < 8; ++e) o[e] = bs[e];
#pragma unroll
                    for (int s5 = 0; s5 < 5; ++s5) { const u32x4 x = win[r + s5];
#pragma unroll
                        for (int q = 0; q < 4; ++q) { o[2 * q] += w5[s5][2 * q] * bflo(x[q]); o[2 * q + 1] += w5[s5][2 * q + 1] * bfhi(x[q]); } }
                    float ss = 0.f;
#pragma unroll
                    for (int e = 0; e < 8; ++e) { o[e] = silu_f(o[e]); ss += o[e] * o[e]; }
                    ss += __shfl_xor(ss, 1); ss += __shfl_xor(ss, 2); ss += __shfl_xor(ss, 4); ss += __shfl_xor(ss, 8);
                    float sc = rsqrtf(ss + EPS); if (kind == 0) sc *= 0.08838834764831845f; if (kind == 2) sc = 1.f;
                    u32x4 w; w.x = pk2(o[0] * sc, o[1] * sc); w.y = pk2(o[2] * sc, o[3] * sc); w.z = pk2(o[4] * sc, o[5] * sc); w.w = pk2(o[6] * sc, o[7] * sc);
                    const int rr = 8 * rg + r; const size_t grow = (size_t)(row0 + rr);
                    if (kind == 0) { *(u32x4*)(QG + grow * 512 + 128 * hql + lc) = w; *(LAS u32x4*)(qs + rr * 136 + lc) = w; }
                    else if (kind == 1) { *(u32x4*)(KG + grow * 512 + 128 * hql + (lc - 128)) = w; *(LAS u32x4*)(ks + rr * 136 + (lc - 128)) = w; }
                    else { *(u32x4*)(VG + grow * 1024 + 256 * hql + (lc - 256)) = w; }
                }
            }
        }
        __syncthreads();
        {
            bf16_t* kt = KT + ((size_t)((b * 4 + hql) * 128 + chunk)) * 8192;
            const int dk = tid & 127, tg = tid >> 7;
            unsigned short v[16];
#pragma unroll
            for (int i = 0; i < 16; ++i) v[i] = ks[(16 * tg + i) * 136 + dk];
            u32x4 w0, w1;
#pragma unroll
            for (int q = 0; q < 4; ++q) { w0[q] = (unsigned)v[2 * q] | ((unsigned)v[2 * q + 1] << 16); w1[q] = (unsigned)v[8 + 2 * q] | ((unsigned)v[8 + 2 * q + 1] << 16); }
            *(u32x4*)(kt + (size_t)dk * 64 + 16 * tg) = w0; *(u32x4*)(kt + (size_t)dk * 64 + 16 * tg + 8) = w1;
        }
        {
            const int mat = wave >> 2, mi = (wave >> 1) & 1, ni = wave & 1, r32 = lane & 31, hi = lane >> 5;
            LAS bf16_t* X = mat ? qs : ks; f32x16 acc = {};
#pragma unroll
            for (int kk = 0; kk < 8; ++kk) {
                const bf16x8 a = *(const LAS bf16x8*)(X + (32 * mi + r32) * 136 + 16 * kk + 8 * hi);
                const bf16x8 bb = *(const LAS bf16x8*)(ks + (32 * ni + r32) * 136 + 16 * kk + 8 * hi);
                acc = __builtin_amdgcn_mfma_f32_32x32x16_bf16(a, bb, acc, 0, 0, 0);
            }
            LAS float* M = mat ? QKs : KKs;
#pragma unroll
            for (int r = 0; r < 16; ++r) M[(32 * mi + crow16(r, hi)) * 65 + 32 * ni + r32] = acc[r];
        }
        __syncthreads();
        {
            const int cw = wave & 3, rh = wave >> 2;
            const int vh = cw >> 1, dir = cw & 1, hloc = 2 * hql + vh, head = 8 * p + hloc;
            const int row = row0 + lane;
            const float av = AB[(size_t)row * 256 + dir * 32 + head], bv = AB[(size_t)row * 256 + dir * 32 + 16 + head];
            const float xx = av + INP(C, 12)[dir * 16 + head];
            const float ex = __expf(xx); const float sp = xx > 20.f ? xx : (xx < -10.f ? ex : __logf(1.f + ex));
            const float g = -__expf(INP(C, 11)[dir * 16 + head]) * sp;
            const float beta = sigm_f(bv);
            float v = dir ? __shfl(g, 63 - lane) : g;
#pragma unroll
            for (int off = 1; off < 64; off <<= 1) { const float t = __shfl_up(v, off); if (lane >= off) v += t; }
            const float gc = dir ? __shfl(v, 63 - lane) : v;
            if (rh == 0) { GC[((size_t)dir * T_TOK + row) * 8 + hloc] = gc; BETA[((size_t)dir * T_TOK + row) * 8 + hloc] = beta; }
            const int c = lane, jo = dir ? 63 - c : c;
            const float gcj = __shfl(gc, jo);
            LAS float* L = Ls + cw * 4096;
            const size_t mbase = ((size_t)((b * 8 + hloc) * 128 + chunk)) * 4096;
#pragma unroll 4
            for (int q = 0; q < 32; ++q) {
                const int ip = 32 * rh + q, io = dir ? 63 - ip : ip;
                const float gci = __shfl(gc, io), bti = __shfl(beta, io);
                const float dec = (c <= ip) ? __expf(gci - gcj) : 0.f;
                const float lv = (c < ip) ? bti * KKs[io * 65 + jo] * dec : 0.f;
                L[ip * 64 + c] = lv;
                const bool wr = dir ? (c < ip) : (c <= ip);
                if (wr) APK[mbase + io * 64 + jo] = (bf16_t)f2bf(QKs[io * 65 + jo] * dec);
            }
            __syncthreads();
            if (wave < 4) {
                float x[64];
#pragma unroll
                for (int i = 0; i < 64; ++i) x[i] = 0.f;
                f32x4 cur[8], nxt[8];
#pragma unroll
                for (int j4 = 0; j4 < 8; ++j4) { cur[j4] = (f32x4){0.f, 0.f, 0.f, 0.f}; nxt[j4] = (f32x4){0.f, 0.f, 0.f, 0.f}; }
                cur[0] = *(const LAS f32x4*)(L + 1 * 64);
                x[0] = (c == 0) ? 1.f : 0.f;
#pragma unroll
                for (int i = 1; i < 64; ++i) {
                    if (i + 1 < 64) {
#pragma unroll
                        for (int j4 = 0; j4 < ((i + 1 + 3) / 4 < 8 ? (i + 1 + 3) / 4 : 8); ++j4) nxt[j4] = *(const LAS f32x4*)(L + (i + 1) * 64 + 4 * j4);
                    }
                    float a0 = (c == i) ? 1.f : 0.f, a1 = 0.f;
#pragma unroll
                    for (int j4 = 0; j4 < (i + 3) / 4; ++j4) {
                        const f32x4 l = (j4 < 8) ? cur[j4 < 8 ? j4 : 0] : *(const LAS f32x4*)(L + i * 64 + 4 * j4);
                        if (4 * j4 + 0 < i) a0 -= l[0] * x[4 * j4 + 0];
                        if (4 * j4 + 1 < i) a1 -= l[1] * x[4 * j4 + 1];
                        if (4 * j4 + 2 < i) a0 -= l[2] * x[4 * j4 + 2];
                        if (4 * j4 + 3 < i) a1 -= l[3] * x[4 * j4 + 3];
                    }
                    x[i] = a0 + a1;
                    asm volatile("" ::: "memory");
#pragma unroll
                    for (int j4 = 0; j4 < 8; ++j4) cur[j4] = nxt[j4];
                }
#pragma unroll
                for (int i = 0; i < 64; ++i) L[i * 64 + c] = x[i];
            }
            __syncthreads();
#pragma unroll 4
            for (int q = 0; q < 32; ++q) { const int i = 32 * rh + q, io = dir ? 63 - i : i; const float xv = L[i * 64 + c]; if (c < i) TPK[mbase + io * 64 + jo] = (bf16_t)f2bf(xv); }
        }
        __syncthreads();
    }
}

constexpr int SC_SLOT = 54272;
constexpr int SC_KT = 2 * SC_SLOT;
constexpr int SC_SB = SC_KT + 16384, SC_RB = SC_SB + 8192;
constexpr int SL_VB = 16384, SL_VSB = 16384 + 4096;
#define SC_BAR() do { asm volatile("s_waitcnt lgkmcnt(0)" ::: "memory"); __builtin_amdgcn_s_barrier(); asm volatile("" ::: "memory"); } while (0)
struct ScanRegs { u32x4 q[4], k[4], kt[4], t[2], a[2], v; float gcv, gl, bt; };
__device__ __forceinline__ void scan_issue(const Ctx& C, ScanRegs& R, int ltid, int cidx, int b, int hql, int vh, int dir, int sl) {
    const int hloc = 2 * hql + vh; unsigned char* ws = C.ws;
    const size_t row0 = (size_t)b * SEQ + cidx * 64;
    const bf16_t* QG = (const bf16_t*)(ws + WS_QG) + row0 * 512 + 128 * hql;
    const bf16_t* KG = (const bf16_t*)(ws + WS_KG) + row0 * 512 + 128 * hql;
    const bf16_t* KT = (const bf16_t*)(ws + WS_KT) + ((size_t)((b * 4 + hql) * 128 + cidx)) * 8192;
    const bf16_t* TP = (const bf16_t*)(ws + WS_TPK) + ((size_t)((b * 8 + hloc) * 128 + cidx)) * 4096;
    const bf16_t* AP = (const bf16_t*)(ws + WS_APK) + ((size_t)((b * 8 + hloc) * 128 + cidx)) * 4096;
    const bf16_t* VG = (const bf16_t*)(ws + WS_VG) + row0 * 1024 + 256 * hql + 128 * vh + 32 * sl;
#pragma unroll
    for (int j = 0; j < 4; ++j) { const int i = ltid + 256 * j, r = i >> 4, ch = i & 15;
        R.q[j] = *(const u32x4*)(QG + (size_t)r * 512 + 8 * ch); R.k[j] = *(const u32x4*)(KG + (size_t)r * 512 + 8 * ch);
        const int r2 = i >> 3, c2 = i & 7; R.kt[j] = *(const u32x4*)(KT + (size_t)r2 * 64 + 8 * c2); }
#pragma unroll
    for (int j = 0; j < 2; ++j) { const int i = ltid + 256 * j, r = i >> 3, ch = i & 7; R.t[j] = *(const u32x4*)(TP + r * 64 + 8 * ch); R.a[j] = *(const u32x4*)(AP + r * 64 + 8 * ch); }
    { const int r = ltid >> 2, ch = ltid & 3; R.v = *(const u32x4*)(VG + (size_t)r * 1024 + 8 * ch); }
    if (ltid < 64) { const float* GC = (const float*)(ws + WS_GC) + ((size_t)dir * T_TOK + row0) * 8 + hloc; const float* BT = (const float*)(ws + WS_BETA) + ((size_t)dir * T_TOK + row0) * 8 + hloc;
        R.gcv = GC[ltid * 8]; R.gl = GC[(dir ? 0 : 63) * 8]; R.bt = BT[ltid * 8]; }
}
__device__ __forceinline__ void scan_write_kt(const ScanRegs& R, LAS unsigned char* lds, int ltid) {
#pragma unroll
    for (int j = 0; j < 4; ++j) { const int i = ltid + 256 * j, r2 = i >> 3, c2 = i & 7; *(LAS u32x4*)(lds + SC_KT + r2 * 128 + ((c2 ^ (r2 & 7)) << 4)) = R.kt[j]; }
}
__device__ __forceinline__ void scan_write_slot(const ScanRegs& R, LAS unsigned char* Lb, int ltid, int dir) {
#pragma unroll
    for (int j = 0; j < 4; ++j) { const int i = ltid + 256 * j, r = i >> 4, ch = i & 15; const int o = r * 256 + ((ch ^ (r & 7)) << 4);
        *(LAS u32x4*)(Lb + o) = R.q[j]; *(LAS u32x4*)(Lb + 16384 + o) = R.k[j]; }
#pragma unroll
    for (int j = 0; j < 2; ++j) { const int i = ltid + 256 * j, r = i >> 3, ch = i & 7; u32x4 t = R.t[j], a = R.a[j];
#pragma unroll
        for (int q = 0; q < 4; ++q) {
            unsigned tl = t[q] & 0xffffu, th = t[q] >> 16, al = a[q] & 0xffffu, ah = a[q] >> 16;
            const int j0 = 8 * ch + 2 * q, j1 = j0 + 1;
            const bool s0 = dir ? (j0 > r) : (j0 < r), s1 = dir ? (j1 > r) : (j1 < r);
            tl = s0 ? tl : (j0 == r ? 0x3f80u : 0u); th = s1 ? th : (j1 == r ? 0x3f80u : 0u);
            al = (s0 || j0 == r) ? al : 0u; ah = (s1 || j1 == r) ? ah : 0u;
            t[q] = tl | (th << 16); a[q] = al | (ah << 16);
        }
        const int o = r * 128 + ((ch ^ (r & 7)) << 4);
        *(LAS u32x4*)(Lb + 32768 + o) = t; *(LAS u32x4*)(Lb + 40960 + o) = a; }
    { const int r = ltid >> 2, ch = ltid & 3; *(LAS u32x4*)(Lb + 49152 + r * 64 + ch * 16) = R.v; }
    if (ltid < 64) { LAS float* sc = (LAS float*)(Lb + 53248);
        sc[ltid] = __expf(R.gcv); sc[64 + ltid] = __expf(R.gl - R.gcv); sc[128 + ltid] = R.bt; if (ltid == 0) sc[192] = __expf(R.gl); }
}
__device__ __forceinline__ void scan_out(f32x16 acc, LAS unsigned char* Lb, bf16_t* obase, int mi, int r32, int hi, int lane) {
    bf16x8 af[4], vf[4];
#pragma unroll
    for (int kk = 0; kk < 4; ++kk) { const int row = 32 * mi + r32; af[kk] = *(const LAS bf16x8*)(Lb + 40960 + row * 128 + (((2 * kk + hi) ^ (row & 7)) << 4));
        vf[kk] = *(const LAS bf16x8*)(Lb + SL_VB + kk * 1024 + lane * 16); }
#pragma unroll
    for (int kk = 0; kk < 4; ++kk) acc = __builtin_amdgcn_mfma_f32_32x32x16_bf16(af[kk], vf[kk], acc, 0, 0, 0);
    bf16_t* op = obase + r32;
#pragma unroll
    for (int r = 0; r < 16; ++r) op[(size_t)(32 * mi + crow16(r, hi)) * 2048] = (bf16_t)f2bf(acc[r]);
}
__device__ __forceinline__ void ph_gdn_scan(const Ctx& C, int p, const XcdBarrier& xbar, bool side) {
    if (C.bid >= 128) {
        ph_gdn_prep(C, p, 1);
        xcd_barrier(xbar);
        if (side) ph_convert_ffn(C, 1, (C.bid - 128) * NWAVES + C.wave, (C.G - 128) * NWAVES);
        return;
    }
    const int group = C.bid & 7, b = group >> 2, hql = group & 3, jj = C.bid >> 3, vh = jj >> 3, dir = (jj >> 2) & 1, sl = jj & 3;
    const int hloc = 2 * hql + vh, lane = C.lane, w = C.wave;
    LAS unsigned char* lds = C.lds;
    bf16_t* OD = (bf16_t*)(C.ws + (dir ? WS_OB : WS_OF));
    if (w >= 4) {
        const int ltid = C.tid - 256;
        ScanRegs R;
        scan_issue(C, R, ltid, dir ? 127 : 0, b, hql, vh, dir, sl);
        scan_write_slot(R, lds, ltid, dir); scan_write_kt(R, lds, ltid);
        { unsigned z0 = 0u; asm volatile("" : "+v"(z0));
          for (int i = ltid; i < 8192 / 16; i += 256) *(LAS u32x4*)(lds + SC_SB + i * 16) = (u32x4){z0, z0, z0, z0}; }
        for (int n = 0; n < 128; ++n) {
            if (n == GDN_KS) {
                xcd_barrier(xbar);
                scan_issue(C, R, ltid, dir ? 127 - n : n, b, hql, vh, dir, sl);
                scan_write_slot(R, lds + (n & 1) * SC_SLOT, ltid, dir);
            }
            SC_BAR();
            if (n > 0) scan_write_kt(R, lds, ltid);
            const bool pre = (n + 1 < 128) && (n + 1 != GDN_KS);
            if (pre) scan_issue(C, R, ltid, dir ? 126 - n : n + 1, b, hql, vh, dir, sl);
            SC_BAR();
            SC_BAR();
            if (pre) scan_write_slot(R, lds + ((n + 1) & 1) * SC_SLOT, ltid, dir);
        }
    } else {
        f32x16 S = {}, oacc = {};
        for (int n = 0; n < 128; ++n) {
            int r32 = lane & 31, hi = lane >> 5; asm volatile("" : "+v"(r32), "+v"(hi));
            LAS unsigned char* Lb = lds + (n & 1) * SC_SLOT;
            const LAS float* sc = (const LAS float*)(Lb + 53248);
            const int cidx = dir ? 127 - n : n;
            if (n == GDN_KS) xcd_barrier(xbar);
            SC_BAR();
            const int mi = w & 1;
            f32x16 acc = {};
            {
                LAS unsigned char* Ab = Lb + (w < 2 ? 16384 : 0);
                bf16x8 af[8], sf[8];
#pragma unroll
                for (int kk = 0; kk < 8; ++kk) { const int row = 32 * mi + r32; af[kk] = *(const LAS bf16x8*)(Ab + row * 256 + (((2 * kk + hi) ^ (row & 7)) << 4));
                    sf[kk] = *(const LAS bf16x8*)(lds + SC_SB + kk * 1024 + lane * 16); }
#pragma unroll
                for (int kk = 0; kk < 8; ++kk) acc = __builtin_amdgcn_mfma_f32_32x32x16_bf16(af[kk], sf[kk], acc, 0, 0, 0);
            }
            if (w < 2) {
#pragma unroll
                for (int g4 = 0; g4 < 4; ++g4) { const int i0 = 32 * mi + 8 * g4 + 4 * hi;
                    const f32x4 eg = *(const LAS f32x4*)(sc + i0), bt = *(const LAS f32x4*)(sc + 128 + i0);
#pragma unroll
                    for (int e = 0; e < 4; ++e) { const float vv = bf2f(*(const LAS bf16_t*)(Lb + 49152 + (i0 + e) * 64 + r32 * 2));
                        acc[4 * g4 + e] = bt[e] * (vv - eg[e] * acc[4 * g4 + e]); } }
                bf16x8 f0, f1; PK4S(acc, 0, f0); PK4S(acc, 8, f1);
                *(LAS bf16x8*)(lds + SC_RB + (2 * mi) * 1024 + lane * 16) = f0; *(LAS bf16x8*)(lds + SC_RB + (2 * mi + 1) * 1024 + lane * 16) = f1;
            }
            SC_BAR();
            if (w < 2) {
                bf16x8 af[4], rf[4];
#pragma unroll
                for (int kk = 0; kk < 4; ++kk) { const int row = 32 * mi + r32; af[kk] = *(const LAS bf16x8*)(Lb + 32768 + row * 128 + (((2 * kk + hi) ^ (row & 7)) << 4));
                    rf[kk] = *(const LAS bf16x8*)(lds + SC_RB + kk * 1024 + lane * 16); }
                f32x16 vn = {};
#pragma unroll
                for (int kk = 0; kk < 4; ++kk) vn = __builtin_amdgcn_mfma_f32_32x32x16_bf16(af[kk], rf[kk], vn, 0, 0, 0);
                bf16x8 f0, f1; PK4S(vn, 0, f0); PK4S(vn, 8, f1);
                *(LAS bf16x8*)(Lb + SL_VB + (2 * mi) * 1024 + lane * 16) = f0; *(LAS bf16x8*)(Lb + SL_VB + (2 * mi + 1) * 1024 + lane * 16) = f1;
#pragma unroll
                for (int g4 = 0; g4 < 4; ++g4) { const int i0 = 32 * mi + 8 * g4 + 4 * hi; const f32x4 ek = *(const LAS f32x4*)(sc + 64 + i0);
#pragma unroll
                    for (int e = 0; e < 4; ++e) vn[4 * g4 + e] *= ek[e]; }
                PK4S(vn, 0, f0); PK4S(vn, 8, f1);
                *(LAS bf16x8*)(Lb + SL_VSB + (2 * mi) * 1024 + lane * 16) = f0; *(LAS bf16x8*)(Lb + SL_VSB + (2 * mi + 1) * 1024 + lane * 16) = f1;
            }
            if (w >= 2) {
#pragma unroll
                for (int g4 = 0; g4 < 4; ++g4) { const int i0 = 32 * mi + 8 * g4 + 4 * hi; const f32x4 eg = *(const LAS f32x4*)(sc + i0);
#pragma unroll
                    for (int e = 0; e < 4; ++e) acc[4 * g4 + e] *= eg[e]; }
                if (n > 0) scan_out(oacc, lds + ((n - 1) & 1) * SC_SLOT, OD + ((size_t)b * SEQ + (dir ? 128 - n : n - 1) * 64) * 2048 + hloc * 128 + sl * 32, mi, r32, hi, lane);
                oacc = acc;
            }
            SC_BAR();
            {
                const float gl = sc[192];
                bf16x8 af[4], vf[4];
#pragma unroll
                for (int kk = 0; kk < 4; ++kk) { const int row = 32 * w + r32; af[kk] = *(const LAS bf16x8*)(lds + SC_KT + row * 128 + (((2 * kk + hi) ^ (row & 7)) << 4));
                    vf[kk] = *(const LAS bf16x8*)(Lb + SL_VSB + kk * 1024 + lane * 16); }
                S = S * gl;
#pragma unroll
                for (int kk = 0; kk < 4; ++kk) S = __builtin_amdgcn_mfma_f32_32x32x16_bf16(af[kk], vf[kk], S, 0, 0, 0);
                bf16x8 f0, f1; PK4S(S, 0, f0); PK4S(S, 8, f1);
                *(LAS bf16x8*)(lds + SC_SB + (2 * w) * 1024 + lane * 16) = f0; *(LAS bf16x8*)(lds + SC_SB + (2 * w + 1) * 1024 + lane * 16) = f1;
            }
        }
        if (w >= 2) { int r32 = lane & 31, hi = lane >> 5; scan_out(oacc, lds + (127 & 1) * SC_SLOT, OD + ((size_t)b * SEQ + (dir ? 0 : 127) * 64) * 2048 + hloc * 128 + sl * 32, w & 1, r32, hi, lane); }
    }
    __syncthreads();
}

constexpr int NPH = 25;

__device__ __forceinline__ void run_gemm_bf16(const Ctx& C, const bf16_t* A, const bf16_t* Bt, int N, int K, bf16_t* O) {
    pg8::Gemm g{A, Bt, T_TOK, N, K}; pg8::StaticOrder S; S.init(T_TOK, N, C.G, C.bid);
    pg8::EpiBf16 E{O, N};
    pg8::gemm_phase<pg8::EpiBf16, pg8::StaticOrder, true, true>(C.lds, g, S, E);
}
__device__ __forceinline__ void run_gemm_res(const Ctx& C, const bf16_t* A, const bf16_t* Bt, int K, const float* base) {
    pg8::Gemm g{A, Bt, T_TOK, DM, K}; pg8::StaticOrder S; S.init(T_TOK, DM, C.G, C.bid);
    pg8::EpiRes E{base, C.out, DM};
    pg8::gemm_phase<pg8::EpiRes, pg8::StaticOrder, true, true>(C.lds, g, S, E);
}

__global__ void __launch_bounds__(NTHR, 2) mega_fwd(const Args args) {
    extern __shared__ __attribute__((aligned(16))) unsigned char lds_raw[];
    cg::grid_group grid = cg::this_grid();
    Ctx C;
    C.out = args.out; C.ws = args.ws; C.lds = (LAS unsigned char*)lds_raw; C.ldsg = (char*)lds_raw;
    C.tid = threadIdx.x; C.lane = C.tid & 63; C.wave = __builtin_amdgcn_readfirstlane(C.tid >> 6); C.G = gridDim.x; C.bid = blockIdx.x;
    volatile LAS unsigned* bst = (volatile LAS unsigned*)((LAS unsigned char*)lds_raw + (LDS_BYTES - 64));
    if (threadIdx.x < 2) bst[threadIdx.x] = 0u;
    __syncthreads();
    XcdBarrier xbar; xbar.bar = nullptr; xbar.x = 0; xbar.st = bst;
    if (args.ph_hi - args.ph_lo > 1) xbar = xcd_barrier_post((unsigned*)(args.ws + WS_BAR), bst);
    for (int ph = args.ph_lo; ph < args.ph_hi; ++ph) {
        {
            __attribute__((address_space(1))) unsigned char* w_ = (__attribute__((address_space(1))) unsigned char*)args.ws; __attribute__((address_space(1))) float* o_ = (__attribute__((address_space(1))) float*)args.out; int t_ = threadIdx.x, g_ = gridDim.x, b_ = blockIdx.x;
            unsigned long long ka_ = (unsigned long long)__builtin_amdgcn_kernarg_segment_ptr();
            asm volatile("" : "+s"(w_), "+s"(o_), "+v"(t_), "+s"(g_), "+s"(b_), "+s"(ka_));
            C.ws = (unsigned char*)w_; C.out = (float*)o_; C.a = (const __attribute__((address_space(4))) Args*)ka_; C.G = g_; C.bid = b_; C.tid = t_; C.lane = t_ & 63; C.wave = __builtin_amdgcn_readfirstlane(t_ >> 6);
        }
        unsigned char* ws = C.ws;
        int kind, layer = 0, pass = 0;
        int sub = 0;
        if (ph == 0) { kind = 0; layer = 0; }
        else if (ph == 1) { kind = 1; sub = 0; }
        else if (ph == 2) kind = 2;
        else if (ph == 3) kind = 3;
        else if (ph == 4) { kind = 4; sub = 0; }
        else if (ph == 5) { kind = 5; layer = 0; }
        else if (ph >= 6 && ph <= 8) { layer = 0; const int q = ph - 6; if (q == 2) { kind = 4; sub = 1; } else if (q == 1) kind = 6; else kind = 12; }
        else if (ph == 9) { kind = 0; layer = 1; }
        else if (ph >= 10 && ph <= 19) { layer = 1; const int q = (ph - 10) % 5; pass = (ph - 10) / 5;
            if (q == 0) { kind = (pass == 0) ? 7 : 1; sub = 2; } else if (q == 1) kind = 8; else if (q == 2) kind = 9; else if (q == 3) kind = 10; else { kind = 4; sub = 2; } }
        else if (ph == 20) { kind = 5; layer = 1; }
        else if (ph >= 21 && ph <= 23) { layer = 1; const int q = ph - 21; if (q == 2) { kind = 4; sub = 1; } else if (q == 1) kind = 6; else kind = 12; }
        else kind = 11;

#ifndef PH_MASK
#define PH_MASK 0xFFFF
#endif
#define EN(k) ((PH_MASK >> (k)) & 1)
        const int gw = C.bid * NWAVES + C.wave, NGW = C.G * NWAVES;
        if (kind == 0) { if (EN(0)) {
            if (layer == 0) ph_convert_mixer(C, 0, gw, NGW);
            rms_rows_bf16(layer == 0 ? INP(C, 0) : (const float*)C.out, INP(C, 1) + layer * DM, (bf16_t*)(ws + WS_XN), gw, NGW, C.lane); } }
        else if (kind == 1 || kind == 7) { if (EN(1)) {
            if (kind == 7) ph_ab_small(C);
            const bf16_t* A = (const bf16_t*)(ws + WS_XN); const bf16_t* Bt; int N; bf16_t* O;
            if (sub == 0) { Bt = (const bf16_t*)(ws + WS_W0_IN); N = 2560; O = (bf16_t*)(ws + WS_PROJ); }
            else if (sub == 1) { Bt = (const bf16_t*)(ws + WS_WUP) + (size_t)pass * 2816 * 1024; N = 2816; O = (bf16_t*)(ws + WS_RAWF); }
            else if (sub == 2) { Bt = (const bf16_t*)(ws + WS_WA) + (size_t)pass * 2048 * 1024; N = 2048; O = (bf16_t*)(ws + WS_RAWG); }
            else { Bt = (const bf16_t*)(ws + WS_WZ) + (size_t)pass * 1024 * 1024; N = 1024; O = (bf16_t*)(ws + WS_Z); }
            run_gemm_bf16(C, A, Bt, N, 1024, O);
            if (sub == 0) { int sgw, sngw; if (side_job(C, sgw, sngw)) ph_convert_ffn(C, 0, sgw, sngw); }
        } }
        else if (kind == 2) { if (EN(2)) ph_attn_post(C); }
        else if (kind == 3) { if (EN(3)) ph_attention(C); }
        else if (kind == 4) { if (EN(4)) {
            const bf16_t* A; const bf16_t* Bt; int K; const float* base = C.out;
            if (sub == 0) { A = (const bf16_t*)(ws + WS_AO); Bt = (const bf16_t*)(ws + WS_W0_OUT); K = 1024; base = INP(C, 0); }
            else if (sub == 1) { A = (const bf16_t*)(ws + WS_ACT); Bt = (const bf16_t*)(ws + WS_WDOWN); K = 2816; }
            else { A = (const bf16_t*)(ws + WS_GO); Bt = (const bf16_t*)(ws + WS_WO) + (size_t)pass * 1024 * 1024; K = 1024; }
            run_gemm_res(C, A, Bt, K, base);
        } }
        else if (kind == 5) { if (EN(5)) { rms_rows_bf16(C.out, INP(C, 2) + layer * DM, (bf16_t*)(ws + WS_XN), gw, NGW, C.lane); } }
        else if (kind == 6) { if (EN(6)) ph_ffn_fixup(C, layer); }
        else if (kind == 12) { if (EN(6)) {
            pg8::Gemm g{(const bf16_t*)(ws + WS_XN), (const bf16_t*)(ws + WS_WUP), T_TOK, 5632, 1024}; pg8::StaticOrder S; S.init(T_TOK, 5632, C.G, C.bid);
            pg8::EpiFfn E{(bf16_t*)(ws + WS_ACT), (float*)(ws + WS_EDGE), INP(C, 16) + (size_t)layer * 3 * 5632, INP(C, 17) + (size_t)layer * 5632, 0, (LAS float*)(C.lds + 131072)};
            pg8::gemm_phase<pg8::EpiFfn, pg8::StaticOrder, true, true>(C.lds, g, S, E);
            if (layer == 0) { int sgw, sngw; if (side_job(C, sgw, sngw)) ph_convert_mixer(C, 1, sgw, sngw); } } }
        else if (kind == 8) { if (EN(8)) ph_gdn_prep(C, pass, 0); }
        else if (kind == 9) { if (EN(9)) ph_gdn_scan(C, pass, xbar, pass == 1); }
        else if (kind == 10) { if (EN(10)) {
            pg8::Gemm g{(const bf16_t*)(ws + WS_XN), (const bf16_t*)(ws + WS_WZ) + (size_t)pass * 1024 * 1024, T_TOK, 1024, 1024}; pg8::StaticOrder S; S.init(T_TOK, 1024, C.G, C.bid);
            pg8::EpiGate E{(const bf16_t*)(ws + WS_OF), (const bf16_t*)(ws + WS_OB), (bf16_t*)(ws + WS_GO), INP(C, 13), (LAS float*)(C.lds + 131072)};
            pg8::gemm_phase<pg8::EpiGate, pg8::StaticOrder, true, true>(C.lds, g, S, E); } }
        else rms_rows_f32_inplace(C.out, INP(C, 3), gw, NGW, C.lane);

        if (ph + 1 < args.ph_hi) { if (args.ph_hi > 1000) grid.sync(); else xcd_barrier(xbar); }
#ifdef DBG_XSYNC
        if (ph + 1 < args.ph_hi) { xcd_barrier(xbar); xcd_barrier(xbar); }
#endif
    }
}


#ifdef DBG_DUMP_A
__global__ void dbg_dump(const unsigned short* a, const unsigned short* b, float* out) {
    for (size_t i = (size_t)blockIdx.x * blockDim.x + threadIdx.x; i < (size_t)T_TOK * DM; i += (size_t)gridDim.x * blockDim.x) {
        unsigned short x = a[i], y = b[i]; x &= 0x7fffu; y &= 0x7fffu; if (x > 0x7f00u) x = 0; if (y > 0x7f00u) y = 0;
        float f = __uint_as_float(((unsigned)x) << 16) + __uint_as_float(((unsigned)y) << 16); if (!(f < 1e30f)) f = 1e30f; out[i] = f; }
}
#endif
#ifndef MK_MULTI
#define MK_MULTI 0
#endif
extern "C" void kernel_launch(void* const* d_in, const int* in_sizes, int n_in, void* d_out, int out_size, void* d_ws, size_t ws_size, hipStream_t stream) {
    static int grid = 0;
    if (grid == 0) {
        if (n_in != 19 || out_size != T_TOK * DM || ws_size < WS_END) { fprintf(stderr, "kernel_launch: unexpected shapes (n_in %d out %d ws %zu)\n", n_in, out_size, ws_size); grid = -1; return; }
        int dev = 0, cus = 0, per_cu = 0;
        hipGetDevice(&dev); hipDeviceGetAttribute(&cus, hipDeviceAttributeMultiprocessorCount, dev);
        if (hipFuncSetAttribute((const void*)mega_fwd, hipFuncAttributeMaxDynamicSharedMemorySize, LDS_BYTES) != hipSuccess) { fprintf(stderr, "kernel_launch: hipFuncSetAttribute failed\n"); grid = -1; return; }
        if (hipOccupancyMaxActiveBlocksPerMultiprocessor(&per_cu, (const void*)mega_fwd, NTHR, LDS_BYTES) != hipSuccess || per_cu < 1) { fprintf(stderr, "kernel_launch: occupancy query says %d\n", per_cu); per_cu = 1; }
        (void)hipGetLastError();
        grid = cus * (per_cu > 1 ? 1 : per_cu);
    }
    if (grid < 0) return;
    Args a{};
    for (int i = 0; i < 19; ++i) a.in[i] = (const float*)d_in[i];
    a.out = (float*)d_out; a.ws = (unsigned char*)d_ws;
#if MK_MULTI
#ifndef DBG_STOP
#define DBG_STOP NPH
#endif
#ifndef DBG_REP
#define DBG_REP 0
#endif
    for (int ph = 0; ph < DBG_STOP; ++ph) { a.ph_lo = ph; a.ph_hi = ph + 1; const int nrep = ((DBG_REP >> ph) & 1) ? 3 : 1;
        for (int r = 0; r < nrep; ++r) hipLaunchKernelGGL(mega_fwd, dim3(grid), dim3(NTHR), LDS_BYTES, stream, a); }
#ifdef DBG_DUMP_A
    hipLaunchKernelGGL(dbg_dump, dim3(2048), dim3(256), 0, stream, (const unsigned short*)((char*)d_ws + (size_t)DBG_DUMP_A * MiB), (const unsigned short*)((char*)d_ws + (size_t)DBG_DUMP_B * MiB), (float*)d_out);
#endif
#else
    a.ph_lo = 0; a.ph_hi = NPH;
    if (hipMemsetAsync((char*)d_ws + WS_BAR, 0, XCD_BAR_WORDS * 4, stream) != hipSuccess) { fprintf(stderr, "kernel_launch: memset failed\n"); return; }
    void* kargs[] = {&a};
    hipError_t e = hipLaunchCooperativeKernel((const void*)mega_fwd, dim3(grid), dim3(NTHR), kargs, LDS_BYTES, stream);
    if (e != hipSuccess) fprintf(stderr, "cooperative launch failed: %s (grid %d)\n", hipGetErrorString(e), grid);
#endif
}
```

```cpp
#include <hip/hip_runtime.h>
#include <hip/hip_cooperative_groups.h>
#include <hip/hip_bf16.h>
#include <cstdio>
#include <cstdint>
#include <cmath>
namespace cg = cooperative_groups;
#define MK_MULTI 0

__device__ __forceinline__ int mk_tid() { int t = threadIdx.x; asm volatile("" : "+v"(t)); return t; }
namespace pg8 {
#define PG8_LAS __attribute__((address_space(3)))
typedef unsigned short bf16_t;
typedef short bf16x8 __attribute__((ext_vector_type(8)));
typedef float f32x4 __attribute__((ext_vector_type(4)));
typedef unsigned u32x4 __attribute__((ext_vector_type(4)));
constexpr int BM = 256, BK = 64, HALF = 128, HTB = HALF * BK * 2  , STAGE_BYTES = 8 * HTB, NXCD = 8, WGM = 8;

__host__ __device__ __forceinline__ int lds_byte(int r, int c) { const int st = (r >> 4) * 2 + (c >> 5), rr = r & 15, cc = c & 31, ob = rr * 64 + cc * 2; return st * 1024 + (ob ^ (((ob >> 9) & 1) << 5)); }
__host__ __device__ __forceinline__ void stage_rc(int b, int& R, int& C) { const int st = b / 1024, sb = b % 1024, swz = sb ^ (((sb >> 9) & 1) << 5); R = (st >> 1) * 16 + swz / 64; C = (st & 1) * 32 + (swz % 64) / 2; }
__host__ __device__ __forceinline__ int perm32(int rho) { const int n = rho >> 4, i = rho & 15; return 8 * (i >> 2) + 4 * n + (i & 3); }

struct Unit { int pm, pn; };
struct Gemm { const bf16_t* A; const bf16_t* Bt; int M, N, K; };

struct StaticOrder {
    int nM, nN, nwg, G, c;
    __host__ __device__ void init(int M, int N, int G_, int c_) { nM = M / BM; nN = N / BM; nwg = nM * nN; G = G_; c = c_; }
    __host__ __device__ bool next(int i, Unit& u) const {
        const long L = (long)i * G + c; if (L >= nwg) return false;
        int wgid = (int)L; { const int q = nwg / NXCD, r = nwg % NXCD, xcd = wgid % NXCD, off = wgid / NXCD; wgid = (xcd < r ? xcd * (q + 1) : r * (q + 1) + (xcd - r) * q) + off; }
        const int nig = WGM * nN, gid = wgid / nig, fm = gid * WGM, gsz = (nM - fm) < WGM ? (nM - fm) : WGM;
        u.pm = fm + ((wgid % nig) % gsz); u.pn = (wgid % nig) / gsz; return true;
    }
    __device__ __forceinline__ void a_ready(const Unit&) const {}
    __device__ __forceinline__ void done(const Unit&) const {}
};


typedef float f32x2 __attribute__((ext_vector_type(2)));
typedef __bf16 bf16x2_t __attribute__((ext_vector_type(2)));
__device__ __forceinline__ unsigned cvt_pk_bf16(float lo, float hi) { f32x2 v = {lo, hi}; bf16x2_t r = __builtin_convertvector(v, bf16x2_t); return __builtin_bit_cast(unsigned, r); }

struct EpiBf16 {
    static constexpr bool PERM = true, AFTER_DRAIN = false;
    bf16_t* O; int ldc;
    __device__ __forceinline__ void operator()(const f32x4 (&acc)[2][2][4][2], const Unit& u, int wr, int wc, int fr, int fq) const {
        const int row0 = u.pm * BM + wr * 64 + fr; const int col0 = u.pn * BM + wc * 32 + 8 * fq;
#pragma unroll
        for (int ai = 0; ai < 2; ++ai)
#pragma unroll
            for (int m = 0; m < 4; ++m) { bf16_t* rowp = O + (size_t)(row0 + ai * HALF + m * 16) * ldc + col0;
#pragma unroll
                for (int bj = 0; bj < 2; ++bj) { const f32x4 v0 = acc[ai][bj][m][0], v1 = acc[ai][bj][m][1];
                    u32x4 w; w.x = cvt_pk_bf16(v0[0], v0[1]); w.y = cvt_pk_bf16(v0[2], v0[3]); w.z = cvt_pk_bf16(v1[0], v1[1]); w.w = cvt_pk_bf16(v1[2], v1[3]);
                    *(u32x4*)(rowp + bj * HALF) = w; } }
    }
};
struct EpiF32 {
    static constexpr bool PERM = true, AFTER_DRAIN = false;
    float* O; int ldc;
    __device__ __forceinline__ void operator()(const f32x4 (&acc)[2][2][4][2], const Unit& u, int wr, int wc, int fr, int fq) const {
        const int row0 = u.pm * BM + wr * 64 + fr; const int col0 = u.pn * BM + wc * 32 + 8 * fq;
#pragma unroll
        for (int ai = 0; ai < 2; ++ai)
#pragma unroll
            for (int m = 0; m < 4; ++m) { float* rowp = O + (size_t)(row0 + ai * HALF + m * 16) * ldc + col0;
#pragma unroll
                for (int bj = 0; bj < 2; ++bj) { *(f32x4*)(rowp + bj * HALF) = acc[ai][bj][m][0]; *(f32x4*)(rowp + bj * HALF + 4) = acc[ai][bj][m][1]; } }
    }
};
struct EpiRes {
    static constexpr bool PERM = false, AFTER_DRAIN = false;
    const float* base; float* out; int ldc;
    __device__ __forceinline__ void operator()(const f32x4 (&acc)[2][2][4][2], const Unit& u, int wr, int wc, int fr, int fq) const {
        const int row0 = u.pm * BM + wr * 64 + fr; const int col0 = u.pn * BM + wc * 32 + 4 * fq;
#pragma unroll
        for (int ai = 0; ai < 2; ++ai)
#pragma unroll
            for (int m = 0; m < 4; ++m) { const size_t off = (size_t)(row0 + ai * HALF + m * 16) * ldc + col0;
#pragma unroll
                for (int bj = 0; bj < 2; ++bj)
#pragma unroll
                    for (int n = 0; n < 2; ++n) { const f32x4 b = *(const f32x4*)(base + off + bj * HALF + n * 16); *(f32x4*)(out + off + bj * HALF + n * 16) = b + acc[ai][bj][m][n]; } }
    }
};

struct EpiGate {
    static constexpr bool PERM = true, AFTER_DRAIN = false;
    const bf16_t* OF; const bf16_t* OB; bf16_t* GO; const float* gain; PG8_LAS float* tab;
    __device__ __forceinline__ void operator()(const f32x4 (&acc)[2][2][4][2], const Unit& u, int wr, int wc, int fr, int fq) const {
        const int tid = mk_tid();
        {
            const int row = tid >> 1, hd = tid & 1; const size_t off = (size_t)(u.pm * BM + row) * 2048 + u.pn * BM + hd * HALF;
            float ss = 0.f;
#pragma unroll 4
            for (int j = 0; j < 16; ++j) { const u32x4 a = *(const u32x4*)(OF + off + 8 * j), b = *(const u32x4*)(OB + off + 8 * j);
#pragma unroll
                for (int q = 0; q < 4; ++q) { const float lo = __uint_as_float(a[q] << 16) + __uint_as_float(b[q] << 16), hi = __uint_as_float(a[q] & 0xffff0000u) + __uint_as_float(b[q] & 0xffff0000u); ss += lo * lo + hi * hi; } }
            tab[row * 2 + hd] = rsqrtf(ss * (1.f / 128.f) + 1e-6f);
        }
        asm volatile("s_waitcnt lgkmcnt(0)" ::: "memory"); __builtin_amdgcn_s_barrier(); asm volatile("" ::: "memory");
        const int row0 = wr * 64 + fr; const int colw = wc * 32 + 8 * fq;
        f32x4 g0 = *(const f32x4*)(gain + colw), g1 = *(const f32x4*)(gain + colw + 4);
#pragma unroll
        for (int ai = 0; ai < 2; ++ai)
#pragma unroll
            for (int m = 0; m < 4; ++m) { const int rt = row0 + ai * HALF + m * 16;
#pragma unroll
                for (int bj = 0; bj < 2; ++bj) { const size_t off = (size_t)(u.pm * BM + rt) * 1024 + u.pn * BM + bj * HALF + colw, offo = off + (size_t)(u.pm * BM + rt) * 1024;
                    const float rs = tab[rt * 2 + bj];
                    const u32x4 a = *(const u32x4*)(OF + offo), b = *(const u32x4*)(OB + offo);
                    const f32x4 z0 = acc[ai][bj][m][0], z1 = acc[ai][bj][m][1];
                    float o[8];
#pragma unroll
                    for (int q = 0; q < 4; ++q) { o[2 * q] = __uint_as_float(a[q] << 16) + __uint_as_float(b[q] << 16); o[2 * q + 1] = __uint_as_float(a[q] & 0xffff0000u) + __uint_as_float(b[q] & 0xffff0000u); }
#pragma unroll
                    for (int e = 0; e < 4; ++e) { o[e] = o[e] * rs * g0[e] * (z0[e] / (1.f + __expf(-z0[e]))); o[4 + e] = o[4 + e] * rs * g1[e] * (z1[e] / (1.f + __expf(-z1[e]))); }
                    u32x4 w; w.x = cvt_pk_bf16(o[0], o[1]); w.y = cvt_pk_bf16(o[2], o[3]); w.z = cvt_pk_bf16(o[4], o[5]); w.w = cvt_pk_bf16(o[6], o[7]);
                    *(u32x4*)(GO + off) = w; }
                asm volatile("" ::: "memory"); }
        asm volatile("s_waitcnt lgkmcnt(0)" ::: "memory"); __builtin_amdgcn_s_barrier(); asm volatile("" ::: "memory");
    }
};

typedef unsigned u32x2 __attribute__((ext_vector_type(2)));
__device__ __forceinline__ float dpp_ror1(float v)  { return __int_as_float(__builtin_amdgcn_update_dpp(0, __float_as_int(v), 0x121, 0xF, 0xF, false)); }
__device__ __forceinline__ float dpp_ror15(float v) { return __int_as_float(__builtin_amdgcn_update_dpp(0, __float_as_int(v), 0x12F, 0xF, 0xF, false)); }
struct EpiFfn {
    static constexpr bool PERM = true, AFTER_DRAIN = false;
    bf16_t* ACT; float* EDGE; const float* cw; const float* cb; int chan0; PG8_LAS float* bt;
    __device__ __forceinline__ void operator()(const f32x4 (&acc)[2][2][4][2], const Unit& u, int wr, int wc, int fr, int fq) const {
        const int chl = wc * 32 + 8 * fq;
        const int cha = chan0 + u.pn * 128 + chl, chb = 2816 + cha;
        PG8_LAS float* wt = bt + 2048;
        { const int t = mk_tid(); if (t < 256) { const int ch = (t < 128) ? (chan0 + u.pn * 128 + t) : (2816 + chan0 + u.pn * 128 + (t - 128));
            wt[t] = cw[ch]; wt[256 + t] = cw[5632 + ch]; wt[512 + t] = cw[2 * 5632 + ch]; wt[768 + t] = cb[ch]; } }
#pragma unroll
        for (int ai = 0; ai < 2; ++ai) { const int beta = 2 * ai + wr;
#pragma unroll
            for (int bj = 0; bj < 2; ++bj)
#pragma unroll
                for (int n = 0; n < 2; ++n) { const int col = 128 * bj + chl + 4 * n;
                    if (fr == 0)  *(PG8_LAS f32x4*)(bt + (2 * beta) * 256 + col) = acc[ai][bj][0][n];
                    if (fr == 15) *(PG8_LAS f32x4*)(bt + (2 * beta + 1) * 256 + col) = acc[ai][bj][3][n];
                    float* eg = EDGE + (size_t)((u.pm * 22 + u.pn) * 4) * 256 + col;
                    if (beta == 0 && fr < 2)  *(f32x4*)(eg + fr * 256) = acc[ai][bj][0][n];
                    if (beta == 3 && fr >= 14) *(f32x4*)(eg + (fr - 12) * 256) = acc[ai][bj][3][n]; } }
        asm volatile("s_waitcnt lgkmcnt(0)" ::: "memory"); __builtin_amdgcn_s_barrier(); asm volatile("" ::: "memory");
#pragma unroll
        for (int n = 0; n < 2; ++n) {
            f32x4 tp[2][4];
#pragma unroll
            for (int bj = 0; bj < 2; ++bj)
#pragma unroll
                for (int s = 0; s < 4; ++s) tp[bj][s] = *(const PG8_LAS f32x4*)(wt + s * 256 + 128 * bj + chl + 4 * n);
#pragma unroll
            for (int ai = 0; ai < 2; ++ai) { const int beta = 2 * ai + wr;
#pragma unroll
                for (int m = 0; m < 4; ++m) {
                    const int trow = 128 * ai + 64 * wr + 16 * m + fr;
                    f32x4 yy[2];
#pragma unroll
                    for (int bj = 0; bj < 2; ++bj) {
                        const f32x4 cur = acc[ai][bj][m][n]; f32x4 pv, nx;
                        const int col = 128 * bj + chl + 4 * n;
                        f32x4 pe, ne;
                        if (m > 0) { const f32x4 t = acc[ai][bj][m > 0 ? m - 1 : 0][n]; pe = (f32x4){dpp_ror1(t[0]), dpp_ror1(t[1]), dpp_ror1(t[2]), dpp_ror1(t[3])}; }
                        else pe = (beta > 0) ? *(const PG8_LAS f32x4*)(bt + (2 * (beta - 1) + 1) * 256 + col) : (f32x4){0.f, 0.f, 0.f, 0.f};
                        if (m < 3) { const f32x4 t = acc[ai][bj][m < 3 ? m + 1 : 3][n]; ne = (f32x4){dpp_ror15(t[0]), dpp_ror15(t[1]), dpp_ror15(t[2]), dpp_ror15(t[3])}; }
                        else ne = (beta < 3) ? *(const PG8_LAS f32x4*)(bt + (2 * (beta + 1)) * 256 + col) : (f32x4){0.f, 0.f, 0.f, 0.f};
#pragma unroll
                        for (int e = 0; e < 4; ++e) {
                            pv[e] = __int_as_float(__builtin_amdgcn_update_dpp(__float_as_int(pe[e]), __float_as_int(cur[e]), 0x111, 0xF, 0xF, false));
                            nx[e] = __int_as_float(__builtin_amdgcn_update_dpp(__float_as_int(ne[e]), __float_as_int(cur[e]), 0x101, 0xF, 0xF, false)); }
                        yy[bj] = tp[bj][0] * pv + tp[bj][1] * cur + tp[bj][2] * nx + tp[bj][3];
                    }
                    float o[4];
#pragma unroll
                    for (int e = 0; e < 4; ++e) o[e] = yy[0][e] * __builtin_amdgcn_rcpf(1.f + __expf(-yy[0][e])) * yy[1][e];
                    if (trow != 0 && trow != 255) { u32x2 w; w.x = cvt_pk_bf16(o[0], o[1]); w.y = cvt_pk_bf16(o[2], o[3]);
                        *(u32x2*)(ACT + (size_t)(u.pm * BM + trow) * 2816 + cha + 4 * n) = w; }
                } }
        }
        asm volatile("s_waitcnt lgkmcnt(0)" ::: "memory"); __builtin_amdgcn_s_barrier(); asm volatile("" ::: "memory");
    }
};

template <class Epi, class Sched, bool ALIGN_EPI = false, bool SP2 = false>
__device__ __forceinline__ void gemm_phase(PG8_LAS unsigned char* lds, const Gemm g, const Sched& S, const Epi& E) {
    const int tid = mk_tid(), wid = __builtin_amdgcn_readfirstlane(tid >> 6), lane = tid & 63, wr = wid >> 2, wc = wid & 3, fr = lane & 15, fq = lane >> 4;
    const int K = g.K, nt = K / BK;
    unsigned voffA[2], voffB[2];
#pragma unroll
    for (int i = 0; i < 2; ++i) { int R, C; stage_rc(tid * 16 + i * 8192, R, C); const int Rb = Epi::PERM ? ((R & ~31) + perm32(R & 31)) : R;
        voffA[i] = (unsigned)(R * K + C) * 2u; voffB[i] = (unsigned)(Rb * K + C) * 2u; }
    const size_t kstep = (size_t)(BK * 2);
    const size_t hstep = (size_t)HALF * K * 2;
    const size_t tstep = 2 * hstep;
    const unsigned ldsw = (unsigned)wid * 1024u;
    const int aoff = lds_byte(wr * 64 + fr, fq * 8), boff = lds_byte(wc * 32 + fr, fq * 8);
#define PG8_SA(b, h) (((b) * 2 + (h)) * HTB)
#define PG8_SB(b, h) ((4 + (b) * 2 + (h)) * HTB)
#define PG8_STAGE(bufoff, gbase, voff) do { _Pragma("unroll") for (int _i = 0; _i < 2; ++_i) \
        __builtin_amdgcn_global_load_lds((const unsigned*)((const char*)(gbase) + (voff)[_i]), (PG8_LAS unsigned*)(lds + (bufoff) + ldsw + _i * 8192), 16, 0, 0); } while (0)
#define PG8_LDA(dst, b, h) do { _Pragma("unroll") for (int m = 0; m < 4; ++m) _Pragma("unroll") for (int k = 0; k < 2; ++k) dst[m][k] = *(const PG8_LAS bf16x8*)(lds + PG8_SA(b, h) + aoff + m * 2048 + k * 1024); } while (0)
#define PG8_LDB(dst, b, h) do { _Pragma("unroll") for (int n = 0; n < 2; ++n) _Pragma("unroll") for (int k = 0; k < 2; ++k) dst[n][k] = *(const PG8_LAS bf16x8*)(lds + PG8_SB(b, h) + boff + n * 2048 + k * 1024); } while (0)
#define PG8_MMA(ai, bj, At, Bt) do { __builtin_amdgcn_s_setprio(1); _Pragma("unroll") for (int m = 0; m < 4; ++m) _Pragma("unroll") for (int n = 0; n < 2; ++n) _Pragma("unroll") for (int k = 0; k < 2; ++k) \
        acc[ai][bj][m][n] = __builtin_amdgcn_mfma_f32_16x16x32_bf16(Bt[n][k], At[m][k], acc[ai][bj][m][n], 0, 0, 0); __builtin_amdgcn_s_setprio(0); } while (0)
#define PG8_WAIT_V(n) asm volatile("s_waitcnt vmcnt(" #n ")" ::: "memory")
#define PG8_WAIT_L(n) asm volatile("s_waitcnt lgkmcnt(" #n ")" ::: "memory")
#define PG8_BAR __builtin_amdgcn_s_barrier()
#define PG8_SCHED __builtin_amdgcn_sched_barrier(0)
    Unit cur, nxt; int ui = 0;
    if (!S.next(0, cur)) return;
    f32x4 acc[2][2][4][2];
    float zr_ = 0.f; asm volatile("" : "+v"(zr_));
#pragma unroll
    for (int a = 0; a < 2; ++a)
#pragma unroll
        for (int b = 0; b < 2; ++b)
#pragma unroll
            for (int m = 0; m < 4; ++m)
#pragma unroll
                for (int n = 0; n < 2; ++n) acc[a][b][m][n] = (f32x4){zr_, zr_, zr_, zr_};
    bf16x8 At[4][2], B0[2][2], B1[2][2];
    const char* cA = (const char*)g.A + (size_t)cur.pm * tstep; const char* cB = (const char*)g.Bt + (size_t)cur.pn * tstep;
    S.a_ready(cur);
    if constexpr (SP2) {
        PG8_STAGE(PG8_SB(0, 0), cB, voffB); PG8_STAGE(PG8_SB(0, 1), cB + hstep, voffB); PG8_STAGE(PG8_SA(0, 0), cA, voffA); PG8_STAGE(PG8_SA(0, 1), cA + hstep, voffA);
        if (wr == 1) PG8_BAR;
        PG8_WAIT_V(2); PG8_BAR;
        PG8_STAGE(PG8_SB(1, 0), cB + kstep, voffB); PG8_STAGE(PG8_SA(1, 0), cA + kstep, voffA); PG8_STAGE(PG8_SB(1, 1), cB + hstep + kstep, voffB);
        PG8_WAIT_V(6); PG8_BAR;
    } else {
        PG8_STAGE(PG8_SB(0, 0), cB, voffB); PG8_STAGE(PG8_SA(0, 0), cA, voffA); PG8_STAGE(PG8_SB(0, 1), cB + hstep, voffB); PG8_STAGE(PG8_SA(0, 1), cA + hstep, voffA);
        if (wr == 1) PG8_BAR;
        PG8_WAIT_V(4); PG8_BAR;
        PG8_STAGE(PG8_SB(1, 0), cB + kstep, voffB); PG8_STAGE(PG8_SA(1, 0), cA + kstep, voffA); PG8_STAGE(PG8_SB(1, 1), cB + hstep + kstep, voffB);
        PG8_WAIT_V(6); PG8_BAR;
    }
    for (;;) {
        const bool has_next = S.next(ui + 1, nxt);
        const char* nA = has_next ? (const char*)g.A + (size_t)nxt.pm * tstep : cA; const char* nB = has_next ? (const char*)g.Bt + (size_t)nxt.pn * tstep : cB;
        for (int t = 0; t < nt; t += 2) {
            const bool last = (t == nt - 2);
            const char* a1 = cA + (size_t)(t + 1) * kstep;
            const char* a2 = last ? nA : cA + (size_t)(t + 2) * kstep; const char* b2 = last ? nB : cB + (size_t)(t + 2) * kstep;
            const char* a3 = a2 + kstep; const char* b3 = b2 + kstep;
            if (last && has_next) S.a_ready(nxt);
            if constexpr (SP2) {
            PG8_LDB(B0, 0, 0); PG8_LDB(B1, 0, 1); PG8_SCHED; PG8_LDA(At, 0, 0); PG8_STAGE(PG8_SA(1, 1), a1 + hstep, voffA);
            PG8_WAIT_V(8); PG8_WAIT_L(0); PG8_BAR; PG8_MMA(0, 0, At, B0); PG8_MMA(0, 1, At, B1); PG8_BAR; PG8_SCHED;
            PG8_LDA(At, 0, 1); PG8_STAGE(PG8_SB(0, 0), b2, voffB); PG8_STAGE(PG8_SB(0, 1), b2 + hstep, voffB); PG8_STAGE(PG8_SA(0, 0), a2, voffA);
            PG8_WAIT_V(8); PG8_WAIT_L(0); PG8_BAR; PG8_MMA(1, 0, At, B0); PG8_MMA(1, 1, At, B1); PG8_BAR; PG8_SCHED;
            PG8_LDB(B0, 1, 0); PG8_LDB(B1, 1, 1); PG8_SCHED; PG8_LDA(At, 1, 0); PG8_STAGE(PG8_SA(0, 1), a2 + hstep, voffA);
            PG8_WAIT_V(8); PG8_WAIT_L(0); PG8_BAR; PG8_MMA(0, 0, At, B0); PG8_MMA(0, 1, At, B1); PG8_BAR; PG8_SCHED;
            PG8_LDA(At, 1, 1); PG8_STAGE(PG8_SB(1, 0), b3, voffB); PG8_STAGE(PG8_SB(1, 1), b3 + hstep, voffB); PG8_STAGE(PG8_SA(1, 0), a3, voffA);
            PG8_WAIT_V(8); PG8_WAIT_L(0); PG8_BAR; PG8_MMA(1, 0, At, B0); PG8_MMA(1, 1, At, B1); PG8_BAR; PG8_SCHED;
            } else {
            PG8_LDB(B0, 0, 0); PG8_SCHED; PG8_LDA(At, 0, 0); PG8_STAGE(PG8_SA(1, 1), a1 + hstep, voffA);
            PG8_WAIT_L(8); PG8_BAR; PG8_WAIT_L(0); PG8_MMA(0, 0, At, B0); PG8_BAR; PG8_SCHED;
            PG8_LDB(B1, 0, 1); PG8_STAGE(PG8_SB(0, 0), b2, voffB);
            PG8_BAR; PG8_WAIT_L(0); PG8_MMA(0, 1, At, B1); PG8_BAR;
            PG8_LDA(At, 0, 1); PG8_STAGE(PG8_SA(0, 0), a2, voffA);
            PG8_BAR; PG8_WAIT_L(0); PG8_MMA(1, 0, At, B0); PG8_BAR; PG8_SCHED;
            PG8_STAGE(PG8_SB(0, 1), b2 + hstep, voffB);
            PG8_WAIT_V(6); PG8_BAR; PG8_MMA(1, 1, At, B1); PG8_BAR;
            PG8_LDB(B0, 1, 0); PG8_SCHED; PG8_LDA(At, 1, 0); PG8_STAGE(PG8_SA(0, 1), a2 + hstep, voffA);
            PG8_WAIT_L(8); PG8_BAR; PG8_WAIT_L(0); PG8_MMA(0, 0, At, B0); PG8_BAR; PG8_SCHED;
            PG8_LDB(B1, 1, 1); PG8_STAGE(PG8_SB(1, 0), b3, voffB);
            PG8_BAR; PG8_WAIT_L(0); PG8_MMA(0, 1, At, B1); PG8_BAR;
            PG8_LDA(At, 1, 1); PG8_STAGE(PG8_SA(1, 0), a3, voffA);
            PG8_BAR; PG8_WAIT_L(0); PG8_MMA(1, 0, At, B0); PG8_BAR; PG8_SCHED;
            PG8_STAGE(PG8_SB(1, 1), b3 + hstep, voffB);
            PG8_WAIT_V(6); PG8_BAR; PG8_MMA(1, 1, At, B1); PG8_BAR;
            }
        }
        if constexpr (ALIGN_EPI) { if (wr == 0) PG8_BAR; }
        if constexpr (!Epi::AFTER_DRAIN) { E(acc, cur, wr, wc, fr, fq); S.done(cur); }
        if (!has_next) break;
#pragma unroll
        for (int a = 0; a < 2; ++a)
#pragma unroll
            for (int b = 0; b < 2; ++b)
#pragma unroll
                for (int m = 0; m < 4; ++m)
#pragma unroll
                    for (int n = 0; n < 2; ++n) acc[a][b][m][n] = (f32x4){zr_, zr_, zr_, zr_};
        cur = nxt; cA = nA; cB = nB; ++ui;
        if constexpr (ALIGN_EPI) { if (wr == 1) PG8_BAR; }
    }
    PG8_WAIT_V(0);
    if constexpr (!ALIGN_EPI) { if (wr == 0) PG8_BAR; }
    PG8_BAR;
    if constexpr (Epi::AFTER_DRAIN) { E.fused(acc, cur, wr, wc, fr, fq, lds, wid, lane); S.done(cur); }
#undef PG8_SA
#undef PG8_SB
#undef PG8_STAGE
#undef PG8_LDA
#undef PG8_LDB
#undef PG8_MMA
#undef PG8_WAIT_V
#undef PG8_WAIT_L
#undef PG8_BAR
#undef PG8_SCHED
}
}

namespace attn {
using bf16 = __hip_bfloat16;
constexpr int   D = 128, NW = 8, QBLK = 32, KVBLK = 64;
constexpr float SCALE = 0.088388347648318440f;
constexpr float THR = 8.f;
constexpr int SDEPTH = 2;
constexpr int LDQ = 2560, LDK = 2560, LDO = 1024;
constexpr size_t SHM_V = KVBLK * D * 2, SHM_K = KVBLK * D * 2, SHM_ATTN = 2 * SHM_V + 2 * SHM_K + NW * 64 * 4;
using bf16x8 = __attribute__((ext_vector_type(8))) short;
using s16x4  = __attribute__((ext_vector_type(4))) short;
using f32x16 = __attribute__((ext_vector_type(16))) float;
using f32x8  = __attribute__((ext_vector_type(8))) float;
using u32x4  = __attribute__((ext_vector_type(4))) unsigned;
#define KSWZ(row, colB) ((row) * 256 + ((colB) ^ (((row) & 7) << 4)))
#define SBAR() __builtin_amdgcn_sched_barrier(0)
__device__ __forceinline__ int crow(int r, int hi) { return (r & 3) + 8 * (r >> 2) + 4 * hi; }
__device__ __forceinline__ unsigned cvtpk(float lo, float hi) {
  unsigned r; asm volatile("v_cvt_pk_bf16_f32 %0, %1, %2" : "=v"(r) : "v"(lo), "v"(hi)); return r;
}
template <typename TIn> struct Stage;
template <> struct Stage<bf16>  { using T = bf16x8;
  __device__ static __forceinline__ T ld8(const bf16* p) { return *reinterpret_cast<const bf16x8*>(p); }
  __device__ static __forceinline__ bf16x8 tobf(T x) { return x; } };
template <> struct Stage<float> { using T = f32x8;
  __device__ static __forceinline__ T ld8(const float* p) { return *reinterpret_cast<const f32x8*>(p); }
  __device__ static __forceinline__ bf16x8 tobf(T x) {
    u32x4 w = {cvtpk(x[0], x[1]), cvtpk(x[2], x[3]), cvtpk(x[4], x[5]), cvtpk(x[6], x[7])}; return *reinterpret_cast<bf16x8*>(&w); } };

__device__ __forceinline__ void partialSM(f32x16& p0, f32x16& p1, float& m_reg, float& mn, float& alpha) {
  constexpr float C = SCALE * 1.4426950408889634f;
  float pmax = p0[0]; for (int r = 1; r < 16; ++r) pmax = fmaxf(pmax, p0[r]); for (int r = 0; r < 16; ++r) pmax = fmaxf(pmax, p1[r]);
  { auto rr = __builtin_amdgcn_permlane32_swap(__float_as_uint(pmax), __float_as_uint(pmax), false, false);
    pmax = fmaxf(__uint_as_float(rr[0]), __uint_as_float(rr[1])); }
  if (__builtin_expect(__all(pmax - m_reg <= THR / SCALE), 1)) { mn = m_reg; alpha = 1.f; }
  else { mn = fmaxf(m_reg, pmax); alpha = __builtin_amdgcn_exp2f((m_reg - mn) * C); m_reg = mn; }
  float mnC = -mn * C;
  for (int r = 0; r < 16; ++r) p0[r] = fmaf(p0[r], C, mnC); for (int r = 0; r < 16; ++r) p1[r] = fmaf(p1[r], C, mnC);
  for (int r = 0; r < 16; ++r) p0[r] = __builtin_amdgcn_exp2f(p0[r]);
}
__device__ __forceinline__ void finishSM(f32x16& p0, f32x16& p1, float alpha, float& l_reg, bf16x8& pa0, bf16x8& pa1, bf16x8& pa2, bf16x8& pa3) {
  for (int r = 0; r < 16; ++r) p1[r] = __builtin_amdgcn_exp2f(p1[r]);
  float ps = 0; for (int r = 0; r < 16; ++r) ps += p0[r]; for (int r = 0; r < 16; ++r) ps += p1[r];
  { auto rr = __builtin_amdgcn_permlane32_swap(__float_as_uint(ps), __float_as_uint(ps), false, false);
    ps = __uint_as_float(rr[0]) + __uint_as_float(rr[1]); }
  l_reg = l_reg * alpha + ps;
#define PK4(P, BASE, OUT) do { unsigned a0 = cvtpk(P[BASE + 0], P[BASE + 1]), a1 = cvtpk(P[BASE + 2], P[BASE + 3]);   \
    unsigned b0 = cvtpk(P[BASE + 4], P[BASE + 5]), b1 = cvtpk(P[BASE + 6], P[BASE + 7]);                              \
    auto r0 = __builtin_amdgcn_permlane32_swap(a0, b0, false, false); auto r1 = __builtin_amdgcn_permlane32_swap(a1, b1, false, false); \
    u32x4 w = {r0[0], r1[0], r0[1], r1[1]}; OUT = *reinterpret_cast<bf16x8*>(&w); } while (0)
  PK4(p0, 0, pa0); PK4(p0, 8, pa1); PK4(p1, 0, pa2); PK4(p1, 8, pa3);
#undef PK4
}
__device__ __forceinline__ void qkt(f32x16& p0, f32x16& p1, const bf16* Ks, const bf16x8* qr, int r32, int hi) {
  p0 = f32x16{}; p1 = f32x16{};
  for (int d0 = 0; d0 < 8; ++d0) { int cb = (d0 * 16 + hi * 8) * 2;
    bf16x8 b0 = *reinterpret_cast<const bf16x8*>((const char*)Ks + KSWZ(r32, cb));
    bf16x8 b1 = *reinterpret_cast<const bf16x8*>((const char*)Ks + KSWZ(32 + r32, cb));
    p0 = __builtin_amdgcn_mfma_f32_32x32x16_bf16(b0, qr[d0], p0, 0, 0, 0);
    p1 = __builtin_amdgcn_mfma_f32_32x32x16_bf16(b1, qr[d0], p1, 0, 0, 0); }
}
__device__ __forceinline__ int v_st(int k, int c) { const int kk = (k & ~0xC) | ((k & 4) << 1) | ((k & 8) >> 1); return ((kk >> 3) * 4 + (c >> 5)) * 512 + ((kk & 7) * 32 + (c & 31)) * 2; }
__device__ __forceinline__ int v_rd_base(int lane) { return ((lane & 3) << 3) | (((lane >> 2) & 3) << 6) | (((lane >> 4) & 1) << 5) | (((lane >> 5) & 1) << 8); }
constexpr int v_rd_off(int d0, int ks, int half) { return d0 * 512 + ks * 4096 + half * 2048; }
template <int OFF> __device__ __forceinline__ s16x4 tr_read(int vb) {
  s16x4 r; asm volatile("ds_read_b64_tr_b16 %0, %1 offset:%2" : "=&v"(r) : "v"(vb), "i"(OFF) : "memory"); return r;
}
template <int D0> __device__ __forceinline__ void pv_one(f32x16& od, int vb, bf16x8 pa0, bf16x8 pa1, bf16x8 pa2, bf16x8 pa3) {
  const s16x4 l0 = tr_read<v_rd_off(D0, 0, 0)>(vb), h0 = tr_read<v_rd_off(D0, 0, 1)>(vb), l1 = tr_read<v_rd_off(D0, 1, 0)>(vb), h1 = tr_read<v_rd_off(D0, 1, 1)>(vb);
  const s16x4 l2 = tr_read<v_rd_off(D0, 2, 0)>(vb), h2 = tr_read<v_rd_off(D0, 2, 1)>(vb), l3 = tr_read<v_rd_off(D0, 3, 0)>(vb), h3 = tr_read<v_rd_off(D0, 3, 1)>(vb);
  asm volatile("s_waitcnt lgkmcnt(0)" ::: "memory"); SBAR();
#define PK(L, H) (bf16x8){L[0], L[1], L[2], L[3], H[0], H[1], H[2], H[3]}
  od = __builtin_amdgcn_mfma_f32_32x32x16_bf16(pa0, PK(l0, h0), od, 0, 0, 0);
  od = __builtin_amdgcn_mfma_f32_32x32x16_bf16(pa1, PK(l1, h1), od, 0, 0, 0);
  od = __builtin_amdgcn_mfma_f32_32x32x16_bf16(pa2, PK(l2, h2), od, 0, 0, 0);
  od = __builtin_amdgcn_mfma_f32_32x32x16_bf16(pa3, PK(l3, h3), od, 0, 0, 0);
#undef PK
}
__device__ __forceinline__ void pv_d0(f32x16* o, int vb, bf16x8 pa0, bf16x8 pa1, bf16x8 pa2, bf16x8 pa3) {
  pv_one<0>(o[0], vb, pa0, pa1, pa2, pa3); pv_one<1>(o[1], vb, pa0, pa1, pa2, pa3); pv_one<2>(o[2], vb, pa0, pa1, pa2, pa3); pv_one<3>(o[3], vb, pa0, pa1, pa2, pa3);
}

__device__ __forceinline__ void attn_dense_body(const bf16* __restrict__ Qb, const bf16* __restrict__ Kh, const bf16* __restrict__ Vh,
                                                const unsigned short* __restrict__ Gb, unsigned short* __restrict__ Ob, int seq, char* lds) {
  using TQ = bf16; using St = Stage<bf16>; using SQ = Stage<TQ>;
  const int tid = mk_tid(), wid = __builtin_amdgcn_readfirstlane(tid >> 6), lane = tid & 63, r32 = lane & 31, hi = lane >> 5;
  bf16* V_lds = (bf16*)lds; bf16* K_lds = (bf16*)(lds + 2 * SHM_V);
  float* ws = (float*)(lds + 2 * SHM_V + 2 * SHM_K) + wid * 64; float* li_l = ws; float* al_l = ws + 32;
  float m_reg = -1e30f, l_reg = 0; f32x16 o[4] = {}; bf16x8 qr[8];
  const TQ* Qw = Qb + (long)(wid * QBLK + r32) * LDQ + hi * 8;
#pragma unroll
  for (int d0 = 0; d0 < 8; ++d0) qr[d0] = SQ::tobf(SQ::ld8(Qw + d0 * 16));
  const int sr = tid >> 4, sc = (tid & 15) * 8, vst0 = v_st(sr, sc), vst1 = v_st(32 + sr, sc);
  const int vb0 = (int)(uintptr_t)V_lds + v_rd_base(lane);
  struct { typename St::T vs0, vs1, ks0, ks1; } sr_[SDEPTH];
#define SLOAD(i, k0) do { sr_[i].vs0 = St::ld8(&Vh[(long)((k0) + sr) * LDK + sc]); sr_[i].vs1 = St::ld8(&Vh[(long)((k0) + 32 + sr) * LDK + sc]); \
    sr_[i].ks0 = St::ld8(&Kh[(long)((k0) + sr) * LDK + sc]); sr_[i].ks1 = St::ld8(&Kh[(long)((k0) + 32 + sr) * LDK + sc]); } while (0)
#define SWRITE(b, i) do { *(bf16x8*)((char*)V_lds + (b) * SHM_V + vst0) = St::tobf(sr_[i].vs0);          \
    *(bf16x8*)((char*)V_lds + (b) * SHM_V + vst1) = St::tobf(sr_[i].vs1); int kc = sc * 2;               \
    *(bf16x8*)((char*)K_lds + (b) * SHM_K + KSWZ(sr, kc)) = St::tobf(sr_[i].ks0);                       \
    *(bf16x8*)((char*)K_lds + (b) * SHM_K + KSWZ(32 + sr, kc)) = St::tobf(sr_[i].ks1); } while (0)
#define SWAIT() do { if constexpr (SDEPTH == 2) asm volatile("s_waitcnt vmcnt(4)" ::: "memory"); else asm volatile("s_waitcnt vmcnt(0)" ::: "memory"); } while (0)
#define RESC(a) do { if (__any((a) < 1.f)) { if (hi == 0) al_l[r32] = (a); asm volatile("s_waitcnt lgkmcnt(0)" ::: "memory"); \
    for (int d = 0; d < 4; ++d) for (int r = 0; r < 16; ++r) o[d][r] *= al_l[crow(r, hi)]; } } while (0)
  f32x16 pA0, pA1, pB0, pB1; float mnA, mnB, alA, alB; bf16x8 pa0, pa1, pa2, pa3; const int NT = seq / KVBLK;
  constexpr int SE = 0, SO = SDEPTH - 1;
  SLOAD(SE, 0); asm volatile("s_waitcnt vmcnt(0)" ::: "memory"); SWRITE(0, SE); __syncthreads();
  qkt(pA0, pA1, K_lds, qr, r32, hi); partialSM(pA0, pA1, m_reg, mnA, alA);
  SLOAD(SO, KVBLK); if constexpr (SDEPTH == 2) { if (2 < NT) SLOAD(SE, 2 * KVBLK); }
  SWAIT(); SWRITE(1, SO); __syncthreads();
  for (int j = 1; j + 1 < NT; j += 2) {
    SBAR(); qkt(pB0, pB1, (bf16*)((char*)K_lds + SHM_K), qr, r32, hi);
    finishSM(pA0, pA1, alA, l_reg, pa0, pa1, pa2, pa3); SBAR();
    SLOAD(SO, (j + SDEPTH) * KVBLK); SBAR();
    pv_d0(o, vb0, pa0, pa1, pa2, pa3); partialSM(pB0, pB1, m_reg, mnB, alB);
    __syncthreads(); SWAIT(); SWRITE(0, SE);
    RESC(alB); __syncthreads();
    SBAR(); qkt(pA0, pA1, K_lds, qr, r32, hi);
    finishSM(pB0, pB1, alB, l_reg, pa0, pa1, pa2, pa3); SBAR();
    if (SDEPTH == 1 || j + 3 < NT) SLOAD(SE, (j + 1 + SDEPTH) * KVBLK); SBAR();
    pv_d0(o, vb0 + (int)SHM_V, pa0, pa1, pa2, pa3); partialSM(pA0, pA1, m_reg, mnA, alA);
    __syncthreads(); SWAIT(); SWRITE(1, SO);
    RESC(alA); __syncthreads();
  }
  SBAR(); qkt(pB0, pB1, (bf16*)((char*)K_lds + SHM_K), qr, r32, hi);
  finishSM(pA0, pA1, alA, l_reg, pa0, pa1, pa2, pa3); SBAR();
  pv_d0(o, vb0, pa0, pa1, pa2, pa3); partialSM(pB0, pB1, m_reg, mnB, alB);
  __syncthreads(); RESC(alB);
  finishSM(pB0, pB1, alB, l_reg, pa0, pa1, pa2, pa3); SBAR();
  pv_d0(o, vb0 + (int)SHM_V, pa0, pa1, pa2, pa3);
  if (hi == 0) li_l[r32] = l_reg; asm volatile("s_waitcnt lgkmcnt(0)" ::: "memory");
  float rli[16];
#pragma unroll
  for (int r = 0; r < 16; ++r) rli[r] = __builtin_amdgcn_rcpf(li_l[crow(r, hi)]);
  unsigned short* Ow = Ob + (long)(wid * QBLK) * LDO; const unsigned short* Gw = Gb + (long)(wid * QBLK) * LDQ;
  int lane_e = lane, r32_e = r32, hi_e = hi; asm volatile("" : "+v"(lane_e), "+v"(r32_e), "+v"(hi_e));
  unsigned short* stg = (unsigned short*)(lds + 69632 + wid * 8704);
#pragma unroll
  for (int r = 0; r < 16; ++r) { int orow = crow(r, hi_e);
#pragma unroll
    for (int d0 = 0; d0 < 4; ++d0) { unsigned u = __float_as_uint(o[d0][r] * rli[r]); u = (u + 0x7fffu + ((u >> 16) & 1u)) >> 16; stg[orow * 136 + d0 * 32 + r32_e] = (unsigned short)u; } }
  asm volatile("s_waitcnt lgkmcnt(0)" ::: "memory");
#pragma unroll 2
  for (int i = 0; i < 8; ++i) { const int idx = i * 64 + lane_e, row = idx >> 4, ch = idx & 15;
    const u32x4 x = *reinterpret_cast<const u32x4*>(stg + row * 136 + 8 * ch);
    const u32x4 g = *reinterpret_cast<const u32x4*>(Gw + (long)row * LDQ + 8 * ch);
    u32x4 w;
#pragma unroll
    for (int q = 0; q < 4; ++q) { const float x0 = __uint_as_float(x[q] << 16), x1 = __uint_as_float(x[q] & 0xffff0000u), g0 = __uint_as_float(g[q] << 16), g1 = __uint_as_float(g[q] & 0xffff0000u);
      const float y0 = x0 / (1.f + __expf(-g0)), y1 = x1 / (1.f + __expf(-g1));
      unsigned u0 = __float_as_uint(y0), u1 = __float_as_uint(y1); u0 = (u0 + 0x7fffu + ((u0 >> 16) & 1u)) >> 16; u1 = (u1 + 0x7fffu + ((u1 >> 16) & 1u)) >> 16; w[q] = u0 | (u1 << 16); }
    *reinterpret_cast<u32x4*>(Ow + (long)row * LDO + 8 * ch) = w; }
  __syncthreads();
#undef SLOAD
#undef SWRITE
#undef SWAIT
#undef RESC
}

#undef KSWZ
#undef SBAR
}

#define LAS __attribute__((address_space(3)))
typedef unsigned short bf16_t;
typedef short bf16x8 __attribute__((ext_vector_type(8)));
typedef float f32x4 __attribute__((ext_vector_type(4)));
typedef float f32x16 __attribute__((ext_vector_type(16)));
typedef unsigned u32x4 __attribute__((ext_vector_type(4)));
typedef unsigned u32x2 __attribute__((ext_vector_type(2)));

constexpr int NWAVES = 8, NTHR = 512;
constexpr int T_TOK = 16384, SEQ = 8192, DM = 1024;
constexpr float EPS = 1e-6f;
constexpr int LDS_BYTES = 147456;
constexpr size_t MiB = 1u << 20;
constexpr size_t WS_BAR = 512 * 1024;
constexpr size_t WS_TAB = 0;
constexpr size_t WS_W0_IN = 1 * MiB, WS_W0_OUT = 6 * MiB;
constexpr size_t WS_WA = 1 * MiB, WS_WZ = 9 * MiB, WS_WAB = 13 * MiB, WS_WO = 14 * MiB;
constexpr size_t WS_WUP = 18 * MiB, WS_WDOWN = 29 * MiB;
constexpr size_t WS_XN = 35 * MiB;
constexpr size_t WS_PROJ = 67 * MiB, WS_AO = 147 * MiB;
constexpr size_t WS_RAWF = 67 * MiB, WS_ACT = 155 * MiB;
constexpr size_t WS_AB = 18 * MiB  , WS_RAWG = 71 * MiB, WS_OF = 71 * MiB, WS_OB = 71 * MiB + 2048;
constexpr size_t WS_QG = 135 * MiB, WS_KG = 151 * MiB, WS_VG = 167 * MiB, WS_KT = 199 * MiB, WS_TPK = 215 * MiB, WS_APK = 231 * MiB;
constexpr size_t WS_EDGE = 249 * MiB  ;
constexpr size_t WS_GC = 247 * MiB, WS_BETA = 248 * MiB, WS_Z = 135 * MiB, WS_GO = 167 * MiB, WS_END = 255 * MiB;

__device__ __forceinline__ unsigned f2bf(float f) { unsigned u = __float_as_uint(f); return (u + 0x7fffu + ((u >> 16) & 1u)) >> 16; }
__device__ __forceinline__ unsigned pk2(float lo, float hi) { return f2bf(lo) | (f2bf(hi) << 16); }
__device__ __forceinline__ float bf2f(unsigned short h) { return __uint_as_float(((unsigned)h) << 16); }
__device__ __forceinline__ float bflo(unsigned w) { return __uint_as_float(w << 16); }
__device__ __forceinline__ float bfhi(unsigned w) { return __uint_as_float(w & 0xffff0000u); }
__device__ __forceinline__ float wave_sum(float v) {
#pragma unroll
    for (int o = 1; o < 64; o <<= 1) v += __shfl_xor(v, o);
    return v;
}
__device__ __forceinline__ float silu_f(float x) { return x * __builtin_amdgcn_rcpf(1.f + __expf(-x)); }
__device__ __forceinline__ float sigm_f(float x) { return __builtin_amdgcn_rcpf(1.f + __expf(-x)); }
#define LDS_WAIT() asm volatile("s_waitcnt lgkmcnt(0)" ::: "memory")

struct Args { const float* in[19]; float* out; unsigned char* ws; int ph_lo, ph_hi; };
struct Ctx {
    const __attribute__((address_space(4))) Args* a; float* out; unsigned char* ws; LAS unsigned char* lds; char* ldsg;
    int tid, lane, wave, G, bid;
};

#define GAS __attribute__((address_space(1)))
#define INP(C, i) ((const float*)(const GAS float*)(C).a->in[i])
__device__ __forceinline__ void transpose_seg(const float* W, int ldw, int k0, int c0, int Kc, int Nc, bf16_t* dst, int ldd, LAS float* scr, int gw, int NGW, int lane) {
    const int nblk = Nc / 32, nitems = (Kc / 64) * nblk;
    for (int it = gw; it < nitems; it += NGW) {
        const int kb = it / nblk, nb = it % nblk, kk0 = 64 * kb, n0 = 32 * nb;
        float wv[32];
#pragma unroll
        for (int i = 0; i < 32; ++i) { const int kk = 2 * i + (lane >> 5); wv[i] = W[(size_t)(k0 + kk0 + kk) * ldw + c0 + n0 + (lane & 31)]; }
#pragma unroll
        for (int i = 0; i < 32; ++i) { const int kk = 2 * i + (lane >> 5); scr[kk * 33 + (lane & 31)] = wv[i]; }
        LDS_WAIT(); asm volatile("" ::: "memory");
        const int c = lane & 7;
#pragma unroll
        for (int j = 0; j < 4; ++j) { const int n = (lane >> 3) + 8 * j; const LAS float* s = scr + (8 * c) * 33 + n;
            u32x4 o; o.x = pk2(s[0 * 33], s[1 * 33]); o.y = pk2(s[2 * 33], s[3 * 33]); o.z = pk2(s[4 * 33], s[5 * 33]); o.w = pk2(s[6 * 33], s[7 * 33]);
            *(u32x4*)(dst + (size_t)(n0 + n) * ldd + kk0 + 8 * c) = o; }
        LDS_WAIT(); asm volatile("" ::: "memory");
    }
}
__device__ __forceinline__ void rms_rows_bf16(const float* src, const float* gain, bf16_t* dst, int gw, int NGW, int lane) {
    f32x4 g[4];
#pragma unroll
    for (int j = 0; j < 4; ++j) g[j] = ((const f32x4*)gain)[lane + 64 * j];
    for (int m = gw; m < T_TOK; m += NGW) {
        const f32x4* xr = (const f32x4*)(src + (size_t)m * DM) + lane; f32x4 v[4]; float s = 0.f;
#pragma unroll
        for (int j = 0; j < 4; ++j) { v[j] = xr[64 * j]; s += (v[j].x * v[j].x + v[j].y * v[j].y) + (v[j].z * v[j].z + v[j].w * v[j].w); }
        const float rs = rsqrtf(wave_sum(s) * (1.f / DM) + EPS);
        u32x2* o8 = (u32x2*)(dst + (size_t)m * DM) + lane;
#pragma unroll
        for (int j = 0; j < 4; ++j) { u32x2 w; w.x = pk2(v[j].x * rs * g[j].x, v[j].y * rs * g[j].y); w.y = pk2(v[j].z * rs * g[j].z, v[j].w * rs * g[j].w); o8[64 * j] = w; }
    }
}
__device__ __forceinline__ void rms_rows_f32_inplace(float* buf, const float* gain, int gw, int NGW, int lane) {
    f32x4 g[4];
#pragma unroll
    for (int j = 0; j < 4; ++j) g[j] = ((const f32x4*)gain)[lane + 64 * j];
    for (int m = gw; m < T_TOK; m += NGW) {
        f32x4* xr = (f32x4*)(buf + (size_t)m * DM) + lane; f32x4 v[4]; float s = 0.f;
#pragma unroll
        for (int j = 0; j < 4; ++j) { v[j] = xr[64 * j]; s += (v[j].x * v[j].x + v[j].y * v[j].y) + (v[j].z * v[j].z + v[j].w * v[j].w); }
        const float rs = rsqrtf(wave_sum(s) * (1.f / DM) + EPS);
#pragma unroll
        for (int j = 0; j < 4; ++j) xr[64 * j] = v[j] * rs * g[j];
    }
}

__device__ __forceinline__ void ph_convert_ffn(const Ctx& C, int layer, int gw, int NGW) {
    LAS float* scr = (LAS float*)(C.lds + C.wave * 16384);
    unsigned char* ws = C.ws;
    const float* wup = INP(C, 15) + (size_t)layer * 1024 * 5632;
    for (int it = gw; it < 44 * 64; it += NGW) {
        const int seg = it >> 6, r = it & 63, ab = seg & 1, j = seg >> 1;
        transpose_seg(wup, 5632, 0, (ab ? 2816 : 0) + 128 * j, 1024, 128, (bf16_t*)(ws + WS_WUP) + (size_t)(256 * j + 128 * ab) * 1024, 1024, scr, r, 64, C.lane);
    }
    transpose_seg(INP(C, 18) + (size_t)layer * 2816 * 1024, 1024, 0, 0, 2816, 1024, (bf16_t*)(ws + WS_WDOWN), 2816, scr, gw, NGW, C.lane);
}
__device__ __forceinline__ void ph_convert_mixer(const Ctx& C, int layer, int gw, int NGW) {
    LAS float* scr = (LAS float*)(C.lds + C.wave * 16384);
    const int gt = gw * 64 + C.lane, NGT = NGW * 64;
    unsigned char* ws = C.ws;
    if (layer == 0) {
        transpose_seg(INP(C, 4), 2560, 0, 0, 1024, 2560, (bf16_t*)(ws + WS_W0_IN), 1024, scr, gw, NGW, C.lane);
        transpose_seg(INP(C, 7), 1024, 0, 0, 1024, 1024, (bf16_t*)(ws + WS_W0_OUT), 1024, scr, gw, NGW, C.lane);
        float* tab = (float*)(ws + WS_TAB);
        for (int i = gt; i < (128 + 64) * 32; i += NGT) {
            const int f = i & 31, pos = i >> 5;
            const float inv = powf(10000.0f, -(float)f * (2.0f / 64.0f));
            const float p = (pos < 128) ? (float)pos : (float)(pos - 128);
            const float ang = p * inv; float sn, cs; sincosf(ang, &sn, &cs);
            if (pos < 128) { tab[pos * 32 + f] = cs; tab[4096 + pos * 32 + f] = sn; }
            else { tab[8192 + (pos - 128) * 32 + f] = cs; tab[8192 + 2048 + (pos - 128) * 32 + f] = sn; }
        }
    } else {
        const float* wi = INP(C, 8);
        for (int p = 0; p < 2; ++p) {
            bf16_t* wa = (bf16_t*)(ws + WS_WA) + (size_t)p * 2048 * 1024;
            transpose_seg(wi, 6208, 0, 512 * p, 1024, 512, wa, 1024, scr, gw, NGW, C.lane);
            transpose_seg(wi, 6208, 0, 1024 + 512 * p, 1024, 512, wa + (size_t)512 * 1024, 1024, scr, gw, NGW, C.lane);
            transpose_seg(wi, 6208, 0, 2048 + 1024 * p, 1024, 1024, wa + (size_t)1024 * 1024, 1024, scr, gw, NGW, C.lane);
            transpose_seg(wi, 6208, 0, 4096 + 1024 * p, 1024, 1024, (bf16_t*)(ws + WS_WZ) + (size_t)p * 1024 * 1024, 1024, scr, gw, NGW, C.lane);
            transpose_seg(INP(C, 14), 1024, 1024 * p, 0, 1024, 1024, (bf16_t*)(ws + WS_WO) + (size_t)p * 1024 * 1024, 1024, scr, gw, NGW, C.lane);
        }
        transpose_seg(wi, 6208, 0, 6144, 1024, 64, (bf16_t*)(ws + WS_WAB), 1024, scr, gw, NGW, C.lane);
        { u32x4* z = (u32x4*)((bf16_t*)(ws + WS_WAB) + (size_t)64 * 1024);
          unsigned z0 = 0u; asm volatile("" : "+v"(z0));
          for (int i = gt; i < 192 * 1024 / 8; i += NGT) z[i] = (u32x4){z0, z0, z0, z0}; }
    }
}
__device__ __forceinline__ bool side_job(const Ctx& C, int& gw, int& NGW) {
    const int h = C.G >> 1;
    if (C.G < 16) { gw = C.bid * NWAVES + C.wave; NGW = C.G * NWAVES; return true; }
    if (C.bid < h) return false;
    gw = (C.bid - h) * NWAVES + C.wave; NGW = (C.G - h) * NWAVES; return true;
}

__device__ __forceinline__ void ph_attn_post(const Ctx& C) {
    const int gw = C.bid * NWAVES + C.wave, NGW = C.G * NWAVES, lane = C.lane;
    bf16_t* P = (bf16_t*)(C.ws + WS_PROJ); const float* tab = (const float*)(C.ws + WS_TAB);
    const int f = lane & 31, i1 = (lane < 32) ? f : 64 + f, i2 = i1 + 32;
    const float gq1 = INP(C, 5)[i1], gq2 = INP(C, 5)[i2], gk1 = INP(C, 6)[i1], gk2 = INP(C, 6)[i2];
    for (int it0 = gw; it0 < T_TOK * 10; it0 += 4 * NGW) {
        bf16_t* pp[4]; float x1[4], x2[4]; int hh4[4], t4[4];
#pragma unroll
        for (int u = 0; u < 4; ++u) { const int it = it0 + u * NGW; const int row = it / 10, hh = it - row * 10;
            const int col0 = hh < 8 ? hh * 128 : 1024 + (hh - 8) * 128;
            pp[u] = P + (size_t)row * 2560 + col0; hh4[u] = hh; t4[u] = row & (SEQ - 1);
            x1[u] = bf2f(pp[u][i1]); x2[u] = bf2f(pp[u][i2]); }
#pragma unroll
        for (int u = 0; u < 4; ++u) {
            const float rs = rsqrtf(wave_sum(x1[u] * x1[u] + x2[u] * x2[u]) * (1.f / 128.f) + EPS);
            const float y1 = x1[u] * rs * (hh4[u] < 8 ? gq1 : gk1), y2 = x2[u] * rs * (hh4[u] < 8 ? gq2 : gk2);
            float cs, sn;
            if (lane < 32) { const int pos = t4[u] >> 6; cs = tab[pos * 32 + f]; sn = tab[4096 + pos * 32 + f]; }
            else { const int pos = t4[u] & 63; cs = tab[8192 + pos * 32 + f]; sn = tab[8192 + 2048 + pos * 32 + f]; }
            x1[u] = y1 * cs - y2 * sn; x2[u] = y1 * sn + y2 * cs;
        }
#pragma unroll
        for (int u = 0; u < 4; ++u) { pp[u][i1] = (bf16_t)f2bf(x1[u]); pp[u][i2] = (bf16_t)f2bf(x2[u]); }
    }
}

__device__ __forceinline__ void ph_attention(const Ctx& C) {
    const bf16_t* P = (const bf16_t*)(C.ws + WS_PROJ); bf16_t* AO = (bf16_t*)(C.ws + WS_AO);
    for (int u = C.bid; u < 512; u += C.G) {
        const int qb = u & 31, h = (u >> 5) & 7, b = u >> 8;
        const size_t row0 = (size_t)b * SEQ + qb * 256, rowb = (size_t)b * SEQ;
        attn::attn_dense_body((const attn::bf16*)(P + row0 * 2560 + h * 128), (const attn::bf16*)(P + rowb * 2560 + 1024 + (h >> 2) * 128),
                              (const attn::bf16*)(P + rowb * 2560 + 1280 + (h >> 2) * 128), P + row0 * 2560 + 1536 + h * 128, AO + row0 * 1024 + h * 128, SEQ, C.ldsg);
    }
}

__device__ __forceinline__ void ph_ffn_gate(const Ctx& C, int layer, int p) {
    const bf16_t* R = (const bf16_t*)(C.ws + WS_RAWF); bf16_t* A = (bf16_t*)(C.ws + WS_ACT);
    const float* cw = INP(C, 16) + (size_t)layer * 3 * 5632; const float* cb = INP(C, 17) + (size_t)layer * 5632;
    for (int task = C.bid * NTHR + C.tid; task < 1024 * 176; task += C.G * NTHR) {
        const int cg = task % 176, rb = task / 176, r0 = rb * 16, t0 = r0 & (SEQ - 1);
        const int ca = 1408 * p + 8 * cg, cbn = 2816 + ca;
        float wa[3][8], wb[3][8], ba[8], bb[8];
#pragma unroll
        for (int s = 0; s < 3; ++s)
#pragma unroll
            for (int e = 0; e < 8; ++e) { wa[s][e] = cw[s * 5632 + ca + e]; wb[s][e] = cw[s * 5632 + cbn + e]; }
#pragma unroll
        for (int e = 0; e < 8; ++e) { ba[e] = cb[ca + e]; bb[e] = cb[cbn + e]; }
        const bf16_t* ra = R + (size_t)r0 * 2816 + 8 * cg; const bf16_t* rbp = ra + 1408;
        const u32x4 zero = {0u, 0u, 0u, 0u};
        u32x4 a0 = (t0 > 0) ? *(const u32x4*)(ra - 2816) : zero, b0 = (t0 > 0) ? *(const u32x4*)(rbp - 2816) : zero;
        u32x4 a1 = *(const u32x4*)ra, b1 = *(const u32x4*)rbp;
#pragma unroll 4
        for (int r = 0; r < 16; ++r) {
            const bool has = (t0 + r + 1) < SEQ;
            const u32x4 a2 = has ? *(const u32x4*)(ra + (size_t)(r + 1) * 2816) : zero, b2 = has ? *(const u32x4*)(rbp + (size_t)(r + 1) * 2816) : zero;
            float o[8];
#pragma unroll
            for (int q = 0; q < 4; ++q) {
                const float ua0 = wa[0][2 * q] * bflo(a0[q]) + wa[1][2 * q] * bflo(a1[q]) + wa[2][2 * q] * bflo(a2[q]) + ba[2 * q];
                const float ua1 = wa[0][2 * q + 1] * bfhi(a0[q]) + wa[1][2 * q + 1] * bfhi(a1[q]) + wa[2][2 * q + 1] * bfhi(a2[q]) + ba[2 * q + 1];
                const float ub0 = wb[0][2 * q] * bflo(b0[q]) + wb[1][2 * q] * bflo(b1[q]) + wb[2][2 * q] * bflo(b2[q]) + bb[2 * q];
                const float ub1 = wb[0][2 * q + 1] * bfhi(b0[q]) + wb[1][2 * q + 1] * bfhi(b1[q]) + wb[2][2 * q + 1] * bfhi(b2[q]) + bb[2 * q + 1];
                o[2 * q] = silu_f(ua0) * ub0; o[2 * q + 1] = silu_f(ua1) * ub1;
            }
            u32x4 w; w.x = pk2(o[0], o[1]); w.y = pk2(o[2], o[3]); w.z = pk2(o[4], o[5]); w.w = pk2(o[6], o[7]);
            *(u32x4*)(A + (size_t)(r0 + r) * 2816 + ca) = w;
            a0 = a1; a1 = a2; b0 = b1; b1 = b2;
        }
    }
}


__device__ __forceinline__ void ph_ffn_fixup(const Ctx& C, int layer) {
    const float* E = (const float*)(C.ws + WS_EDGE); bf16_t* A = (bf16_t*)(C.ws + WS_ACT);
    const float* cw = INP(C, 16) + (size_t)layer * 3 * 5632; const float* cb = INP(C, 17) + (size_t)layer * 5632;
    for (int it = C.bid * NTHR + C.tid; it < 64 * 2 * 22 * 16; it += C.G * NTHR) {
        const int cg = it & 15, j = (it >> 4) % 22, rest = (it >> 4) / 22, which = rest & 1, pm = rest >> 1;
        const int chl = 8 * cg, cha = 128 * j + chl, chb = 2816 + cha;
        const float* e0 = E + (size_t)((pm * 22 + j) * 4) * 256;
        const float *pr, *cu, *nx; bool zp = false, zn = false;
        if (which == 0) { zp = (pm & 31) == 0; pr = E + (size_t)(((pm > 0 ? pm - 1 : 0) * 22 + j) * 4 + 3) * 256; cu = e0; nx = e0 + 256; }
        else { pr = e0 + 2 * 256; cu = e0 + 3 * 256; zn = (pm & 31) == 31; nx = E + (size_t)(((pm < 63 ? pm + 1 : 63) * 22 + j) * 4) * 256; }
        float o[8];
#pragma unroll
        for (int e = 0; e < 8; ++e) {
            const float pa = zp ? 0.f : pr[chl + e], ca = cu[chl + e], na = zn ? 0.f : nx[chl + e];
            const float pb = zp ? 0.f : pr[128 + chl + e], cbv = cu[128 + chl + e], nb = zn ? 0.f : nx[128 + chl + e];
            const float ya = cw[cha + e] * pa + cw[5632 + cha + e] * ca + cw[2 * 5632 + cha + e] * na + cb[cha + e];
            const float yb = cw[chb + e] * pb + cw[5632 + chb + e] * cbv + cw[2 * 5632 + chb + e] * nb + cb[chb + e];
            o[e] = silu_f(ya) * yb;
        }
        u32x4 w; w.x = pk2(o[0], o[1]); w.y = pk2(o[2], o[3]); w.z = pk2(o[4], o[5]); w.w = pk2(o[6], o[7]);
        *(u32x4*)(A + (size_t)(pm * 256 + (which ? 255 : 0)) * 2816 + cha) = w;
    }
}

__device__ __forceinline__ void ph_gdn_gate(const Ctx& C) {
    const int gw = C.bid * NWAVES + C.wave, NGW = C.G * NWAVES, lane = C.lane;
    const unsigned* OF = (const unsigned*)(C.ws + WS_OF); const unsigned* OB = (const unsigned*)(C.ws + WS_OB);
    const unsigned* Z = (const unsigned*)(C.ws + WS_Z); unsigned* GO = (unsigned*)(C.ws + WS_GO);
    const float g0 = INP(C, 13)[2 * lane], g1 = INP(C, 13)[2 * lane + 1];
    for (int it0 = gw; it0 < T_TOK * 8; it0 += 4 * NGW) {
        unsigned a[4], b[4], z[4];
#pragma unroll
        for (int u = 0; u < 4; ++u) { const size_t idx = (size_t)(it0 + u * NGW) * 64 + lane; a[u] = OF[idx]; b[u] = OB[idx]; z[u] = Z[idx]; }
#pragma unroll
        for (int u = 0; u < 4; ++u) {
            const float o0 = bflo(a[u]) + bflo(b[u]), o1 = bfhi(a[u]) + bfhi(b[u]);
            const float rs = rsqrtf(wave_sum(o0 * o0 + o1 * o1) * (1.f / 128.f) + EPS);
            const float z0 = bflo(z[u]), z1 = bfhi(z[u]);
            GO[(size_t)(it0 + u * NGW) * 64 + lane] = pk2(o0 * rs * g0 * silu_f(z0), o1 * rs * g1 * silu_f(z1));
        }
    }
}

#define XB_TMO      128
#define XB_XCNT(j)  (256  + 64 * (j))
#define XB_XSUB(j)  (1280 + 64 * (j))
#define XB_XGEN(j)  (2304 + 64 * (j))
#define XB_TOP      3328
#define XB_TOPGEN   3392
#define XCD_BAR_WORDS 3456
#define XB_SPIN_CAP (1u << 18)

__device__ __forceinline__ unsigned xb_ld(unsigned* p)              { return __hip_atomic_load(p, __ATOMIC_RELAXED, __HIP_MEMORY_SCOPE_AGENT); }
__device__ __forceinline__ unsigned xb_add(unsigned* p, unsigned v) { return __hip_atomic_fetch_add(p, v, __ATOMIC_RELAXED, __HIP_MEMORY_SCOPE_AGENT); }
__device__ __forceinline__ unsigned xb_xcc_id() { return (unsigned)__builtin_amdgcn_s_getreg((3 << 11) | 20) & 0xFu; }
#define XB_SPIN(cond, bar) do { unsigned _sp = 0; while (cond) { __builtin_amdgcn_s_sleep(1); \
    if ((++_sp & 255u) == 0u) { if (xb_ld(&(bar)[XB_TMO])) break; if (_sp > XB_SPIN_CAP) { atomicAdd(&(bar)[XB_TMO], 1u); break; } } } } while (0)

struct XcdBarrier {
    unsigned* bar; unsigned x;
    volatile LAS unsigned* st;
};

__device__ __forceinline__ XcdBarrier xcd_barrier_post(unsigned* bar, volatile LAS unsigned* st) {
    XcdBarrier b; b.bar = bar; b.x = xb_xcc_id(); b.st = st;
    if (threadIdx.x == 0) (void)xb_add(&bar[XB_XCNT(b.x)], 1u);
    return b;
}
__device__ __forceinline__ void xcd_barrier_complete(unsigned* bar, unsigned x, unsigned& nloc, unsigned& nx) {
    const unsigned G = gridDim.x * gridDim.y * gridDim.z;
    unsigned sum, cnt, mine, sp = 0u;
    for (;;) {
        sum = 0u; cnt = 0u; mine = 0u;
#pragma unroll
        for (unsigned j = 0; j < 16; ++j) { const unsigned c = xb_ld(&bar[XB_XCNT(j)]); sum += c; cnt += (c > 0u) ? 1u : 0u; mine = (j == x) ? c : mine; }
        if (sum == G) break;
        __builtin_amdgcn_s_sleep(1);
        if ((++sp & 255u) == 0u) { if (xb_ld(&bar[XB_TMO])) break; if (sp > XB_SPIN_CAP) { atomicAdd(&bar[XB_TMO], 1u); break; } }
    }
    nloc = mine > 0u ? mine : 1u; nx = cnt > 0u ? cnt : 1u;
}

__device__ __forceinline__ void xcd_barrier(const XcdBarrier& b) {
    asm volatile("s_waitcnt vmcnt(0)" ::: "memory");
    __syncthreads();
    if (threadIdx.x == 0) {
        unsigned* bar = b.bar;
        __builtin_amdgcn_s_waitcnt(0);
        unsigned nloc = b.st[0], nx = b.st[1];
        if (nloc == 0u) { xcd_barrier_complete(bar, b.x, nloc, nx); b.st[0] = nloc; b.st[1] = nx; }
        const unsigned old = xb_add(&bar[XB_XSUB(b.x)], 1u);
        const unsigned gen = old / nloc;
        if (old + 1u == (gen + 1u) * nloc) {
            __builtin_amdgcn_fence(__ATOMIC_RELEASE, "agent");
            asm volatile("s_waitcnt vmcnt(0)" ::: "memory");
            const unsigned og = xb_add(&bar[XB_TOP], 1u);
            const unsigned tg = og / nx;
            if (og + 1u == (tg + 1u) * nx) xb_add(&bar[XB_TOPGEN], 1u);
            else XB_SPIN(xb_ld(&bar[XB_TOPGEN]) == tg, bar);
            __builtin_amdgcn_fence(__ATOMIC_ACQUIRE, "agent");
            xb_add(&bar[XB_XGEN(b.x)], 1u);
            asm volatile("s_waitcnt vmcnt(0)" ::: "memory");
        } else {
            XB_SPIN(xb_ld(&bar[XB_XGEN(b.x)]) == gen, bar);
            __builtin_amdgcn_fence(__ATOMIC_ACQUIRE, "agent");
            asm volatile("s_waitcnt vmcnt(0)" ::: "memory");
        }
    }
    __syncthreads();
}

__device__ __forceinline__ int crow16(int r, int hi) { return (r & 3) + 8 * (r >> 2) + 4 * hi; }
__device__ __forceinline__ unsigned cvtpk2(float lo, float hi) { return pg8::cvt_pk_bf16(lo, hi); }
#define PK4S(P, BASE, OUT) do { unsigned a0_ = cvtpk2(P[BASE + 0], P[BASE + 1]), a1_ = cvtpk2(P[BASE + 2], P[BASE + 3]);   \
    unsigned b0_ = cvtpk2(P[BASE + 4], P[BASE + 5]), b1_ = cvtpk2(P[BASE + 6], P[BASE + 7]);                              \
    auto r0_ = __builtin_amdgcn_permlane32_swap(a0_, b0_, false, false); auto r1_ = __builtin_amdgcn_permlane32_swap(a1_, b1_, false, false); \
    u32x4 w_ = {r0_[0], r1_[0], r0_[1], r1_[1]}; OUT = *reinterpret_cast<bf16x8*>(&w_); } while (0)

__device__ __forceinline__ void ph_ab_small(const Ctx& C) {
    const bf16_t* XN = (const bf16_t*)(C.ws + WS_XN); const bf16_t* WB = (const bf16_t*)(C.ws + WS_WAB); float* AB = (float*)(C.ws + WS_AB);
    const int lane = C.lane, w = C.wave, mt = w & 1, nt = (w >> 1) & 1, kh = w >> 2, r32 = lane & 31, hi = lane >> 5;
    LAS float* red = (LAS float*)C.lds;
    for (int slab = C.bid; slab < T_TOK / 64; slab += C.G) {
        const bf16_t* ap = XN + (size_t)(slab * 64 + 32 * mt + r32) * 1024 + 512 * kh + 8 * hi;
        const bf16_t* bp = WB + (size_t)(32 * nt + r32) * 1024 + 512 * kh + 8 * hi;
        f32x16 acc = {};
#pragma unroll 8
        for (int ks = 0; ks < 32; ++ks) {
            const bf16x8 a = *(const bf16x8*)(ap + 16 * ks), b = *(const bf16x8*)(bp + 16 * ks);
            acc = __builtin_amdgcn_mfma_f32_32x32x16_bf16(a, b, acc, 0, 0, 0);
        }
        if (kh == 1) {
#pragma unroll
            for (int r = 0; r < 16; ++r) red[((w & 3) * 16 + r) * 64 + lane] = acc[r];
        }
        __syncthreads();
        if (kh == 0) {
#pragma unroll
            for (int r = 0; r < 16; ++r) AB[(size_t)(slab * 64 + 32 * mt + crow16(r, hi)) * 256 + 32 * nt + r32] = acc[r] + red[((w & 3) * 16 + r) * 64 + lane];
        }
        __syncthreads();
    }
}
constexpr int GDN_KS = 47;
__device__ __forceinline__ void ph_gdn_prep(const Ctx& C, int p, int mode) {
    const int tid = C.tid, lane = C.lane, wave = C.wave;
    unsigned char* ws = C.ws;
    const bf16_t* RAW = (const bf16_t*)(ws + WS_RAWG);
    bf16_t* QG = (bf16_t*)(ws + WS_QG); bf16_t* KG = (bf16_t*)(ws + WS_KG); bf16_t* VG = (bf16_t*)(ws + WS_VG); bf16_t* KT = (bf16_t*)(ws + WS_KT);
    bf16_t* TPK = (bf16_t*)(ws + WS_TPK); bf16_t* APK = (bf16_t*)(ws + WS_APK);
    float* GC = (float*)(ws + WS_GC); float* BETA = (float*)(ws + WS_BETA); const float* AB = (const float*)(ws + WS_AB);
    const float* cw = INP(C, 9); const float* cb = INP(C, 10);
    LAS bf16_t* qs = (LAS bf16_t*)(C.lds); LAS bf16_t* ks = (LAS bf16_t*)(C.lds + 17408);
    LAS float* KKs = (LAS float*)(C.lds + 34816); LAS float* QKs = (LAS float*)(C.lds + 51456);
    LAS float* Ls = (LAS float*)(C.lds + 68096);
    const int per = mode ? (126 - 2 * GDN_KS) : 2 * (GDN_KS + 1), ntask = 8 * per;
    for (int task = mode ? C.bid - 128 : C.bid; task < ntask; task += mode ? C.G - 128 : C.G) {
        const int ci = task % per, grp = task / per, hql = grp & 3, b = grp >> 2;
        const int chunk = mode ? GDN_KS + 1 + ci : (ci <= GDN_KS ? ci : 126 - 2 * GDN_KS + ci);
        const int row0 = b * SEQ + chunk * 64;
#ifndef PREP_REP_A
#define PREP_REP_A 1
#endif
#ifndef PREP_REP_C
#define PREP_REP_C 1
#endif
#pragma unroll 1
        for (int repa = 0; repa < PREP_REP_A; ++repa) {
            const int cgp = tid & 63, rg = wave, lc = 8 * cgp;
            int rcol, chan; int kind;
            if (lc < 128) { kind = 0; rcol = 128 * hql + lc; chan = (4 * p + hql) * 128 + lc; }
            else if (lc < 256) { kind = 1; rcol = 512 + 128 * hql + (lc - 128); chan = 1024 + (4 * p + hql) * 128 + (lc - 128); }
            else { kind = 2; rcol = 1024 + 256 * hql + (lc - 256); chan = 2048 + (8 * p + 2 * hql) * 128 + (lc - 256); }
            float w5[5][8], bs[8];
#pragma unroll
            for (int s = 0; s < 5; ++s)
#pragma unroll
                for (int e = 0; e < 8; ++e) w5[s][e] = cw[s * 4096 + chan + e];
#pragma unroll
            for (int e = 0; e < 8; ++e) bs[e] = cb[chan + e];
            {
                const int tl0 = chunk * 64 + 8 * rg - 2;
                u32x4 win[12];
#pragma unroll
                for (int j = 0; j < 12; ++j) { const int tl = tl0 + j; win[j] = (u32x4){0u, 0u, 0u, 0u};
                    if (tl >= 0 && tl < SEQ) win[j] = *(const u32x4*)(RAW + (size_t)(b * SEQ + tl) * 2048 + rcol); }
#pragma unroll
                for (int r = 0; r < 8; ++r) {
                    float o[8];
#pragma unroll
                    for (int e = 0; e < 8; ++e) o[e] = bs[e];
#pragma unroll
                    for (int s5 = 0; s5 < 5; ++s5) { const u32x4 x = win[r + s5];
#pragma unroll
                        for (int q = 0; q < 4; ++q) { o[2 * q] += w5[s5][2 * q] * bflo(x[q]); o[2 * q + 1] += w5[s5][2 * q + 1] * bfhi(x[q]); } }
                    float ss = 0.f;
#pragma unroll
                    for (int e = 0; e < 8; ++e) { o[e] = silu_f(o[e]); ss += o[e] * o[e]; }
                    ss += __shfl_xor(ss, 1); ss += __shfl_xor(ss, 2); ss += __shfl_xor(ss, 4); ss += __shfl_xor(ss, 8);
                    float sc = rsqrtf(ss + EPS); if (kind == 0) sc *= 0.08838834764831845f; if (kind == 2) sc = 1.f;
                    u32x4 w; w.x = pk2(o[0] * sc, o[1] * sc); w.y = pk2(o[2] * sc, o[3] * sc); w.z = pk2(o[4] * sc, o[5] * sc); w.w = pk2(o[6] * sc, o[7] * sc);
                    const int rr = 8 * rg + r; const size_t grow = (size_t)(row0 + rr);
                    if (kind == 0) { *(u32x4*)(QG + grow * 512 + 128 * hql + lc) = w; *(LAS u32x4*)(qs + rr * 136 + lc) = w; }
                    else if (kind == 1) { *(u32x4*)(KG + grow * 512 + 128 * hql + (lc - 128)) = w; *(LAS u32x4*)(ks + rr * 136 + (lc - 128)) = w; }
                    else { *(u32x4*)(VG + grow * 1024 + 256 * hql + (lc - 256)) = w; }
                }
            }
        }
        __syncthreads();
        {
            bf16_t* kt = KT + ((size_t)((b * 4 + hql) * 128 + chunk)) * 8192;
            const int dk = tid & 127, tg = tid >> 7;
            unsigned short v[16];
#pragma unroll
            for (int i = 0; i < 16; ++i) v[i] = ks[(16 * tg + i) * 136 + dk];
            u32x4 w0, w1;
#pragma unroll
            for (int q = 0; q < 4; ++q) { w0[q] = (unsigned)v[2 * q] | ((unsigned)v[2 * q + 1] << 16); w1[q] = (unsigned)v[8 + 2 * q] | ((unsigned)v[8 + 2 * q + 1] << 16); }
            *(u32x4*)(kt + (size_t)dk * 64 + 16 * tg) = w0; *(u32x4*)(kt + (size_t)dk * 64 + 16 * tg + 8) = w1;
        }
        {
            const int mat = wave >> 2, mi = (wave >> 1) & 1, ni = wave & 1, r32 = lane & 31, hi = lane >> 5;
            LAS bf16_t* X = mat ? qs : ks; f32x16 acc = {};
#pragma unroll
            for (int kk = 0; kk < 8; ++kk) {
                const bf16x8 a = *(const LAS bf16x8*)(X + (32 * mi + r32) * 136 + 16 * kk + 8 * hi);
                const bf16x8 bb = *(const LAS bf16x8*)(ks + (32 * ni + r32) * 136 + 16 * kk + 8 * hi);
                acc = __builtin_amdgcn_mfma_f32_32x32x16_bf16(a, bb, acc, 0, 0, 0);
            }
            LAS float* M = mat ? QKs : KKs;
#pragma unroll
            for (int r = 0; r < 16; ++r) M[(32 * mi + crow16(r, hi)) * 65 + 32 * ni + r32] = acc[r];
        }
        __syncthreads();
        {
            const int cw = wave & 3, rh = wave >> 2;
            const int vh = cw >> 1, dir = cw & 1, hloc = 2 * hql + vh, head = 8 * p + hloc;
            const int row = row0 + lane;
            const float av = AB[(size_t)row * 256 + dir * 32 + head], bv = AB[(size_t)row * 256 + dir * 32 + 16 + head];
            const float xx = av + INP(C, 12)[dir * 16 + head];
            const float ex = __expf(xx); const float sp = xx > 20.f ? xx : (xx < -10.f ? ex : __logf(1.f + ex));
            const float g = -__expf(INP(C, 11)[dir * 16 + head]) * sp;
            const float beta = sigm_f(bv);
            float v = dir ? __shfl(g, 63 - lane) : g;
#pragma unroll
            for (int off = 1; off < 64; off <<= 1) { const float t = __shfl_up(v, off); if (lane >= off) v += t; }
            const float gc = dir ? __shfl(v, 63 - lane) : v;
            if (rh == 0) { GC[((size_t)dir * T_TOK + row) * 8 + hloc] = gc; BETA[((size_t)dir * T_TOK + row) * 8 + hloc] = beta; }
            const int c = lane, jo = dir ? 63 - c : c;
            const float gcj = __shfl(gc, jo);
            LAS float* L = Ls + cw * 4096;
            const size_t mbase = ((size_t)((b * 8 + hloc) * 128 + chunk)) * 4096;
#pragma unroll 4
            for (int q = 0; q < 32; ++q) {
                const int ip = 32 * rh + q, io = dir ? 63 - ip : ip;
                const float gci = __shfl(gc, io), bti = __shfl(beta, io);
                const float dec = (c <= ip) ? __expf(gci - gcj) : 0.f;
                const float lv = (c < ip) ? bti * KKs[io * 65 + jo] * dec : 0.f;
                L[ip * 64 + c] = lv;
                const bool wr = dir ? (c < ip) : (c <= ip);
                if (wr) APK[mbase + io * 64 + jo] = (bf16_t)f2bf(QKs[io * 65 + jo] * dec);
            }
            __syncthreads();
            if (wave < 4) {
                float x[64];
#pragma unroll
                for (int i = 0; i < 64; ++i) x[i] = 0.f;
                f32x4 cur[8], nxt[8];
#pragma unroll
                for (int j4 = 0; j4 < 8; ++j4) { cur[j4] = (f32x4){0.f, 0.f, 0.f, 0.f}; nxt[j4] = (f32x4){0.f, 0.f, 0.f, 0.f}; }
                cur[0] = *(const LAS f32x4*)(L + 1 * 64);
                x[0] = (c == 0) ? 1.f : 0.f;
#pragma unroll
                for (int i = 1; i < 64; ++i) {
                    if (i + 1 < 64) {
#pragma unroll
                        for (int j4 = 0; j4 < ((i + 1 + 3) / 4 < 8 ? (i + 1 + 3) / 4 : 8); ++j4) nxt[j4] = *(const LAS f32x4*)(L + (i + 1) * 64 + 4 * j4);
                    }
                    float a0 = (c == i) ? 1.f : 0.f, a1 = 0.f;
#pragma unroll
                    for (int j4 = 0; j4 < (i + 3) / 4; ++j4) {
                        const f32x4 l = (j4 < 8) ? cur[j4 < 8 ? j4 : 0] : *(const LAS f32x4*)(L + i * 64 + 4 * j4);
                        if (4 * j4 + 0 < i) a0 -= l[0] * x[4 * j4 + 0];
                        if (4 * j4 + 1 < i) a1 -= l[1] * x[4 * j4 + 1];
                        if (4 * j4 + 2 < i) a0 -= l[2] * x[4 * j4 + 2];
                        if (4 * j4 + 3 < i) a1 -= l[3] * x[4 * j4 + 3];
                    }
                    x[i] = a0 + a1;
                    asm volatile("" ::: "memory");
#pragma unroll
                    for (int j4 = 0; j4 < 8; ++j4) cur[j4] = nxt[j4];
                }
#pragma unroll
                for (int i = 0; i < 64; ++i) L[i * 64 + c] = x[i];
            }
            __syncthreads();
#pragma unroll 4
            for (int q = 0; q < 32; ++q) { const int i = 32 * rh + q, io = dir ? 63 - i : i; const float xv = L[i * 64 + c]; if (c < i) TPK[mbase + io * 64 + jo] = (bf16_t)f2bf(xv); }
        }
        __syncthreads();
    }
}

constexpr int SC_SLOT = 54272;
constexpr int SC_KT = 2 * SC_SLOT;
constexpr int SC_SB = SC_KT + 16384, SC_RB = SC_SB + 8192;
constexpr int SL_VB = 16384, SL_VSB = 16384 + 4096;
#define SC_BAR() do { asm volatile("s_waitcnt lgkmcnt(0)" ::: "memory"); __builtin_amdgcn_s_barrier(); asm volatile("" ::: "memory"); } while (0)
struct ScanRegs { u32x4 q[4], k[4], kt[4], t[2], a[2], v; float gcv, gl, bt; };
__device__ __forceinline__ void scan_issue(const Ctx& C, ScanRegs& R, int ltid, int cidx, int b, int hql, int vh, int dir, int sl) {
    const int hloc = 2 * hql + vh; unsigned char* ws = C.ws;
    const size_t row0 = (size_t)b * SEQ + cidx * 64;
    const bf16_t* QG = (const bf16_t*)(ws + WS_QG) + row0 * 512 + 128 * hql;
    const bf16_t* KG = (const bf16_t*)(ws + WS_KG) + row0 * 512 + 128 * hql;
    const bf16_t* KT = (const bf16_t*)(ws + WS_KT) + ((size_t)((b * 4 + hql) * 128 + cidx)) * 8192;
    const bf16_t* TP = (const bf16_t*)(ws + WS_TPK) + ((size_t)((b * 8 + hloc) * 128 + cidx)) * 4096;
    const bf16_t* AP = (const bf16_t*)(ws + WS_APK) + ((size_t)((b * 8 + hloc) * 128 + cidx)) * 4096;
    const bf16_t* VG = (const bf16_t*)(ws + WS_VG) + row0 * 1024 + 256 * hql + 128 * vh + 32 * sl;
#pragma unroll
    for (int j = 0; j < 4; ++j) { const int i = ltid + 256 * j, r = i >> 4, ch = i & 15;
        R.q[j] = *(const u32x4*)(QG + (size_t)r * 512 + 8 * ch); R.k[j] = *(const u32x4*)(KG + (size_t)r * 512 + 8 * ch);
        const int r2 = i >> 3, c2 = i & 7; R.kt[j] = *(const u32x4*)(KT + (size_t)r2 * 64 + 8 * c2); }
#pragma unroll
    for (int j = 0; j < 2; ++j) { const int i = ltid + 256 * j, r = i >> 3, ch = i & 7; R.t[j] = *(const u32x4*)(TP + r * 64 + 8 * ch); R.a[j] = *(const u32x4*)(AP + r * 64 + 8 * ch); }
    { const int r = ltid >> 2, ch = ltid & 3; R.v = *(const u32x4*)(VG + (size_t)r * 1024 + 8 * ch); }
    if (ltid < 64) { const float* GC = (const float*)(ws + WS_GC) + ((size_t)dir * T_TOK + row0) * 8 + hloc; const float* BT = (const float*)(ws + WS_BETA) + ((size_t)dir * T_TOK + row0) * 8 + hloc;
        R.gcv = GC[ltid * 8]; R.gl = GC[(dir ? 0 : 63) * 8]; R.bt = BT[ltid * 8]; }
}
__device__ __forceinline__ void scan_write_kt(const ScanRegs& R, LAS unsigned char* lds, int ltid) {
#pragma unroll
    for (int j = 0; j < 4; ++j) { const int i = ltid + 256 * j, r2 = i >> 3, c2 = i & 7; *(LAS u32x4*)(lds + SC_KT + r2 * 128 + ((c2 ^ (r2 & 7)) << 4)) = R.kt[j]; }
}
__device__ __forceinline__ void scan_write_slot(const ScanRegs& R, LAS unsigned char* Lb, int ltid, int dir) {
#pragma unroll
    for (int j = 0; j < 4; ++j) { const int i = ltid + 256 * j, r = i >> 4, ch = i & 15; const int o = r * 256 + ((ch ^ (r & 7)) << 4);
        *(LAS u32x4*)(Lb + o) = R.q[j]; *(LAS u32x4*)(Lb + 16384 + o) = R.k[j]; }
#pragma unroll
    for (int j = 0; j < 2; ++j) { const int i = ltid + 256 * j, r = i >> 3, ch = i & 7; u32x4 t = R.t[j], a = R.a[j];
#pragma unroll
        for (int q = 0; q < 4; ++q) {
            unsigned tl = t[q] & 0xffffu, th = t[q] >> 16, al = a[q] & 0xffffu, ah = a[q] >> 16;
            const int j0 = 8 * ch + 2 * q, j1 = j0 + 1;
            const bool s0 = dir ? (j0 > r) : (j0 < r), s1 = dir ? (j1 > r) : (j1 < r);
            tl = s0 ? tl : (j0 == r ? 0x3f80u : 0u); th = s1 ? th : (j1 == r ? 0x3f80u : 0u);
            al = (s0 || j0 == r) ? al : 0u; ah = (s1 || j1 == r) ? ah : 0u;
            t[q] = tl | (th << 16); a[q] = al | (ah << 16);
        }
        const int o = r * 128 + ((ch ^ (r & 7)) << 4);
        *(LAS u32x4*)(Lb + 32768 + o) = t; *(LAS u32x4*)(Lb + 40960 + o) = a; }
    { const int r = ltid >> 2, ch = ltid & 3; *(LAS u32x4*)(Lb + 49152 + r * 64 + ch * 16) = R.v; }
    if (ltid < 64) { LAS float* sc = (LAS float*)(Lb + 53248);
        sc[ltid] = __expf(R.gcv); sc[64 + ltid] = __expf(R.gl - R.gcv); sc[128 + ltid] = R.bt; if (ltid == 0) sc[192] = __expf(R.gl); }
}
__device__ __forceinline__ void scan_out(f32x16 acc, LAS unsigned char* Lb, bf16_t* obase, int mi, int r32, int hi, int lane) {
    bf16x8 af[4], vf[4];
#pragma unroll
    for (int kk = 0; kk < 4; ++kk) { const int row = 32 * mi + r32; af[kk] = *(const LAS bf16x8*)(Lb + 40960 + row * 128 + (((2 * kk + hi) ^ (row & 7)) << 4));
        vf[kk] = *(const LAS bf16x8*)(Lb + SL_VB + kk * 1024 + lane * 16); }
#pragma unroll
    for (int kk = 0; kk < 4; ++kk) acc = __builtin_amdgcn_mfma_f32_32x32x16_bf16(af[kk], vf[kk], acc, 0, 0, 0);
    bf16_t* op = obase + r32;
#pragma unroll
    for (int r = 0; r < 16; ++r) op[(size_t)(32 * mi + crow16(r, hi)) * 2048] = (bf16_t)f2bf(acc[r]);
}
__device__ __forceinline__ void ph_gdn_scan(const Ctx& C, int p, const XcdBarrier& xbar, bool side) {
    if (C.bid >= 128) {
        ph_gdn_prep(C, p, 1);
        xcd_barrier(xbar);
        if (side) ph_convert_ffn(C, 1, (C.bid - 128) * NWAVES + C.wave, (C.G - 128) * NWAVES);
        return;
    }
    const int group = C.bid & 7, b = group >> 2, hql = group & 3, jj = C.bid >> 3, vh = jj >> 3, dir = (jj >> 2) & 1, sl = jj & 3;
    const int hloc = 2 * hql + vh, lane = C.lane, w = C.wave;
    LAS unsigned char* lds = C.lds;
    bf16_t* OD = (bf16_t*)(C.ws + (dir ? WS_OB : WS_OF));
    if (w >= 4) {
        const int ltid = C.tid - 256;
        ScanRegs R;
        scan_issue(C, R, ltid, dir ? 127 : 0, b, hql, vh, dir, sl);
        scan_write_slot(R, lds, ltid, dir); scan_write_kt(R, lds, ltid);
        { unsigned z0 = 0u; asm volatile("" : "+v"(z0));
          for (int i = ltid; i < 8192 / 16; i += 256) *(LAS u32x4*)(lds + SC_SB + i * 16) = (u32x4){z0, z0, z0, z0}; }
        for (int n = 0; n < 128; ++n) {
            if (n == GDN_KS) {
                xcd_barrier(xbar);
                scan_issue(C, R, ltid, dir ? 127 - n : n, b, hql, vh, dir, sl);
                scan_write_slot(R, lds + (n & 1) * SC_SLOT, ltid, dir);
            }
            SC_BAR();
            if (n > 0) scan_write_kt(R, lds, ltid);
            const bool pre = (n + 1 < 128) && (n + 1 != GDN_KS);
            if (pre) scan_issue(C, R, ltid, dir ? 126 - n : n + 1, b, hql, vh, dir, sl);
            SC_BAR();
            SC_BAR();
            if (pre) scan_write_slot(R, lds + ((n + 1) & 1) * SC_SLOT, ltid, dir);
        }
    } else {
        f32x16 S = {}, oacc = {};
        for (int n = 0; n < 128; ++n) {
            int r32 = lane & 31, hi = lane >> 5; asm volatile("" : "+v"(r32), "+v"(hi));
            LAS unsigned char* Lb = lds + (n & 1) * SC_SLOT;
            const LAS float* sc = (const LAS float*)(Lb + 53248);
            const int cidx = dir ? 127 - n : n;
            if (n == GDN_KS) xcd_barrier(xbar);
            SC_BAR();
            const int mi = w & 1;
            f32x16 acc = {};
            {
                LAS unsigned char* Ab = Lb + (w < 2 ? 16384 : 0);
                bf16x8 af[8], sf[8];
#pragma unroll
                for (int kk = 0; kk < 8; ++kk) { const int row = 32 * mi + r32; af[kk] = *(const LAS bf16x8*)(Ab + row * 256 + (((2 * kk + hi) ^ (row & 7)) << 4));
                    sf[kk] = *(const LAS bf16x8*)(lds + SC_SB + kk * 1024 + lane * 16); }
#pragma unroll
                for (int kk = 0; kk < 8; ++kk) acc = __builtin_amdgcn_mfma_f32_32x32x16_bf16(af[kk], sf[kk], acc, 0, 0, 0);
            }
            if (w < 2) {
#pragma unroll
                for (int g4 = 0; g4 < 4; ++g4) { const int i0 = 32 * mi + 8 * g4 + 4 * hi;
                    const f32x4 eg = *(const LAS f32x4*)(sc + i0), bt = *(const LAS f32x4*)(sc + 128 + i0);
#pragma unroll
                    for (int e = 0; e < 4; ++e) { const float vv = bf2f(*(const LAS bf16_t*)(Lb + 49152 + (i0 + e) * 64 + r32 * 2));
                        acc[4 * g4 + e] = bt[e] * (vv - eg[e] * acc[4 * g4 + e]); } }
                bf16x8 f0, f1; PK4S(acc, 0, f0); PK4S(acc, 8, f1);
                *(LAS bf16x8*)(lds + SC_RB + (2 * mi) * 1024 + lane * 16) = f0; *(LAS bf16x8*)(lds + SC_RB + (2 * mi + 1) * 1024 + lane * 16) = f1;
            }
            SC_BAR();
            if (w < 2) {
                bf16x8 af[4], rf[4];
#pragma unroll
                for (int kk = 0; kk < 4; ++kk) { const int row = 32 * mi + r32; af[kk] = *(const LAS bf16x8*)(Lb + 32768 + row * 128 + (((2 * kk + hi) ^ (row & 7)) << 4));
                    rf[kk] = *(const LAS bf16x8*)(lds + SC_RB + kk * 1024 + lane * 16); }
                f32x16 vn = {};
#pragma unroll
                for (int kk = 0; kk < 4; ++kk) vn = __builtin_amdgcn_mfma_f32_32x32x16_bf16(af[kk], rf[kk], vn, 0, 0, 0);
                bf16x8 f0, f1; PK4S(vn, 0, f0); PK4S(vn, 8, f1);
                *(LAS bf16x8*)(Lb + SL_VB + (2 * mi) * 1024 + lane * 16) = f0; *(LAS bf16x8*)(Lb + SL_VB + (2 * mi + 1) * 1024 + lane * 16) = f1;
#pragma unroll
                for (int g4 = 0; g4 < 4; ++g4) { const int i0 = 32 * mi + 8 * g4 + 4 * hi; const f32x4 ek = *(const LAS f32x4*)(sc + 64 + i0);
#pragma unroll
                    for (int e = 0; e < 4; ++e) vn[4 * g4 + e] *= ek[e]; }
                PK4S(vn, 0, f0); PK4S(vn, 8, f1);
                *(LAS bf16x8*)(Lb + SL_VSB + (2 * mi) * 1024 + lane * 16) = f0; *(LAS bf16x8*)(Lb + SL_VSB + (2 * mi + 1) * 1024 + lane * 16) = f1;
            }
            if (w >= 2) {
#pragma unroll
                for (int g4 = 0; g4 < 4; ++g4) { const int i0 = 32 * mi + 8 * g4 + 4 * hi; const f32x4 eg = *(const LAS f32x4*)(sc + i0);
#pragma unroll
                    for (int e = 0; e < 4; ++e) acc[4 * g4 + e] *= eg[e]; }
                if (n > 0) scan_out(oacc, lds + ((n - 1) & 1) * SC_SLOT, OD + ((size_t)b * SEQ + (dir ? 128 - n : n - 1) * 64) * 2048 + hloc * 128 + sl * 32, mi, r32, hi, lane);
                oacc = acc;
            }
            SC_BAR();
            {
                const float gl = sc[192];
                bf16x8 af[4], vf[4];
#pragma unroll
                for (int kk = 0; kk < 4; ++kk) { const int row = 32 * w + r32; af[kk] = *(const LAS bf16x8*)(lds + SC_KT + row * 128 + (((2 * kk + hi) ^ (row & 7)) << 4));
                    vf[kk] = *(const LAS bf16x8*)(Lb + SL_VSB + kk * 1024 + lane * 16); }
                S = S * gl;
#pragma unroll
                for (int kk = 0; kk < 4; ++kk) S = __builtin_amdgcn_mfma_f32_32x32x16_bf16(af[kk], vf[kk], S, 0, 0, 0);
                bf16x8 f0, f1; PK4S(S, 0, f0); PK4S(S, 8, f1);
                *(LAS bf16x8*)(lds + SC_SB + (2 * w) * 1024 + lane * 16) = f0; *(LAS bf16x8*)(lds + SC_SB + (2 * w + 1) * 1024 + lane * 16) = f1;
            }
        }
        if (w >= 2) { int r32 = lane & 31, hi = lane >> 5; scan_out(oacc, lds + (127 & 1) * SC_SLOT, OD + ((size_t)b * SEQ + (dir ? 0 : 127) * 64) * 2048 + hloc * 128 + sl * 32, w & 1, r32, hi, lane); }
    }
    __syncthreads();
}

constexpr int NPH = 25;

__device__ __forceinline__ void run_gemm_bf16(const Ctx& C, const bf16_t* A, const bf16_t* Bt, int N, int K, bf16_t* O) {
    pg8::Gemm g{A, Bt, T_TOK, N, K}; pg8::StaticOrder S; S.init(T_TOK, N, C.G, C.bid);
    pg8::EpiBf16 E{O, N};
    pg8::gemm_phase<pg8::EpiBf16, pg8::StaticOrder, true, true>(C.lds, g, S, E);
}
__device__ __forceinline__ void run_gemm_res(const Ctx& C, const bf16_t* A, const bf16_t* Bt, int K, const float* base) {
    pg8::Gemm g{A, Bt, T_TOK, DM, K}; pg8::StaticOrder S; S.init(T_TOK, DM, C.G, C.bid);
    pg8::EpiRes E{base, C.out, DM};
    pg8::gemm_phase<pg8::EpiRes, pg8::StaticOrder, true, true>(C.lds, g, S, E);
}

__global__ void __launch_bounds__(NTHR, 2) mega_fwd(const Args args) {
    extern __shared__ __attribute__((aligned(16))) unsigned char lds_raw[];
    cg::grid_group grid = cg::this_grid();
    Ctx C;
    C.out = args.out; C.ws = args.ws; C.lds = (LAS unsigned char*)lds_raw; C.ldsg = (char*)lds_raw;
    C.tid = threadIdx.x; C.lane = C.tid & 63; C.wave = __builtin_amdgcn_readfirstlane(C.tid >> 6); C.G = gridDim.x; C.bid = blockIdx.x;
    volatile LAS unsigned* bst = (volatile LAS unsigned*)((LAS unsigned char*)lds_raw + (LDS_BYTES - 64));
    if (threadIdx.x < 2) bst[threadIdx.x] = 0u;
    __syncthreads();
    XcdBarrier xbar; xbar.bar = nullptr; xbar.x = 0; xbar.st = bst;
    if (args.ph_hi - args.ph_lo > 1) xbar = xcd_barrier_post((unsigned*)(args.ws + WS_BAR), bst);
    for (int ph = args.ph_lo; ph < args.ph_hi; ++ph) {
        {
            __attribute__((address_space(1))) unsigned char* w_ = (__attribute__((address_space(1))) unsigned char*)args.ws; __attribute__((address_space(1))) float* o_ = (__attribute__((address_space(1))) float*)args.out; int t_ = threadIdx.x, g_ = gridDim.x, b_ = blockIdx.x;
            unsigned long long ka_ = (unsigned long long)__builtin_amdgcn_kernarg_segment_ptr();
            asm volatile("" : "+s"(w_), "+s"(o_), "+v"(t_), "+s"(g_), "+s"(b_), "+s"(ka_));
            C.ws = (unsigned char*)w_; C.out = (float*)o_; C.a = (const __attribute__((address_space(4))) Args*)ka_; C.G = g_; C.bid = b_; C.tid = t_; C.lane = t_ & 63; C.wave = __builtin_amdgcn_readfirstlane(t_ >> 6);
        }
        unsigned char* ws = C.ws;
        int kind, layer = 0, pass = 0;
        int sub = 0;
        if (ph == 0) { kind = 0; layer = 0; }
        else if (ph == 1) { kind = 1; sub = 0; }
        else if (ph == 2) kind = 2;
        else if (ph == 3) kind = 3;
        else if (ph == 4) { kind = 4; sub = 0; }
        else if (ph == 5) { kind = 5; layer = 0; }
        else if (ph >= 6 && ph <= 8) { layer = 0; const int q = ph - 6; if (q == 2) { kind = 4; sub = 1; } else if (q == 1) kind = 6; else kind = 12; }
        else if (ph == 9) { kind = 0; layer = 1; }
        else if (ph >= 10 && ph <= 19) { layer = 1; const int q = (ph - 10) % 5; pass = (ph - 10) / 5;
            if (q == 0) { kind = (pass == 0) ? 7 : 1; sub = 2; } else if (q == 1) kind = 8; else if (q == 2) kind = 9; else if (q == 3) kind = 10; else { kind = 4; sub = 2; } }
        else if (ph == 20) { kind = 5; layer = 1; }
        else if (ph >= 21 && ph <= 23) { layer = 1; const int q = ph - 21; if (q == 2) { kind = 4; sub = 1; } else if (q == 1) kind = 6; else kind = 12; }
        else kind = 11;

#ifndef PH_MASK
#define PH_MASK 0xFFFF
#endif
#define EN(k) ((PH_MASK >> (k)) & 1)
        const int gw = C.bid * NWAVES + C.wave, NGW = C.G * NWAVES;
        if (kind == 0) { if (EN(0)) {
            if (layer == 0) ph_convert_mixer(C, 0, gw, NGW);
            rms_rows_bf16(layer == 0 ? INP(C, 0) : (const float*)C.out, INP(C, 1) + layer * DM, (bf16_t*)(ws + WS_XN), gw, NGW, C.lane); } }
        else if (kind == 1 || kind == 7) { if (EN(1)) {
            if (kind == 7) ph_ab_small(C);
            const bf16_t* A = (const bf16_t*)(ws + WS_XN); const bf16_t* Bt; int N; bf16_t* O;
            if (sub == 0) { Bt = (const bf16_t*)(ws + WS_W0_IN); N = 2560; O = (bf16_t*)(ws + WS_PROJ); }
            else if (sub == 1) { Bt = (const bf16_t*)(ws + WS_WUP) + (size_t)pass * 2816 * 1024; N = 2816; O = (bf16_t*)(ws + WS_RAWF); }
            else if (sub == 2) { Bt = (const bf16_t*)(ws + WS_WA) + (size_t)pass * 2048 * 1024; N = 2048; O = (bf16_t*)(ws + WS_RAWG); }
            else { Bt = (const bf16_t*)(ws + WS_WZ) + (size_t)pass * 1024 * 1024; N = 1024; O = (bf16_t*)(ws + WS_Z); }
            run_gemm_bf16(C, A, Bt, N, 1024, O);
            if (sub == 0) { int sgw, sngw; if (side_job(C, sgw, sngw)) ph_convert_ffn(C, 0, sgw, sngw); }
        } }
        else if (kind == 2) { if (EN(2)) ph_attn_post(C); }
        else if (kind == 3) { if (EN(3)) ph_attention(C); }
        else if (kind == 4) { if (EN(4)) {
            const bf16_t* A; const bf16_t* Bt; int K; const float* base = C.out;
            if (sub == 0) { A = (const bf16_t*)(ws + WS_AO); Bt = (const bf16_t*)(ws + WS_W0_OUT); K = 1024; base = INP(C, 0); }
            else if (sub == 1) { A = (const bf16_t*)(ws + WS_ACT); Bt = (const bf16_t*)(ws + WS_WDOWN); K = 2816; }
            else { A = (const bf16_t*)(ws + WS_GO); Bt = (const bf16_t*)(ws + WS_WO) + (size_t)pass * 1024 * 1024; K = 1024; }
            run_gemm_res(C, A, Bt, K, base);
        } }
        else if (kind == 5) { if (EN(5)) { rms_rows_bf16(C.out, INP(C, 2) + layer * DM, (bf16_t*)(ws + WS_XN), gw, NGW, C.lane); } }
        else if (kind == 6) { if (EN(6)) ph_ffn_fixup(C, layer); }
        else if (kind == 12) { if (EN(6)) {
            pg8::Gemm g{(const bf16_t*)(ws + WS_XN), (const bf16_t*)(ws + WS_WUP), T_TOK, 5632, 1024}; pg8::StaticOrder S; S.init(T_TOK, 5632, C.G, C.bid);
            pg8::EpiFfn E{(bf16_t*)(ws + WS_ACT), (float*)(ws + WS_EDGE), INP(C, 16) + (size_t)layer * 3 * 5632, INP(C, 17) + (size_t)layer * 5632, 0, (LAS float*)(C.lds + 131072)};
            pg8::gemm_phase<pg8::EpiFfn, pg8::StaticOrder, true, true>(C.lds, g, S, E);
            if (layer == 0) { int sgw, sngw; if (side_job(C, sgw, sngw)) ph_convert_mixer(C, 1, sgw, sngw); } } }
        else if (kind == 8) { if (EN(8)) ph_gdn_prep(C, pass, 0); }
        else if (kind == 9) { if (EN(9)) ph_gdn_scan(C, pass, xbar, pass == 1); }
        else if (kind == 10) { if (EN(10)) {
            pg8::Gemm g{(const bf16_t*)(ws + WS_XN), (const bf16_t*)(ws + WS_WZ) + (size_t)pass * 1024 * 1024, T_TOK, 1024, 1024}; pg8::StaticOrder S; S.init(T_TOK, 1024, C.G, C.bid);
            pg8::EpiGate E{(const bf16_t*)(ws + WS_OF), (const bf16_t*)(ws + WS_OB), (bf16_t*)(ws + WS_GO), INP(C, 13), (LAS float*)(C.lds + 131072)};
            pg8::gemm_phase<pg8::EpiGate, pg8::StaticOrder, true, true>(C.lds, g, S, E); } }
        else rms_rows_f32_inplace(C.out, INP(C, 3), gw, NGW, C.lane);

        if (ph + 1 < args.ph_hi) { if (args.ph_hi > 1000) grid.sync(); else xcd_barrier(xbar); }
#ifdef DBG_XSYNC
        if (ph + 1 < args.ph_hi) { xcd_barrier(xbar); xcd_barrier(xbar); }
#endif
    }
}


#ifdef DBG_DUMP_A
__global__ void dbg_dump(const unsigned short* a, const unsigned short* b, float* out) {
    for (size_t i = (size_t)blockIdx.x * blockDim.x + threadIdx.x; i < (size_t)T_TOK * DM; i += (size_t)gridDim.x * blockDim.x) {
        unsigned short x = a[i], y = b[i]; x &= 0x7fffu; y &= 0x7fffu; if (x > 0x7f00u) x = 0; if (y > 0x7f00u) y = 0;
        float f = __uint_as_float(((unsigned)x) << 16) + __uint_as_float(((unsigned)y) << 16); if (!(f < 1e30f)) f = 1e30f; out[i] = f; }
}
#endif
#ifndef MK_MULTI
#define MK_MULTI 0
#endif
extern "C" void kernel_launch(void* const* d_in, const int* in_sizes, int n_in, void* d_out, int out_size, void* d_ws, size_t ws_size, hipStream_t stream) {
    static int grid = 0;
    if (grid == 0) {
        if (n_in != 19 || out_size != T_TOK * DM || ws_size < WS_END) { fprintf(stderr, "kernel_launch: unexpected shapes (n_in %d out %d ws %zu)\n", n_in, out_size, ws_size); grid = -1; return; }
        int dev = 0, cus = 0, per_cu = 0;
        hipGetDevice(&dev); hipDeviceGetAttribute(&cus, hipDeviceAttributeMultiprocessorCount, dev);
        if (hipFuncSetAttribute((const void*)mega_fwd, hipFuncAttributeMaxDynamicSharedMemorySize, LDS_BYTES) != hipSuccess) { fprintf(stderr, "kernel_launch: hipFuncSetAttribute failed\n"); grid = -1; return; }
        if (hipOccupancyMaxActiveBlocksPerMultiprocessor(&per_cu, (const void*)mega_fwd, NTHR, LDS_BYTES) != hipSuccess || per_cu < 1) { fprintf(stderr, "kernel_launch: occupancy query says %d\n", per_cu); per_cu = 1; }
        (void)hipGetLastError();
        grid = cus * (per_cu > 1 ? 1 : per_cu);
    }
    if (grid < 0) return;
    Args a{};
    for (int i = 0; i < 19; ++i) a.in[i] = (const float*)d_in[i];
    a.out = (float*)d_out; a.ws = (unsigned char*)d_ws;
#if MK_MULTI
#ifndef DBG_STOP
#define DBG_STOP NPH
#endif
#ifndef DBG_REP
#define DBG_REP 0
#endif
    for (int ph = 0; ph < DBG_STOP; ++ph) { a.ph_lo = ph; a.ph_hi = ph + 1; const int nrep = ((DBG_REP >> ph) & 1) ? 3 : 1;
        for (int r = 0; r < nrep; ++r) hipLaunchKernelGGL(mega_fwd, dim3(grid), dim3(NTHR), LDS_BYTES, stream, a); }
#ifdef DBG_DUMP_A
    hipLaunchKernelGGL(dbg_dump, dim3(2048), dim3(256), 0, stream, (const unsigned short*)((char*)d_ws + (size_t)DBG_DUMP_A * MiB), (const unsigned short*)((char*)d_ws + (size_t)DBG_DUMP_B * MiB), (float*)d_out);
#endif
#else
    a.ph_lo = 0; a.ph_hi = NPH;
    if (hipMemsetAsync((char*)d_ws + WS_BAR, 0, XCD_BAR_WORDS * 4, stream) != hipSuccess) { fprintf(stderr, "kernel_launch: memset failed\n"); return; }
    void* kargs[] = {&a};
    hipError_t e = hipLaunchCooperativeKernel((const void*)mega_fwd, dim3(grid), dim3(NTHR), kargs, LDS_BYTES, stream);
    if (e != hipSuccess) fprintf(stderr, "cooperative launch failed: %s (grid %d)\n", hipGetErrorString(e), grid);
#endif
}
```

```cpp
#include <hip/hip_runtime.h>
#include <hip/hip_cooperative_groups.h>
#include <hip/hip_bf16.h>
#include <cstdio>
#include <cstdint>
#include <cmath>
namespace cg = cooperative_groups;
#define MK_MULTI 0

__device__ __forceinline__ int mk_tid() { int t = threadIdx.x; asm volatile("" : "+v"(t)); return t; }
namespace pg8 {
#define PG8_LAS __attribute__((address_space(3)))
typedef unsigned short bf16_t;
typedef short bf16x8 __attribute__((ext_vector_type(8)));
typedef float f32x4 __attribute__((ext_vector_type(4)));
typedef unsigned u32x4 __attribute__((ext_vector_type(4)));
constexpr int BM = 256, BK = 64, HALF = 128, HTB = HALF * BK * 2  , STAGE_BYTES = 8 * HTB, NXCD = 8, WGM = 8;

__host__ __device__ __forceinline__ int lds_byte(int r, int c) { const int st = (r >> 4) * 2 + (c >> 5), rr = r & 15, cc = c & 31, ob = rr * 64 + cc * 2; return st * 1024 + (ob ^ (((ob >> 9) & 1) << 5)); }
__host__ __device__ __forceinline__ void stage_rc(int b, int& R, int& C) { const int st = b / 1024, sb = b % 1024, swz = sb ^ (((sb >> 9) & 1) << 5); R = (st >> 1) * 16 + swz / 64; C = (st & 1) * 32 + (swz % 64) / 2; }
__host__ __device__ __forceinline__ int perm32(int rho) { const int n = rho >> 4, i = rho & 15; return 8 * (i >> 2) + 4 * n + (i & 3); }

struct Unit { int pm, pn; };
struct Gemm { const bf16_t* A; const bf16_t* Bt; int M, N, K; };

struct StaticOrder {
    int nM, nN, nwg, G, c;
    __host__ __device__ void init(int M, int N, int G_, int c_) { nM = M / BM; nN = N / BM; nwg = nM * nN; G = G_; c = c_; }
    __host__ __device__ bool next(int i, Unit& u) const {
        const long L = (long)i * G + c; if (L >= nwg) return false;
        int wgid = (int)L; { const int q = nwg / NXCD, r = nwg % NXCD, xcd = wgid % NXCD, off = wgid / NXCD; wgid = (xcd < r ? xcd * (q + 1) : r * (q + 1) + (xcd - r) * q) + off; }
        const int nig = WGM * nN, gid = wgid / nig, fm = gid * WGM, gsz = (nM - fm) < WGM ? (nM - fm) : WGM;
        u.pm = fm + ((wgid % nig) % gsz); u.pn = (wgid % nig) / gsz; return true;
    }
    __device__ __forceinline__ void a_ready(const Unit&) const {}
    __device__ __forceinline__ void done(const Unit&) const {}
};


typedef float f32x2 __attribute__((ext_vector_type(2)));
typedef __bf16 bf16x2_t __attribute__((ext_vector_type(2)));
__device__ __forceinline__ unsigned cvt_pk_bf16(float lo, float hi) { f32x2 v = {lo, hi}; bf16x2_t r = __builtin_convertvector(v, bf16x2_t); return __builtin_bit_cast(unsigned, r); }

struct EpiBf16 {
    static constexpr bool PERM = true, AFTER_DRAIN = false;
    bf16_t* O; int ldc;
    __device__ __forceinline__ void operator()(const f32x4 (&acc)[2][2][4][2], const Unit& u, int wr, int wc, int fr, int fq) const {
        const int row0 = u.pm * BM + wr * 64 + fr; const int col0 = u.pn * BM + wc * 32 + 8 * fq;
#pragma unroll
        for (int ai = 0; ai < 2; ++ai)
#pragma unroll
            for (int m = 0; m < 4; ++m) { bf16_t* rowp = O + (size_t)(row0 + ai * HALF + m * 16) * ldc + col0;
#pragma unroll
                for (int bj = 0; bj < 2; ++bj) { const f32x4 v0 = acc[ai][bj][m][0], v1 = acc[ai][bj][m][1];
                    u32x4 w; w.x = cvt_pk_bf16(v0[0], v0[1]); w.y = cvt_pk_bf16(v0[2], v0[3]); w.z = cvt_pk_bf16(v1[0], v1[1]); w.w = cvt_pk_bf16(v1[2], v1[3]);
                    *(u32x4*)(rowp + bj * HALF) = w; } }
    }
};
struct EpiF32 {
    static constexpr bool PERM = true, AFTER_DRAIN = false;
    float* O; int ldc;
    __device__ __forceinline__ void operator()(const f32x4 (&acc)[2][2][4][2], const Unit& u, int wr, int wc, int fr, int fq) const {
        const int row0 = u.pm * BM + wr * 64 + fr; const int col0 = u.pn * BM + wc * 32 + 8 * fq;
#pragma unroll
        for (int ai = 0; ai < 2; ++ai)
#pragma unroll
            for (int m = 0; m < 4; ++m) { float* rowp = O + (size_t)(row0 + ai * HALF + m * 16) * ldc + col0;
#pragma unroll
                for (int bj = 0; bj < 2; ++bj) { *(f32x4*)(rowp + bj * HALF) = acc[ai][bj][m][0]; *(f32x4*)(rowp + bj * HALF + 4) = acc[ai][bj][m][1]; } }
    }
};
struct EpiRes {
    static constexpr bool PERM = false, AFTER_DRAIN = false;
    const float* base; float* out; int ldc;
    __device__ __forceinline__ void operator()(const f32x4 (&acc)[2][2][4][2], const Unit& u, int wr, int wc, int fr, int fq) const {
        const int row0 = u.pm * BM + wr * 64 + fr; const int col0 = u.pn * BM + wc * 32 + 4 * fq;
#pragma unroll
        for (int ai = 0; ai < 2; ++ai)
#pragma unroll
            for (int m = 0; m < 4; ++m) { const size_t off = (size_t)(row0 + ai * HALF + m * 16) * ldc + col0;
#pragma unroll
                for (int bj = 0; bj < 2; ++bj)
#pragma unroll
                    for (int n = 0; n < 2; ++n) { const f32x4 b = *(const f32x4*)(base + off + bj * HALF + n * 16); *(f32x4*)(out + off + bj * HALF + n * 16) = b + acc[ai][bj][m][n]; } }
    }
};

struct EpiGate {
    static constexpr bool PERM = true, AFTER_DRAIN = false;
    const bf16_t* OF; const bf16_t* OB; bf16_t* GO; const float* gain; PG8_LAS float* tab;
    __device__ __forceinline__ void operator()(const f32x4 (&acc)[2][2][4][2], const Unit& u, int wr, int wc, int fr, int fq) const {
        const int tid = mk_tid();
        {
            const int row = tid >> 1, hd = tid & 1; const size_t off = (size_t)(u.pm * BM + row) * 2048 + u.pn * BM + hd * HALF;
            float ss = 0.f;
#pragma unroll 4
            for (int j = 0; j < 16; ++j) { const u32x4 a = *(const u32x4*)(OF + off + 8 * j), b = *(const u32x4*)(OB + off + 8 * j);
#pragma unroll
                for (int q = 0; q < 4; ++q) { const float lo = __uint_as_float(a[q] << 16) + __uint_as_float(b[q] << 16), hi = __uint_as_float(a[q] & 0xffff0000u) + __uint_as_float(b[q] & 0xffff0000u); ss += lo * lo + hi * hi; } }
            tab[row * 2 + hd] = rsqrtf(ss * (1.f / 128.f) + 1e-6f);
        }
        asm volatile("s_waitcnt lgkmcnt(0)" ::: "memory"); __builtin_amdgcn_s_barrier(); asm volatile("" ::: "memory");
        const int row0 = wr * 64 + fr; const int colw = wc * 32 + 8 * fq;
        f32x4 g0 = *(const f32x4*)(gain + colw), g1 = *(const f32x4*)(gain + colw + 4);
#pragma unroll
        for (int ai = 0; ai < 2; ++ai)
#pragma unroll
            for (int m = 0; m < 4; ++m) { const int rt = row0 + ai * HALF + m * 16;
#pragma unroll
                for (int bj = 0; bj < 2; ++bj) { const size_t off = (size_t)(u.pm * BM + rt) * 1024 + u.pn * BM + bj * HALF + colw, offo = off + (size_t)(u.pm * BM + rt) * 1024;
                    const float rs = tab[rt * 2 + bj];
                    const u32x4 a = *(const u32x4*)(OF + offo), b = *(const u32x4*)(OB + offo);
                    const f32x4 z0 = acc[ai][bj][m][0], z1 = acc[ai][bj][m][1];
                    float o[8];
#pragma unroll
                    for (int q = 0; q < 4; ++q) { o[2 * q] = __uint_as_float(a[q] << 16) + __uint_as_float(b[q] << 16); o[2 * q + 1] = __uint_as_float(a[q] & 0xffff0000u) + __uint_as_float(b[q] & 0xffff0000u); }
#pragma unroll
                    for (int e = 0; e < 4; ++e) { o[e] = o[e] * rs * g0[e] * (z0[e] / (1.f + __expf(-z0[e]))); o[4 + e] = o[4 + e] * rs * g1[e] * (z1[e] / (1.f + __expf(-z1[e]))); }
                    u32x4 w; w.x = cvt_pk_bf16(o[0], o[1]); w.y = cvt_pk_bf16(o[2], o[3]); w.z = cvt_pk_bf16(o[4], o[5]); w.w = cvt_pk_bf16(o[6], o[7]);
                    *(u32x4*)(GO + off) = w; }
                asm volatile("" ::: "memory"); }
        asm volatile("s_waitcnt lgkmcnt(0)" ::: "memory"); __builtin_amdgcn_s_barrier(); asm volatile("" ::: "memory");
    }
};

typedef unsigned u32x2 __attribute__((ext_vector_type(2)));
__device__ __forceinline__ float dpp_ror1(float v)  { return __int_as_float(__builtin_amdgcn_update_dpp(0, __float_as_int(v), 0x121, 0xF, 0xF, false)); }
__device__ __forceinline__ float dpp_ror15(float v) { return __int_as_float(__builtin_amdgcn_update_dpp(0, __float_as_int(v), 0x12F, 0xF, 0xF, false)); }
struct EpiFfn {
    static constexpr bool PERM = true, AFTER_DRAIN = false;
    bf16_t* ACT; float* EDGE; const float* cw; const float* cb; int chan0; PG8_LAS float* bt;
    __device__ __forceinline__ void operator()(const f32x4 (&acc)[2][2][4][2], const Unit& u, int wr, int wc, int fr, int fq) const {
        const int chl = wc * 32 + 8 * fq;
        const int cha = chan0 + u.pn * 128 + chl, chb = 2816 + cha;
        PG8_LAS float* wt = bt + 2048;
        { const int t = mk_tid(); if (t < 256) { const int ch = (t < 128) ? (chan0 + u.pn * 128 + t) : (2816 + chan0 + u.pn * 128 + (t - 128));
            wt[t] = cw[ch]; wt[256 + t] = cw[5632 + ch]; wt[512 + t] = cw[2 * 5632 + ch]; wt[768 + t] = cb[ch]; } }
#pragma unroll
        for (int ai = 0; ai < 2; ++ai) { const int beta = 2 * ai + wr;
#pragma unroll
            for (int bj = 0; bj < 2; ++bj)
#pragma unroll
                for (int n = 0; n < 2; ++n) { const int col = 128 * bj + chl + 4 * n;
                    if (fr == 0)  *(PG8_LAS f32x4*)(bt + (2 * beta) * 256 + col) = acc[ai][bj][0][n];
                    if (fr == 15) *(PG8_LAS f32x4*)(bt + (2 * beta + 1) * 256 + col) = acc[ai][bj][3][n];
                    float* eg = EDGE + (size_t)((u.pm * 22 + u.pn) * 4) * 256 + col;
                    if (beta == 0 && fr < 2)  *(f32x4*)(eg + fr * 256) = acc[ai][bj][0][n];
                    if (beta == 3 && fr >= 14) *(f32x4*)(eg + (fr - 12) * 256) = acc[ai][bj][3][n]; } }
        asm volatile("s_waitcnt lgkmcnt(0)" ::: "memory"); __builtin_amdgcn_s_barrier(); asm volatile("" ::: "memory");
#pragma unroll
        for (int n = 0; n < 2; ++n) {
            f32x4 tp[2][4];
#pragma unroll
            for (int bj = 0; bj < 2; ++bj)
#pragma unroll
                for (int s = 0; s < 4; ++s) tp[bj][s] = *(const PG8_LAS f32x4*)(wt + s * 256 + 128 * bj + chl + 4 * n);
#pragma unroll
            for (int ai = 0; ai < 2; ++ai) { const int beta = 2 * ai + wr;
#pragma unroll
                for (int m = 0; m < 4; ++m) {
                    const int trow = 128 * ai + 64 * wr + 16 * m + fr;
                    f32x4 yy[2];
#pragma unroll
                    for (int bj = 0; bj < 2; ++bj) {
                        const f32x4 cur = acc[ai][bj][m][n]; f32x4 pv, nx;
                        const int col = 128 * bj + chl + 4 * n;
                        f32x4 pe, ne;
                        if (m > 0) { const f32x4 t = acc[ai][bj][m > 0 ? m - 1 : 0][n]; pe = (f32x4){dpp_ror1(t[0]), dpp_ror1(t[1]), dpp_ror1(t[2]), dpp_ror1(t[3])}; }
                        else pe = (beta > 0) ? *(const PG8_LAS f32x4*)(bt + (2 * (beta - 1) + 1) * 256 + col) : (f32x4){0.f, 0.f, 0.f, 0.f};
                        if (m < 3) { const f32x4 t = acc[ai][bj][m < 3 ? m + 1 : 3][n]; ne = (f32x4){dpp_ror15(t[0]), dpp_ror15(t[1]), dpp_ror15(t[2]), dpp_ror15(t[3])}; }
                        else ne = (beta < 3) ? *(const PG8_LAS f32x4*)(bt + (2 * (beta + 1)) * 256 + col) : (f32x4){0.f, 0.f, 0.f, 0.f};
#pragma unroll
                        for (int e = 0; e < 4; ++e) {
                            pv[e] = __int_as_float(__builtin_amdgcn_update_dpp(__float_as_int(pe[e]), __float_as_int(cur[e]), 0x111, 0xF, 0xF, false));
                            nx[e] = __int_as_float(__builtin_amdgcn_update_dpp(__float_as_int(ne[e]), __float_as_int(cur[e]), 0x101, 0xF, 0xF, false)); }
                        yy[bj] = tp[bj][0] * pv + tp[bj][1] * cur + tp[bj][2] * nx + tp[bj][3];
                    }
                    float o[4];
#pragma unroll
                    for (int e = 0; e < 4; ++e) o[e] = yy[0][e] * __builtin_amdgcn_rcpf(1.f + __expf(-yy[0][e])) * yy[1][e];
                    if (trow != 0 && trow != 255) { u32x2 w; w.x = cvt_pk_bf16(o[0], o[1]); w.y = cvt_pk_bf16(o[2], o[3]);
                        *(u32x2*)(ACT + (size_t)(u.pm * BM + trow) * 2816 + cha + 4 * n) = w; }
                } }
        }
        asm volatile("s_waitcnt lgkmcnt(0)" ::: "memory"); __builtin_amdgcn_s_barrier(); asm volatile("" ::: "memory");
    }
};

template <class Epi, class Sched, bool ALIGN_EPI = false, bool SP2 = false>
__device__ __forceinline__ void gemm_phase(PG8_LAS unsigned char* lds, const Gemm g, const Sched& S, const Epi& E) {
    const int tid = mk_tid(), wid = __builtin_amdgcn_readfirstlane(tid >> 6), lane = tid & 63, wr = wid >> 2, wc = wid & 3, fr = lane & 15, fq = lane >> 4;
    const int K = g.K, nt = K / BK;
    unsigned voffA[2], voffB[2];
#pragma unroll
    for (int i = 0; i < 2; ++i) { int R, C; stage_rc(tid * 16 + i * 8192, R, C); const int Rb = Epi::PERM ? ((R & ~31) + perm32(R & 31)) : R;
        voffA[i] = (unsigned)(R * K + C) * 2u; voffB[i] = (unsigned)(Rb * K + C) * 2u; }
    const size_t kstep = (size_t)(BK * 2);
    const size_t hstep = (size_t)HALF * K * 2;
    const size_t tstep = 2 * hstep;
    const unsigned ldsw = (unsigned)wid * 1024u;
    const int aoff = lds_byte(wr * 64 + fr, fq * 8), boff = lds_byte(wc * 32 + fr, fq * 8);
#define PG8_SA(b, h) (((b) * 2 + (h)) * HTB)
#define PG8_SB(b, h) ((4 + (b) * 2 + (h)) * HTB)
#define PG8_STAGE(bufoff, gbase, voff) do { _Pragma("unroll") for (int _i = 0; _i < 2; ++_i) \
        __builtin_amdgcn_global_load_lds((const unsigned*)((const char*)(gbase) + (voff)[_i]), (PG8_LAS unsigned*)(lds + (bufoff) + ldsw + _i * 8192), 16, 0, 0); } while (0)
#define PG8_LDA(dst, b, h) do { _Pragma("unroll") for (int m = 0; m < 4; ++m) _Pragma("unroll") for (int k = 0; k < 2; ++k) dst[m][k] = *(const PG8_LAS bf16x8*)(lds + PG8_SA(b, h) + aoff + m * 2048 + k * 1024); } while (0)
#define PG8_LDB(dst, b, h) do { _Pragma("unroll") for (int n = 0; n < 2; ++n) _Pragma("unroll") for (int k = 0; k < 2; ++k) dst[n][k] = *(const PG8_LAS bf16x8*)(lds + PG8_SB(b, h) + boff + n * 2048 + k * 1024); } while (0)
#define PG8_MMA(ai, bj, At, Bt) do { __builtin_amdgcn_s_setprio(1); _Pragma("unroll") for (int m = 0; m < 4; ++m) _Pragma("unroll") for (int n = 0; n < 2; ++n) _Pragma("unroll") for (int k = 0; k < 2; ++k) \
        acc[ai][bj][m][n] = __builtin_amdgcn_mfma_f32_16x16x32_bf16(Bt[n][k], At[m][k], acc[ai][bj][m][n], 0, 0, 0); __builtin_amdgcn_s_setprio(0); } while (0)
#define PG8_WAIT_V(n) asm volatile("s_waitcnt vmcnt(" #n ")" ::: "memory")
#define PG8_WAIT_L(n) asm volatile("s_waitcnt lgkmcnt(" #n ")" ::: "memory")
#define PG8_BAR __builtin_amdgcn_s_barrier()
#define PG8_SCHED __builtin_amdgcn_sched_barrier(0)
    Unit cur, nxt; int ui = 0;
    if (!S.next(0, cur)) return;
    f32x4 acc[2][2][4][2];
    float zr_ = 0.f; asm volatile("" : "+v"(zr_));
#pragma unroll
    for (int a = 0; a < 2; ++a)
#pragma unroll
        for (int b = 0; b < 2; ++b)
#pragma unroll
            for (int m = 0; m < 4; ++m)
#pragma unroll
                for (int n = 0; n < 2; ++n) acc[a][b][m][n] = (f32x4){zr_, zr_, zr_, zr_};
    bf16x8 At[4][2], B0[2][2], B1[2][2];
    const char* cA = (const char*)g.A + (size_t)cur.pm * tstep; const char* cB = (const char*)g.Bt + (size_t)cur.pn * tstep;
    S.a_ready(cur);
    if constexpr (SP2) {
        PG8_STAGE(PG8_SB(0, 0), cB, voffB); PG8_STAGE(PG8_SB(0, 1), cB + hstep, voffB); PG8_STAGE(PG8_SA(0, 0), cA, voffA); PG8_STAGE(PG8_SA(0, 1), cA + hstep, voffA);
        if (wr == 1) PG8_BAR;
        PG8_WAIT_V(2); PG8_BAR;
        PG8_STAGE(PG8_SB(1, 0), cB + kstep, voffB); PG8_STAGE(PG8_SA(1, 0), cA + kstep, voffA); PG8_STAGE(PG8_SB(1, 1), cB + hstep + kstep, voffB);
        PG8_WAIT_V(6); PG8_BAR;
    } else {
        PG8_STAGE(PG8_SB(0, 0), cB, voffB); PG8_STAGE(PG8_SA(0, 0), cA, voffA); PG8_STAGE(PG8_SB(0, 1), cB + hstep, voffB); PG8_STAGE(PG8_SA(0, 1), cA + hstep, voffA);
        if (wr == 1) PG8_BAR;
        PG8_WAIT_V(4); PG8_BAR;
        PG8_STAGE(PG8_SB(1, 0), cB + kstep, voffB); PG8_STAGE(PG8_SA(1, 0), cA + kstep, voffA); PG8_STAGE(PG8_SB(1, 1), cB + hstep + kstep, voffB);
        PG8_WAIT_V(6); PG8_BAR;
    }
    for (;;) {
        const bool has_next = S.next(ui + 1, nxt);
        const char* nA = has_next ? (const char*)g.A + (size_t)nxt.pm * tstep : cA; const char* nB = has_next ? (const char*)g.Bt + (size_t)nxt.pn * tstep : cB;
        for (int t = 0; t < nt; t += 2) {
            const bool last = (t == nt - 2);
            const char* a1 = cA + (size_t)(t + 1) * kstep;
            const char* a2 = last ? nA : cA + (size_t)(t + 2) * kstep; const char* b2 = last ? nB : cB + (size_t)(t + 2) * kstep;
            const char* a3 = a2 + kstep; const char* b3 = b2 + kstep;
            if (last && has_next) S.a_ready(nxt);
            if constexpr (SP2) {
            PG8_LDB(B0, 0, 0); PG8_LDB(B1, 0, 1); PG8_SCHED; PG8_LDA(At, 0, 0); PG8_STAGE(PG8_SA(1, 1), a1 + hstep, voffA);
            PG8_WAIT_V(8); PG8_WAIT_L(0); PG8_BAR; PG8_MMA(0, 0, At, B0); PG8_MMA(0, 1, At, B1); PG8_BAR; PG8_SCHED;
            PG8_LDA(At, 0, 1); PG8_STAGE(PG8_SB(0, 0), b2, voffB); PG8_STAGE(PG8_SB(0, 1), b2 + hstep, voffB); PG8_STAGE(PG8_SA(0, 0), a2, voffA);
            PG8_WAIT_V(8); PG8_WAIT_L(0); PG8_BAR; PG8_MMA(1, 0, At, B0); PG8_MMA(1, 1, At, B1); PG8_BAR; PG8_SCHED;
            PG8_LDB(B0, 1, 0); PG8_LDB(B1, 1, 1); PG8_SCHED; PG8_LDA(At, 1, 0); PG8_STAGE(PG8_SA(0, 1), a2 + hstep, voffA);
            PG8_WAIT_V(8); PG8_WAIT_L(0); PG8_BAR; PG8_MMA(0, 0, At, B0); PG8_MMA(0, 1, At, B1); PG8_BAR; PG8_SCHED;
            PG8_LDA(At, 1, 1); PG8_STAGE(PG8_SB(1, 0), b3, voffB); PG8_STAGE(PG8_SB(1, 1), b3 + hstep, voffB); PG8_STAGE(PG8_SA(1, 0), a3, voffA);
            PG8_WAIT_V(8); PG8_WAIT_L(0); PG8_BAR; PG8_MMA(1, 0, At, B0); PG8_MMA(1, 1, At, B1); PG8_BAR; PG8_SCHED;
            } else {
            PG8_LDB(B0, 0, 0); PG8_SCHED; PG8_LDA(At, 0, 0); PG8_STAGE(PG8_SA(1, 1), a1 + hstep, voffA);
            PG8_WAIT_L(8); PG8_BAR; PG8_WAIT_L(0); PG8_MMA(0, 0, At, B0); PG8_BAR; PG8_SCHED;
            PG8_LDB(B1, 0, 1); PG8_STAGE(PG8_SB(0, 0), b2, voffB);
            PG8_BAR; PG8_WAIT_L(0); PG8_MMA(0, 1, At, B1); PG8_BAR;
            PG8_LDA(At, 0, 1); PG8_STAGE(PG8_SA(0, 0), a2, voffA);
            PG8_BAR; PG8_WAIT_L(0); PG8_MMA(1, 0, At, B0); PG8_BAR; PG8_SCHED;
            PG8_STAGE(PG8_SB(0, 1), b2 + hstep, voffB);
            PG8_WAIT_V(6); PG8_BAR; PG8_MMA(1, 1, At, B1); PG8_BAR;
            PG8_LDB(B0, 1, 0); PG8_SCHED; PG8_LDA(At, 1, 0); PG8_STAGE(PG8_SA(0, 1), a2 + hstep, voffA);
            PG8_WAIT_L(8); PG8_BAR; PG8_WAIT_L(0); PG8_MMA(0, 0, At, B0); PG8_BAR; PG8_SCHED;
            PG8_LDB(B1, 1, 1); PG8_STAGE(PG8_SB(1, 0), b3, voffB);
            PG8_BAR; PG8_WAIT_L(0); PG8_MMA(0, 1, At, B1); PG8_BAR;
            PG8_LDA(At, 1, 1); PG8_STAGE(PG8_SA(1, 0), a3, voffA);
            PG8_BAR; PG8_WAIT_L(0); PG8_MMA(1, 0, At, B0); PG8_BAR; PG8_SCHED;
            PG8_STAGE(PG8_SB(1, 1), b3 + hstep, voffB);
            PG8_WAIT_V(6); PG8_BAR; PG8_MMA(1, 1, At, B1); PG8_BAR;
            }
        }
        if constexpr (ALIGN_EPI) { if (wr == 0) PG8_BAR; }
        if constexpr (!Epi::AFTER_DRAIN) { E(acc, cur, wr, wc, fr, fq); S.done(cur); }
        if (!has_next) break;
#pragma unroll
        for (int a = 0; a < 2; ++a)
#pragma unroll
            for (int b = 0; b < 2; ++b)
#pragma unroll
                for (int m = 0; m < 4; ++m)
#pragma unroll
                    for (int n = 0; n < 2; ++n) acc[a][b][m][n] = (f32x4){zr_, zr_, zr_, zr_};
        cur = nxt; cA = nA; cB = nB; ++ui;
        if constexpr (ALIGN_EPI) { if (wr == 1) PG8_BAR; }
    }
    PG8_WAIT_V(0);
    if constexpr (!ALIGN_EPI) { if (wr == 0) PG8_BAR; }
    PG8_BAR;
    if constexpr (Epi::AFTER_DRAIN) { E.fused(acc, cur, wr, wc, fr, fq, lds, wid, lane); S.done(cur); }
#undef PG8_SA
#undef PG8_SB
#undef PG8_STAGE
#undef PG8_LDA
#undef PG8_LDB
#undef PG8_MMA
#undef PG8_WAIT_V
#undef PG8_WAIT_L
#undef PG8_BAR
#undef PG8_SCHED
}
}

namespace attn {
using bf16 = __hip_bfloat16;
constexpr int   D = 128, NW = 8, QBLK = 32, KVBLK = 64;
constexpr float SCALE = 0.088388347648318440f;
constexpr float THR = 8.f;
constexpr int SDEPTH = 2;
constexpr int LDQ = 2560, LDK = 2560, LDO = 1024;
constexpr size_t SHM_V = KVBLK * D * 2, SHM_K = KVBLK * D * 2, SHM_ATTN = 2 * SHM_V + 2 * SHM_K + NW * 64 * 4;
using bf16x8 = __attribute__((ext_vector_type(8))) short;
using s16x4  = __attribute__((ext_vector_type(4))) short;
using f32x16 = __attribute__((ext_vector_type(16))) float;
using f32x8  = __attribute__((ext_vector_type(8))) float;
using u32x4  = __attribute__((ext_vector_type(4))) unsigned;
#define KSWZ(row, colB) ((row) * 256 + ((colB) ^ (((row) & 7) << 4)))
#define SBAR() __builtin_amdgcn_sched_barrier(0)
__device__ __forceinline__ int crow(int r, int hi) { return (r & 3) + 8 * (r >> 2) + 4 * hi; }
__device__ __forceinline__ unsigned cvtpk(float lo, float hi) {
  unsigned r; asm volatile("v_cvt_pk_bf16_f32 %0, %1, %2" : "=v"(r) : "v"(lo), "v"(hi)); return r;
}
template <typename TIn> struct Stage;
template <> struct Stage<bf16>  { using T = bf16x8;
  __device__ static __forceinline__ T ld8(const bf16* p) { return *reinterpret_cast<const bf16x8*>(p); }
  __device__ static __forceinline__ bf16x8 tobf(T x) { return x; } };
template <> struct Stage<float> { using T = f32x8;
  __device__ static __forceinline__ T ld8(const float* p) { return *reinterpret_cast<const f32x8*>(p); }
  __device__ static __forceinline__ bf16x8 tobf(T x) {
    u32x4 w = {cvtpk(x[0], x[1]), cvtpk(x[2], x[3]), cvtpk(x[4], x[5]), cvtpk(x[6], x[7])}; return *reinterpret_cast<bf16x8*>(&w); } };

__device__ __forceinline__ void partialSM(f32x16& p0, f32x16& p1, float& m_reg, float& mn, float& alpha) {
  constexpr float C = SCALE * 1.4426950408889634f;
  float pmax = p0[0]; for (int r = 1; r < 16; ++r) pmax = fmaxf(pmax, p0[r]); for (int r = 0; r < 16; ++r) pmax = fmaxf(pmax, p1[r]);
  { auto rr = __builtin_amdgcn_permlane32_swap(__float_as_uint(pmax), __float_as_uint(pmax), false, false);
    pmax = fmaxf(__uint_as_float(rr[0]), __uint_as_float(rr[1])); }
  if (__builtin_expect(__all(pmax - m_reg <= THR / SCALE), 1)) { mn = m_reg; alpha = 1.f; }
  else { mn = fmaxf(m_reg, pmax); alpha = __builtin_amdgcn_exp2f((m_reg - mn) * C); m_reg = mn; }
  float mnC = -mn * C;
  for (int r = 0; r < 16; ++r) p0[r] = fmaf(p0[r], C, mnC); for (int r = 0; r < 16; ++r) p1[r] = fmaf(p1[r], C, mnC);
  for (int r = 0; r < 16; ++r) p0[r] = __builtin_amdgcn_exp2f(p0[r]);
}
__device__ __forceinline__ void finishSM(f32x16& p0, f32x16& p1, float alpha, float& l_reg, bf16x8& pa0, bf16x8& pa1, bf16x8& pa2, bf16x8& pa3) {
  for (int r = 0; r < 16; ++r) p1[r] = __builtin_amdgcn_exp2f(p1[r]);
  float ps = 0; for (int r = 0; r < 16; ++r) ps += p0[r]; for (int r = 0; r < 16; ++r) ps += p1[r];
  { auto rr = __builtin_amdgcn_permlane32_swap(__float_as_uint(ps), __float_as_uint(ps), false, false);
    ps = __uint_as_float(rr[0]) + __uint_as_float(rr[1]); }
  l_reg = l_reg * alpha + ps;
#define PK4(P, BASE, OUT) do { unsigned a0 = cvtpk(P[BASE + 0], P[BASE + 1]), a1 = cvtpk(P[BASE + 2], P[BASE + 3]);   \
    unsigned b0 = cvtpk(P[BASE + 4], P[BASE + 5]), b1 = cvtpk(P[BASE + 6], P[BASE + 7]);                              \
    auto r0 = __builtin_amdgcn_permlane32_swap(a0, b0, false, false); auto r1 = __builtin_amdgcn_permlane32_swap(a1, b1, false, false); \
    u32x4 w = {r0[0], r1[0], r0[1], r1[1]}; OUT = *reinterpret_cast<bf16x8*>(&w); } while (0)
  PK4(p0, 0, pa0); PK4(p0, 8, pa1); PK4(p1, 0, pa2); PK4(p1, 8, pa3);
#undef PK4
}
__device__ __forceinline__ void qkt(f32x16& p0, f32x16& p1, const bf16* Ks, const bf16x8* qr, int r32, int hi) {
  p0 = f32x16{}; p1 = f32x16{};
  for (int d0 = 0; d0 < 8; ++d0) { int cb = (d0 * 16 + hi * 8) * 2;
    bf16x8 b0 = *reinterpret_cast<const bf16x8*>((const char*)Ks + KSWZ(r32, cb));
    bf16x8 b1 = *reinterpret_cast<const bf16x8*>((const char*)Ks + KSWZ(32 + r32, cb));
    p0 = __builtin_amdgcn_mfma_f32_32x32x16_bf16(b0, qr[d0], p0, 0, 0, 0);
    p1 = __builtin_amdgcn_mfma_f32_32x32x16_bf16(b1, qr[d0], p1, 0, 0, 0); }
}
__device__ __forceinline__ int v_st(int k, int c) { const int kk = (k & ~0xC) | ((k & 4) << 1) | ((k & 8) >> 1); return ((kk >> 3) * 4 + (c >> 5)) * 512 + ((kk & 7) * 32 + (c & 31)) * 2; }
__device__ __forceinline__ int v_rd_base(int lane) { return ((lane & 3) << 3) | (((lane >> 2) & 3) << 6) | (((lane >> 4) & 1) << 5) | (((lane >> 5) & 1) << 8); }
constexpr int v_rd_off(int d0, int ks, int half) { return d0 * 512 + ks * 4096 + half * 2048; }
template <int OFF> __device__ __forceinline__ s16x4 tr_read(int vb) {
  s16x4 r; asm volatile("ds_read_b64_tr_b16 %0, %1 offset:%2" : "=&v"(r) : "v"(vb), "i"(OFF) : "memory"); return r;
}
template <int D0> __device__ __forceinline__ void pv_one(f32x16& od, int vb, bf16x8 pa0, bf16x8 pa1, bf16x8 pa2, bf16x8 pa3) {
  const s16x4 l0 = tr_read<v_rd_off(D0, 0, 0)>(vb), h0 = tr_read<v_rd_off(D0, 0, 1)>(vb), l1 = tr_read<v_rd_off(D0, 1, 0)>(vb), h1 = tr_read<v_rd_off(D0, 1, 1)>(vb);
  const s16x4 l2 = tr_read<v_rd_off(D0, 2, 0)>(vb), h2 = tr_read<v_rd_off(D0, 2, 1)>(vb), l3 = tr_read<v_rd_off(D0, 3, 0)>(vb), h3 = tr_read<v_rd_off(D0, 3, 1)>(vb);
  asm volatile("s_waitcnt lgkmcnt(0)" ::: "memory"); SBAR();
#define PK(L, H) (bf16x8){L[0], L[1], L[2], L[3], H[0], H[1], H[2], H[3]}
  od = __builtin_amdgcn_mfma_f32_32x32x16_bf16(pa0, PK(l0, h0), od, 0, 0, 0);
  od = __builtin_amdgcn_mfma_f32_32x32x16_bf16(pa1, PK(l1, h1), od, 0, 0, 0);
  od = __builtin_amdgcn_mfma_f32_32x32x16_bf16(pa2, PK(l2, h2), od, 0, 0, 0);
  od = __builtin_amdgcn_mfma_f32_32x32x16_bf16(pa3, PK(l3, h3), od, 0, 0, 0);
#undef PK
}
__device__ __forceinline__ void pv_d0(f32x16* o, int vb, bf16x8 pa0, bf16x8 pa1, bf16x8 pa2, bf16x8 pa3) {
  pv_one<0>(o[0], vb, pa0, pa1, pa2, pa3); pv_one<1>(o[1], vb, pa0, pa1, pa2, pa3); pv_one<2>(o[2], vb, pa0, pa1, pa2, pa3); pv_one<3>(o[3], vb, pa0, pa1, pa2, pa3);
}

__device__ __forceinline__ void attn_dense_body(const bf16* __restrict__ Qb, const bf16* __restrict__ Kh, const bf16* __restrict__ Vh,
                                                const unsigned short* __restrict__ Gb, unsigned short* __restrict__ Ob, int seq, char* lds) {
  using TQ = bf16; using St = Stage<bf16>; using SQ = Stage<TQ>;
  const int tid = mk_tid(), wid = __builtin_amdgcn_readfirstlane(tid >> 6), lane = tid & 63, r32 = lane & 31, hi = lane >> 5;
  bf16* V_lds = (bf16*)lds; bf16* K_lds = (bf16*)(lds + 2 * SHM_V);
  float* ws = (float*)(lds + 2 * SHM_V + 2 * SHM_K) + wid * 64; float* li_l = ws; float* al_l = ws + 32;
  float m_reg = -1e30f, l_reg = 0; f32x16 o[4] = {}; bf16x8 qr[8];
  const TQ* Qw = Qb + (long)(wid * QBLK + r32) * LDQ + hi * 8;
#pragma unroll
  for (int d0 = 0; d0 < 8; ++d0) qr[d0] = SQ::tobf(SQ::ld8(Qw + d0 * 16));
  const int sr = tid >> 4, sc = (tid & 15) * 8, vst0 = v_st(sr, sc), vst1 = v_st(32 + sr, sc);
  const int vb0 = (int)(uintptr_t)V_lds + v_rd_base(lane);
  struct { typename St::T vs0, vs1, ks0, ks1; } sr_[SDEPTH];
#define SLOAD(i, k0) do { sr_[i].vs0 = St::ld8(&Vh[(long)((k0) + sr) * LDK + sc]); sr_[i].vs1 = St::ld8(&Vh[(long)((k0) + 32 + sr) * LDK + sc]); \
    sr_[i].ks0 = St::ld8(&Kh[(long)((k0) + sr) * LDK + sc]); sr_[i].ks1 = St::ld8(&Kh[(long)((k0) + 32 + sr) * LDK + sc]); } while (0)
#define SWRITE(b, i) do { *(bf16x8*)((char*)V_lds + (b) * SHM_V + vst0) = St::tobf(sr_[i].vs0);          \
    *(bf16x8*)((char*)V_lds + (b) * SHM_V + vst1) = St::tobf(sr_[i].vs1); int kc = sc * 2;               \
    *(bf16x8*)((char*)K_lds + (b) * SHM_K + KSWZ(sr, kc)) = St::tobf(sr_[i].ks0);                       \
    *(bf16x8*)((char*)K_lds + (b) * SHM_K + KSWZ(32 + sr, kc)) = St::tobf(sr_[i].ks1); } while (0)
#define SWAIT() do { if constexpr (SDEPTH == 2) asm volatile("s_waitcnt vmcnt(4)" ::: "memory"); else asm volatile("s_waitcnt vmcnt(0)" ::: "memory"); } while (0)
#define RESC(a) do { if (__any((a) < 1.f)) { if (hi == 0) al_l[r32] = (a); asm volatile("s_waitcnt lgkmcnt(0)" ::: "memory"); \
    for (int d = 0; d < 4; ++d) for (int r = 0; r < 16; ++r) o[d][r] *= al_l[crow(r, hi)]; } } while (0)
  f32x16 pA0, pA1, pB0, pB1; float mnA, mnB, alA, alB; bf16x8 pa0, pa1, pa2, pa3; const int NT = seq / KVBLK;
  constexpr int SE = 0, SO = SDEPTH - 1;
  SLOAD(SE, 0); asm volatile("s_waitcnt vmcnt(0)" ::: "memory"); SWRITE(0, SE); __syncthreads();
  qkt(pA0, pA1, K_lds, qr, r32, hi); partialSM(pA0, pA1, m_reg, mnA, alA);
  SLOAD(SO, KVBLK); if constexpr (SDEPTH == 2) { if (2 < NT) SLOAD(SE, 2 * KVBLK); }
  SWAIT(); SWRITE(1, SO); __syncthreads();
  for (int j = 1; j + 1 < NT; j += 2) {
    SBAR(); qkt(pB0, pB1, (bf16*)((char*)K_lds + SHM_K), qr, r32, hi);
    finishSM(pA0, pA1, alA, l_reg, pa0, pa1, pa2, pa3); SBAR();
    SLOAD(SO, (j + SDEPTH) * KVBLK); SBAR();
    pv_d0(o, vb0, pa0, pa1, pa2, pa3); partialSM(pB0, pB1, m_reg, mnB, alB);
    __syncthreads(); SWAIT(); SWRITE(0, SE);
    RESC(alB); __syncthreads();
    SBAR(); qkt(pA0, pA1, K_lds, qr, r32, hi);
    finishSM(pB0, pB1, alB, l_reg, pa0, pa1, pa2, pa3); SBAR();
    if (SDEPTH == 1 || j + 3 < NT) SLOAD(SE, (j + 1 + SDEPTH) * KVBLK); SBAR();
    pv_d0(o, vb0 + (int)SHM_V, pa0, pa1, pa2, pa3); partialSM(pA0, pA1, m_reg, mnA, alA);
    __syncthreads(); SWAIT(); SWRITE(1, SO);
    RESC(alA); __syncthreads();
  }
  SBAR(); qkt(pB0, pB1, (bf16*)((char*)K_lds + SHM_K), qr, r32, hi);
  finishSM(pA0, pA1, alA, l_reg, pa0, pa1, pa2, pa3); SBAR();
  pv_d0(o, vb0, pa0, pa1, pa2, pa3); partialSM(pB0, pB1, m_reg, mnB, alB);
  __syncthreads(); RESC(alB);
  finishSM(pB0, pB1, alB, l_reg, pa0, pa1, pa2, pa3); SBAR();
  pv_d0(o, vb0 + (int)SHM_V, pa0, pa1, pa2, pa3);
  if (hi == 0) li_l[r32] = l_reg; asm volatile("s_waitcnt lgkmcnt(0)" ::: "memory");
  float rli[16];
#pragma unroll
  for (int r = 0; r < 16; ++r) rli[r] = __builtin_amdgcn_rcpf(li_l[crow(r, hi)]);
  unsigned short* Ow = Ob + (long)(wid * QBLK) * LDO; const unsigned short* Gw = Gb + (long)(wid * QBLK) * LDQ;
  int lane_e = lane, r32_e = r32, hi_e = hi; asm volatile("" : "+v"(lane_e), "+v"(r32_e), "+v"(hi_e));
  unsigned short* stg = (unsigned short*)(lds + 69632 + wid * 8704);
#pragma unroll
  for (int r = 0; r < 16; ++r) { int orow = crow(r, hi_e);
#pragma unroll
    for (int d0 = 0; d0 < 4; ++d0) { unsigned u = __float_as_uint(o[d0][r] * rli[r]); u = (u + 0x7fffu + ((u >> 16) & 1u)) >> 16; stg[orow * 136 + d0 * 32 + r32_e] = (unsigned short)u; } }
  asm volatile("s_waitcnt lgkmcnt(0)" ::: "memory");
#pragma unroll 2
  for (int i = 0; i < 8; ++i) { const int idx = i * 64 + lane_e, row = idx >> 4, ch = idx & 15;
    const u32x4 x = *reinterpret_cast<const u32x4*>(stg + row * 136 + 8 * ch);
    const u32x4 g = *reinterpret_cast<const u32x4*>(Gw + (long)row * LDQ + 8 * ch);
    u32x4 w;
#pragma unroll
    for (int q = 0; q < 4; ++q) { const float x0 = __uint_as_float(x[q] << 16), x1 = __uint_as_float(x[q] & 0xffff0000u), g0 = __uint_as_float(g[q] << 16), g1 = __uint_as_float(g[q] & 0xffff0000u);
      const float y0 = x0 / (1.f + __expf(-g0)), y1 = x1 / (1.f + __expf(-g1));
      unsigned u0 = __float_as_uint(y0), u1 = __float_as_uint(y1); u0 = (u0 + 0x7fffu + ((u0 >> 16) & 1u)) >> 16; u1 = (u1 + 0x7fffu + ((u1 >> 16) & 1u)) >> 16; w[q] = u0 | (u1 << 16); }
    *reinterpret_cast<u32x4*>(Ow + (long)row * LDO + 8 * ch) = w; }
  __syncthreads();
#undef SLOAD
#undef SWRITE
#undef SWAIT
#undef RESC
}

#undef KSWZ
#undef SBAR
}

#define LAS __attribute__((address_space(3)))
typedef unsigned short bf16_t;
typedef short bf16x8 __attribute__((ext_vector_type(8)));
typedef float f32x4 __attribute__((ext_vector_type(4)));
typedef float f32x16 __attribute__((ext_vector_type(16)));
typedef unsigned u32x4 __attribute__((ext_vector_type(4)));
typedef unsigned u32x2 __attribute__((ext_vector_type(2)));

constexpr int NWAVES = 8, NTHR = 512;
constexpr int T_TOK = 16384, SEQ = 8192, DM = 1024;
constexpr float EPS = 1e-6f;
constexpr int LDS_BYTES = 147456;
constexpr size_t MiB = 1u << 20;
constexpr size_t WS_BAR = 512 * 1024;
constexpr size_t WS_TAB = 0;
constexpr size_t WS_W0_IN = 1 * MiB, WS_W0_OUT = 6 * MiB;
constexpr size_t WS_WA = 1 * MiB, WS_WZ = 9 * MiB, WS_WAB = 13 * MiB, WS_WO = 14 * MiB;
constexpr size_t WS_WUP = 18 * MiB, WS_WDOWN = 29 * MiB;
constexpr size_t WS_XN = 35 * MiB;
constexpr size_t WS_PROJ = 67 * MiB, WS_AO = 147 * MiB;
constexpr size_t WS_RAWF = 67 * MiB, WS_ACT = 155 * MiB;
constexpr size_t WS_AB = 18 * MiB  , WS_RAWG = 71 * MiB, WS_OF = 71 * MiB, WS_OB = 71 * MiB + 2048;
constexpr size_t WS_QG = 135 * MiB, WS_KG = 151 * MiB, WS_VG = 167 * MiB, WS_KT = 199 * MiB, WS_TPK = 215 * MiB, WS_APK = 231 * MiB;
constexpr size_t WS_EDGE = 249 * MiB  ;
constexpr size_t WS_GC = 247 * MiB, WS_BETA = 248 * MiB, WS_Z = 135 * MiB, WS_GO = 167 * MiB, WS_END = 255 * MiB;

__device__ __forceinline__ unsigned f2bf(float f) { unsigned u = __float_as_uint(f); return (u + 0x7fffu + ((u >> 16) & 1u)) >> 16; }
__device__ __forceinline__ unsigned pk2(float lo, float hi) { return f2bf(lo) | (f2bf(hi) << 16); }
__device__ __forceinline__ float bf2f(unsigned short h) { return __uint_as_float(((unsigned)h) << 16); }
__device__ __forceinline__ float bflo(unsigned w) { return __uint_as_float(w << 16); }
__device__ __forceinline__ float bfhi(unsigned w) { return __uint_as_float(w & 0xffff0000u); }
__device__ __forceinline__ float wave_sum(float v) {
#pragma unroll
    for (int o = 1; o < 64; o <<= 1) v += __shfl_xor(v, o);
    return v;
}
__device__ __forceinline__ float silu_f(float x) { return x * __builtin_amdgcn_rcpf(1.f + __expf(-x)); }
__device__ __forceinline__ float sigm_f(float x) { return __builtin_amdgcn_rcpf(1.f + __expf(-x)); }
#define LDS_WAIT() asm volatile("s_waitcnt lgkmcnt(0)" ::: "memory")

struct Args { const float* in[19]; float* out; unsigned char* ws; int ph_lo, ph_hi; };
struct Ctx {
    const __attribute__((address_space(4))) Args* a; float* out; unsigned char* ws; LAS unsigned char* lds; char* ldsg;
    int tid, lane, wave, G, bid;
};

#define GAS __attribute__((address_space(1)))
#define INP(C, i) ((const float*)(const GAS float*)(C).a->in[i])
__device__ __forceinline__ void transpose_seg(const float* W, int ldw, int k0, int c0, int Kc, int Nc, bf16_t* dst, int ldd, LAS float* scr, int gw, int NGW, int lane) {
    const int nblk = Nc / 32, nitems = (Kc / 64) * nblk;
    for (int it = gw; it < nitems; it += NGW) {
        const int kb = it / nblk, nb = it % nblk, kk0 = 64 * kb, n0 = 32 * nb;
        float wv[32];
#pragma unroll
        for (int i = 0; i < 32; ++i) { const int kk = 2 * i + (lane >> 5); wv[i] = W[(size_t)(k0 + kk0 + kk) * ldw + c0 + n0 + (lane & 31)]; }
#pragma unroll
        for (int i = 0; i < 32; ++i) { const int kk = 2 * i + (lane >> 5); scr[kk * 33 + (lane & 31)] = wv[i]; }
        LDS_WAIT(); asm volatile("" ::: "memory");
        const int c = lane & 7;
#pragma unroll
        for (int j = 0; j < 4; ++j) { const int n = (lane >> 3) + 8 * j; const LAS float* s = scr + (8 * c) * 33 + n;
            u32x4 o; o.x = pk2(s[0 * 33], s[1 * 33]); o.y = pk2(s[2 * 33], s[3 * 33]); o.z = pk2(s[4 * 33], s[5 * 33]); o.w = pk2(s[6 * 33], s[7 * 33]);
            *(u32x4*)(dst + (size_t)(n0 + n) * ldd + kk0 + 8 * c) = o; }
        LDS_WAIT(); asm volatile("" ::: "memory");
    }
}
__device__ __forceinline__ void rms_rows_bf16(const float* src, const float* gain, bf16_t* dst, int gw, int NGW, int lane) {
    f32x4 g[4];
#pragma unroll
    for (int j = 0; j < 4; ++j) g[j] = ((const f32x4*)gain)[lane + 64 * j];
    for (int m = gw; m < T_TOK; m += NGW) {
        const f32x4* xr = (const f32x4*)(src + (size_t)m * DM) + lane; f32x4 v[4]; float s = 0.f;
#pragma unroll
        for (int j = 0; j < 4; ++j) { v[j] = xr[64 * j]; s += (v[j].x * v[j].x + v[j].y * v[j].y) + (v[j].z * v[j].z + v[j].w * v[j].w); }
        const float rs = rsqrtf(wave_sum(s) * (1.f / DM) + EPS);
        u32x2* o8 = (u32x2*)(dst + (size_t)m * DM) + lane;
#pragma unroll
        for (int j = 0; j < 4; ++j) { u32x2 w; w.x = pk2(v[j].x * rs * g[j].x, v[j].y * rs * g[j].y); w.y = pk2(v[j].z * rs * g[j].z, v[j].w * rs * g[j].w); o8[64 * j] = w; }
    }
}
__device__ __forceinline__ void rms_rows_f32_inplace(float* buf, const float* gain, int gw, int NGW, int lane) {
    f32x4 g[4];
#pragma unroll
    for (int j = 0; j < 4; ++j) g[j] = ((const f32x4*)gain)[lane + 64 * j];
    for (int m = gw; m < T_TOK; m += NGW) {
        f32x4* xr = (f32x4*)(buf + (size_t)m * DM) + lane; f32x4 v[4]; float s = 0.f;
#pragma unroll
        for (int j = 0; j < 4; ++j) { v[j] = xr[64 * j]; s += (v[j].x * v[j].x + v[j].y * v[j].y) + (v[j].z * v[j].z + v[j].w * v[j].w); }
        const float rs = rsqrtf(wave_sum(s) * (1.f / DM) + EPS);
#pragma unroll
        for (int j = 0; j < 4; ++j) xr[64 * j] = v[j] * rs * g[j];
    }
}

__device__ __forceinline__ void ph_convert_ffn(const Ctx& C, int layer, int gw, int NGW) {
    LAS float* scr = (LAS float*)(C.lds + C.wave * 16384);
    unsigned char* ws = C.ws;
    const float* wup = INP(C, 15) + (size_t)layer * 1024 * 5632;
    for (int it = gw; it < 44 * 64; it += NGW) {
        const int seg = it >> 6, r = it & 63, ab = seg & 1, j = seg >> 1;
        transpose_seg(wup, 5632, 0, (ab ? 2816 : 0) + 128 * j, 1024, 128, (bf16_t*)(ws + WS_WUP) + (size_t)(256 * j + 128 * ab) * 1024, 1024, scr, r, 64, C.lane);
    }
    transpose_seg(INP(C, 18) + (size_t)layer * 2816 * 1024, 1024, 0, 0, 2816, 1024, (bf16_t*)(ws + WS_WDOWN), 2816, scr, gw, NGW, C.lane);
}
__device__ __forceinline__ void ph_convert_mixer(const Ctx& C, int layer, int gw, int NGW) {
    LAS float* scr = (LAS float*)(C.lds + C.wave * 16384);
    const int gt = gw * 64 + C.lane, NGT = NGW * 64;
    unsigned char* ws = C.ws;
    if (layer == 0) {
        transpose_seg(INP(C, 4), 2560, 0, 0, 1024, 2560, (bf16_t*)(ws + WS_W0_IN), 1024, scr, gw, NGW, C.lane);
        transpose_seg(INP(C, 7), 1024, 0, 0, 1024, 1024, (bf16_t*)(ws + WS_W0_OUT), 1024, scr, gw, NGW, C.lane);
        float* tab = (float*)(ws + WS_TAB);
        for (int i = gt; i < (128 + 64) * 32; i += NGT) {
            const int f = i & 31, pos = i >> 5;
            const float inv = powf(10000.0f, -(float)f * (2.0f / 64.0f));
            const float p = (pos < 128) ? (float)pos : (float)(pos - 128);
            const float ang = p * inv; float sn, cs; sincosf(ang, &sn, &cs);
            if (pos < 128) { tab[pos * 32 + f] = cs; tab[4096 + pos * 32 + f] = sn; }
            else { tab[8192 + (pos - 128) * 32 + f] = cs; tab[8192 + 2048 + (pos - 128) * 32 + f] = sn; }
        }
    } else {
        const float* wi = INP(C, 8);
        for (int p = 0; p < 2; ++p) {
            bf16_t* wa = (bf16_t*)(ws + WS_WA) + (size_t)p * 2048 * 1024;
            transpose_seg(wi, 6208, 0, 512 * p, 1024, 512, wa, 1024, scr, gw, NGW, C.lane);
            transpose_seg(wi, 6208, 0, 1024 + 512 * p, 1024, 512, wa + (size_t)512 * 1024, 1024, scr, gw, NGW, C.lane);
            transpose_seg(wi, 6208, 0, 2048 + 1024 * p, 1024, 1024, wa + (size_t)1024 * 1024, 1024, scr, gw, NGW, C.lane);
            transpose_seg(wi, 6208, 0, 4096 + 1024 * p, 1024, 1024, (bf16_t*)(ws + WS_WZ) + (size_t)p * 1024 * 1024, 1024, scr, gw, NGW, C.lane);
            transpose_seg(INP(C, 14), 1024, 1024 * p, 0, 1024, 1024, (bf16_t*)(ws + WS_WO) + (size_t)p * 1024 * 1024, 1024, scr, gw, NGW, C.lane);
        }
        transpose_seg(wi, 6208, 0, 6144, 1024, 64, (bf16_t*)(ws + WS_WAB), 1024, scr, gw, NGW, C.lane);
        { u32x4* z = (u32x4*)((bf16_t*)(ws + WS_WAB) + (size_t)64 * 1024);
          unsigned z0 = 0u; asm volatile("" : "+v"(z0));
          for (int i = gt; i < 192 * 1024 / 8; i += NGT) z[i] = (u32x4){z0, z0, z0, z0}; }
    }
}
__device__ __forceinline__ bool side_job(const Ctx& C, int& gw, int& NGW) {
    const int h = C.G >> 1;
    if (C.G < 16) { gw = C.bid * NWAVES + C.wave; NGW = C.G * NWAVES; return true; }
    if (C.bid < h) return false;
    gw = (C.bid - h) * NWAVES + C.wave; NGW = (C.G - h) * NWAVES; return true;
}

__device__ __forceinline__ void ph_attn_post(const Ctx& C) {
    const int gw = C.bid * NWAVES + C.wave, NGW = C.G * NWAVES, lane = C.lane;
    bf16_t* P = (bf16_t*)(C.ws + WS_PROJ); const float* tab = (const float*)(C.ws + WS_TAB);
    const int f = lane & 31, i1 = (lane < 32) ? f : 64 + f, i2 = i1 + 32;
    const float gq1 = INP(C, 5)[i1], gq2 = INP(C, 5)[i2], gk1 = INP(C, 6)[i1], gk2 = INP(C, 6)[i2];
    for (int it0 = gw; it0 < T_TOK * 10; it0 += 4 * NGW) {
        bf16_t* pp[4]; float x1[4], x2[4]; int hh4[4], t4[4];
#pragma unroll
        for (int u = 0; u < 4; ++u) { const int it = it0 + u * NGW; const int row = it / 10, hh = it - row * 10;
            const int col0 = hh < 8 ? hh * 128 : 1024 + (hh - 8) * 128;
            pp[u] = P + (size_t)row * 2560 + col0; hh4[u] = hh; t4[u] = row & (SEQ - 1);
            x1[u] = bf2f(pp[u][i1]); x2[u] = bf2f(pp[u][i2]); }
#pragma unroll
        for (int u = 0; u < 4; ++u) {
            const float rs = rsqrtf(wave_sum(x1[u] * x1[u] + x2[u] * x2[u]) * (1.f / 128.f) + EPS);
            const float y1 = x1[u] * rs * (hh4[u] < 8 ? gq1 : gk1), y2 = x2[u] * rs * (hh4[u] < 8 ? gq2 : gk2);
            float cs, sn;
            if (lane < 32) { const int pos = t4[u] >> 6; cs = tab[pos * 32 + f]; sn = tab[4096 + pos * 32 + f]; }
            else { const int pos = t4[u] & 63; cs = tab[8192 + pos * 32 + f]; sn = tab[8192 + 2048 + pos * 32 + f]; }
            x1[u] = y1 * cs - y2 * sn; x2[u] = y1 * sn + y2 * cs;
        }
#pragma unroll
        for (int u = 0; u < 4; ++u) { pp[u][i1] = (bf16_t)f2bf(x1[u]); pp[u][i2] = (bf16_t)f2bf(x2[u]); }
    }
}

__device__ __forceinline__ void ph_attention(const Ctx& C) {
    const bf16_t* P = (const bf16_t*)(C.ws + WS_PROJ); bf16_t* AO = (bf16_t*)(C.ws + WS_AO);
    for (int u = C.bid; u < 512; u += C.G) {
        const int qb = u & 31, h = (u >> 5) & 7, b = u >> 8;
        const size_t row0 = (size_t)b * SEQ + qb * 256, rowb = (size_t)b * SEQ;
        attn::attn_dense_body((const attn::bf16*)(P + row0 * 2560 + h * 128), (const attn::bf16*)(P + rowb * 2560 + 1024 + (h >> 2) * 128),
                              (const attn::bf16*)(P + rowb * 2560 + 1280 + (h >> 2) * 128), P + row0 * 2560 + 1536 + h * 128, AO + row0 * 1024 + h * 128, SEQ, C.ldsg);
    }
}

__device__ __forceinline__ void ph_ffn_gate(const Ctx& C, int layer, int p) {
    const bf16_t* R = (const bf16_t*)(C.ws + WS_RAWF); bf16_t* A = (bf16_t*)(C.ws + WS_ACT);
    const float* cw = INP(C, 16) + (size_t)layer * 3 * 5632; const float* cb = INP(C, 17) + (size_t)layer * 5632;
    for (int task = C.bid * NTHR + C.tid; task < 1024 * 176; task += C.G * NTHR) {
        const int cg = task % 176, rb = task / 176, r0 = rb * 16, t0 = r0 & (SEQ - 1);
        const int ca = 1408 * p + 8 * cg, cbn = 2816 + ca;
        float wa[3][8], wb[3][8], ba[8], bb[8];
#pragma unroll
        for (int s = 0; s < 3; ++s)
#pragma unroll
            for (int e = 0; e < 8; ++e) { wa[s][e] = cw[s * 5632 + ca + e]; wb[s][e] = cw[s * 5632 + cbn + e]; }
#pragma unroll
        for (int e = 0; e < 8; ++e) { ba[e] = cb[ca + e]; bb[e] = cb[cbn + e]; }
        const bf16_t* ra = R + (size_t)r0 * 2816 + 8 * cg; const bf16_t* rbp = ra + 1408;
        const u32x4 zero = {0u, 0u, 0u, 0u};
        u32x4 a0 = (t0 > 0) ? *(const u32x4*)(ra - 2816) : zero, b0 = (t0 > 0) ? *(const u32x4*)(rbp - 2816) : zero;
        u32x4 a1 = *(const u32x4*)ra, b1 = *(const u32x4*)rbp;
#pragma unroll 4
        for (int r = 0; r < 16; ++r) {
            const bool has = (t0 + r + 1) < SEQ;
            const u32x4 a2 = has ? *(const u32x4*)(ra + (size_t)(r + 1) * 2816) : zero, b2 = has ? *(const u32x4*)(rbp + (size_t)(r + 1) * 2816) : zero;
            float o[8];
#pragma unroll
            for (int q = 0; q < 4; ++q) {
                const float ua0 = wa[0][2 * q] * bflo(a0[q]) + wa[1][2 * q] * bflo(a1[q]) + wa[2][2 * q] * bflo(a2[q]) + ba[2 * q];
                const float ua1 = wa[0][2 * q + 1] * bfhi(a0[q]) + wa[1][2 * q + 1] * bfhi(a1[q]) + wa[2][2 * q + 1] * bfhi(a2[q]) + ba[2 * q + 1];
                const float ub0 = wb[0][2 * q] * bflo(b0[q]) + wb[1][2 * q] * bflo(b1[q]) + wb[2][2 * q] * bflo(b2[q]) + bb[2 * q];
                const float ub1 = wb[0][2 * q + 1] * bfhi(b0[q]) + wb[1][2 * q + 1] * bfhi(b1[q]) + wb[2][2 * q + 1] * bfhi(b2[q]) + bb[2 * q + 1];
                o[2 * q] = silu_f(ua0) * ub0; o[2 * q + 1] = silu_f(ua1) * ub1;
            }
            u32x4 w; w.x = pk2(o[0], o[1]); w.y = pk2(o[2], o[3]); w.z = pk2(o[4], o[5]); w.w = pk2(o[6], o[7]);
            *(u32x4*)(A + (size_t)(r0 + r) * 2816 + ca) = w;
            a0 = a1; a1 = a2; b0 = b1; b1 = b2;
        }
    }
}


__device__ __forceinline__ void ph_ffn_fixup(const Ctx& C, int layer) {
    const float* E = (const float*)(C.ws + WS_EDGE); bf16_t* A = (bf16_t*)(C.ws + WS_ACT);
    const float* cw = INP(C, 16) + (size_t)layer * 3 * 5632; const float* cb = INP(C, 17) + (size_t)layer * 5632;
    for (int it = C.bid * NTHR + C.tid; it < 64 * 2 * 22 * 16; it += C.G * NTHR) {
        const int cg = it & 15, j = (it >> 4) % 22, rest = (it >> 4) / 22, which = rest & 1, pm = rest >> 1;
        const int chl = 8 * cg, cha = 128 * j + chl, chb = 2816 + cha;
        const float* e0 = E + (size_t)((pm * 22 + j) * 4) * 256;
        const float *pr, *cu, *nx; bool zp = false, zn = false;
        if (which == 0) { zp = (pm & 31) == 0; pr = E + (size_t)(((pm > 0 ? pm - 1 : 0) * 22 + j) * 4 + 3) * 256; cu = e0; nx = e0 + 256; }
        else { pr = e0 + 2 * 256; cu = e0 + 3 * 256; zn = (pm & 31) == 31; nx = E + (size_t)(((pm < 63 ? pm + 1 : 63) * 22 + j) * 4) * 256; }
        float o[8];
#pragma unroll
        for (int e = 0; e < 8; ++e) {
            const float pa = zp ? 0.f : pr[chl + e], ca = cu[chl + e], na = zn ? 0.f : nx[chl + e];
            const float pb = zp ? 0.f : pr[128 + chl + e], cbv = cu[128 + chl + e], nb = zn ? 0.f : nx[128 + chl + e];
            const float ya = cw[cha + e] * pa + cw[5632 + cha + e] * ca + cw[2 * 5632 + cha + e] * na + cb[cha + e];
            const float yb = cw[chb + e] * pb + cw[5632 + chb + e] * cbv + cw[2 * 5632 + chb + e] * nb + cb[chb + e];
            o[e] = silu_f(ya) * yb;
        }
        u32x4 w; w.x = pk2(o[0], o[1]); w.y = pk2(o[2], o[3]); w.z = pk2(o[4], o[5]); w.w = pk2(o[6], o[7]);
        *(u32x4*)(A + (size_t)(pm * 256 + (which ? 255 : 0)) * 2816 + cha) = w;
    }
}

__device__ __forceinline__ void ph_gdn_gate(const Ctx& C) {
    const int gw = C.bid * NWAVES + C.wave, NGW = C.G * NWAVES, lane = C.lane;
    const unsigned* OF = (const unsigned*)(C.ws + WS_OF); const unsigned* OB = (const unsigned*)(C.ws + WS_OB);
    const unsigned* Z = (const unsigned*)(C.ws + WS_Z); unsigned* GO = (unsigned*)(C.ws + WS_GO);
    const float g0 = INP(C, 13)[2 * lane], g1 = INP(C, 13)[2 * lane + 1];
    for (int it0 = gw; it0 < T_TOK * 8; it0 += 4 * NGW) {
        unsigned a[4], b[4], z[4];
#pragma unroll
        for (int u = 0; u < 4; ++u) { const size_t idx = (size_t)(it0 + u * NGW) * 64 + lane; a[u] = OF[idx]; b[u] = OB[idx]; z[u] = Z[idx]; }
#pragma unroll
        for (int u = 0; u < 4; ++u) {
            const float o0 = bflo(a[u]) + bflo(b[u]), o1 = bfhi(a[u]) + bfhi(b[u]);
            const float rs = rsqrtf(wave_sum(o0 * o0 + o1 * o1) * (1.f / 128.f) + EPS);
            const float z0 = bflo(z[u]), z1 = bfhi(z[u]);
            GO[(size_t)(it0 + u * NGW) * 64 + lane] = pk2(o0 * rs * g0 * silu_f(z0), o1 * rs * g1 * silu_f(z1));
        }
    }
}

#define XB_TMO      128
#define XB_XCNT(j)  (256  + 64 * (j))
#define XB_XSUB(j)  (1280 + 64 * (j))
#define XB_XGEN(j)  (2304 + 64 * (j))
#define XB_TOP      3328
#define XB_TOPGEN   3392
#define XCD_BAR_WORDS 3456
#define XB_SPIN_CAP (1u << 18)

__device__ __forceinline__ unsigned xb_ld(unsigned* p)              { return __hip_atomic_load(p, __ATOMIC_RELAXED, __HIP_MEMORY_SCOPE_AGENT); }
__device__ __forceinline__ unsigned xb_add(unsigned* p, unsigned v) { return __hip_atomic_fetch_add(p, v, __ATOMIC_RELAXED, __HIP_MEMORY_SCOPE_AGENT); }
__device__ __forceinline__ unsigned xb_xcc_id() { return (unsigned)__builtin_amdgcn_s_getreg((3 << 11) | 20) & 0xFu; }
#define XB_SPIN(cond, bar) do { unsigned _sp = 0; while (cond) { __builtin_amdgcn_s_sleep(1); \
    if ((++_sp & 255u) == 0u) { if (xb_ld(&(bar)[XB_TMO])) break; if (_sp > XB_SPIN_CAP) { atomicAdd(&(bar)[XB_TMO], 1u); break; } } } } while (0)

struct XcdBarrier {
    unsigned* bar; unsigned x;
    volatile LAS unsigned* st;
};

__device__ __forceinline__ XcdBarrier xcd_barrier_post(unsigned* bar, volatile LAS unsigned* st) {
    XcdBarrier b; b.bar = bar; b.x = xb_xcc_id(); b.st = st;
    if (threadIdx.x == 0) (void)xb_add(&bar[XB_XCNT(b.x)], 1u);
    return b;
}
__device__ __forceinline__ void xcd_barrier_complete(unsigned* bar, unsigned x, unsigned& nloc, unsigned& nx) {
    const unsigned G = gridDim.x * gridDim.y * gridDim.z;
    unsigned sum, cnt, mine, sp = 0u;
    for (;;) {
        sum = 0u; cnt = 0u; mine = 0u;
#pragma unroll
        for (unsigned j = 0; j < 16; ++j) { const unsigned c = xb_ld(&bar[XB_XCNT(j)]); sum += c; cnt += (c > 0u) ? 1u : 0u; mine = (j == x) ? c : mine; }
        if (sum == G) break;
        __builtin_amdgcn_s_sleep(1);
        if ((++sp & 255u) == 0u) { if (xb_ld(&bar[XB_TMO])) break; if (sp > XB_SPIN_CAP) { atomicAdd(&bar[XB_TMO], 1u); break; } }
    }
    nloc = mine > 0u ? mine : 1u; nx = cnt > 0u ? cnt : 1u;
}

__device__ __forceinline__ void xcd_barrier(const XcdBarrier& b) {
    asm volatile("s_waitcnt vmcnt(0)" ::: "memory");
    __syncthreads();
    if (threadIdx.x == 0) {
        unsigned* bar = b.bar;
        __builtin_amdgcn_s_waitcnt(0);
        unsigned nloc = b.st[0], nx = b.st[1];
        if (nloc == 0u) { xcd_barrier_complete(bar, b.x, nloc, nx); b.st[0] = nloc; b.st[1] = nx; }
        const unsigned old = xb_add(&bar[XB_XSUB(b.x)], 1u);
        const unsigned gen = old / nloc;
        if (old + 1u == (gen + 1u) * nloc) {
            __builtin_amdgcn_fence(__ATOMIC_RELEASE, "agent");
            asm volatile("s_waitcnt vmcnt(0)" ::: "memory");
            const unsigned og = xb_add(&bar[XB_TOP], 1u);
            const unsigned tg = og / nx;
            if (og + 1u == (tg + 1u) * nx) xb_add(&bar[XB_TOPGEN], 1u);
            else XB_SPIN(xb_ld(&bar[XB_TOPGEN]) == tg, bar);
            __builtin_amdgcn_fence(__ATOMIC_ACQUIRE, "agent");
            xb_add(&bar[XB_XGEN(b.x)], 1u);
            asm volatile("s_waitcnt vmcnt(0)" ::: "memory");
        } else {
            XB_SPIN(xb_ld(&bar[XB_XGEN(b.x)]) == gen, bar);
            __builtin_amdgcn_fence(__ATOMIC_ACQUIRE, "agent");
            asm volatile("s_waitcnt vmcnt(0)" ::: "memory");
        }
    }
    __syncthreads();
}

__device__ __forceinline__ int crow16(int r, int hi) { return (r & 3) + 8 * (r >> 2) + 4 * hi; }
__device__ __forceinline__ unsigned cvtpk2(float lo, float hi) { return pg8::cvt_pk_bf16(lo, hi); }
#define PK4S(P, BASE, OUT) do { unsigned a0_ = cvtpk2(P[BASE + 0], P[BASE + 1]), a1_ = cvtpk2(P[BASE + 2], P[BASE + 3]);   \
    unsigned b0_ = cvtpk2(P[BASE + 4], P[BASE + 5]), b1_ = cvtpk2(P[BASE + 6], P[BASE + 7]);                              \
    auto r0_ = __builtin_amdgcn_permlane32_swap(a0_, b0_, false, false); auto r1_ = __builtin_amdgcn_permlane32_swap(a1_, b1_, false, false); \
    u32x4 w_ = {r0_[0], r1_[0], r0_[1], r1_[1]}; OUT = *reinterpret_cast<bf16x8*>(&w_); } while (0)

__device__ __forceinline__ void ph_ab_small(const Ctx& C) {
    const bf16_t* XN = (const bf16_t*)(C.ws + WS_XN); const bf16_t* WB = (const bf16_t*)(C.ws + WS_WAB); float* AB = (float*)(C.ws + WS_AB);
    const int lane = C.lane, w = C.wave, mt = w & 1, nt = (w >> 1) & 1, kh = w >> 2, r32 = lane & 31, hi = lane >> 5;
    LAS float* red = (LAS float*)C.lds;
    for (int slab = C.bid; slab < T_TOK / 64; slab += C.G) {
        const bf16_t* ap = XN + (size_t)(slab * 64 + 32 * mt + r32) * 1024 + 512 * kh + 8 * hi;
        const bf16_t* bp = WB + (size_t)(32 * nt + r32) * 1024 + 512 * kh + 8 * hi;
        f32x16 acc = {};
#pragma unroll 8
        for (int ks = 0; ks < 32; ++ks) {
            const bf16x8 a = *(const bf16x8*)(ap + 16 * ks), b = *(const bf16x8*)(bp + 16 * ks);
            acc = __builtin_amdgcn_mfma_f32_32x32x16_bf16(a, b, acc, 0, 0, 0);
        }
        if (kh == 1) {
#pragma unroll
            for (int r = 0; r < 16; ++r) red[((w & 3) * 16 + r) * 64 + lane] = acc[r];
        }
        __syncthreads();
        if (kh == 0) {
#pragma unroll
            for (int r = 0; r < 16; ++r) AB[(size_t)(slab * 64 + 32 * mt + crow16(r, hi)) * 256 + 32 * nt + r32] = acc[r] + red[((w & 3) * 16 + r) * 64 + lane];
        }
        __syncthreads();
    }
}
constexpr int GDN_KS = 47;
__device__ __forceinline__ void ph_gdn_prep(const Ctx& C, int p, int mode) {
    const int tid = C.tid, lane = C.lane, wave = C.wave;
    unsigned char* ws = C.ws;
    const bf16_t* RAW = (const bf16_t*)(ws + WS_RAWG);
    bf16_t* QG = (bf16_t*)(ws + WS_QG); bf16_t* KG = (bf16_t*)(ws + WS_KG); bf16_t* VG = (bf16_t*)(ws + WS_VG); bf16_t* KT = (bf16_t*)(ws + WS_KT);
    bf16_t* TPK = (bf16_t*)(ws + WS_TPK); bf16_t* APK = (bf16_t*)(ws + WS_APK);
    float* GC = (float*)(ws + WS_GC); float* BETA = (float*)(ws + WS_BETA); const float* AB = (const float*)(ws + WS_AB);
    const float* cw = INP(C, 9); const float* cb = INP(C, 10);
    LAS bf16_t* qs = (LAS bf16_t*)(C.lds); LAS bf16_t* ks = (LAS bf16_t*)(C.lds + 17408);
    LAS float* KKs = (LAS float*)(C.lds + 34816); LAS float* QKs = (LAS float*)(C.lds + 51456);
    LAS float* Ls = (LAS float*)(C.lds + 68096);
    const int per = mode ? (126 - 2 * GDN_KS) : 2 * (GDN_KS + 1), ntask = 8 * per;
    for (int task = mode ? C.bid - 128 : C.bid; task < ntask; task += mode ? C.G - 128 : C.G) {
        const int ci = task % per, grp = task / per, hql = grp & 3, b = grp >> 2;
        const int chunk = mode ? GDN_KS + 1 + ci : (ci <= GDN_KS ? ci : 126 - 2 * GDN_KS + ci);
        const int row0 = b * SEQ + chunk * 64;
#ifndef PREP_REP_A
#define PREP_REP_A 1
#endif
#ifndef PREP_REP_C
#define PREP_REP_C 1
#endif
#pragma unroll 1
        for (int repa = 0; repa < PREP_REP_A; ++repa) {
            const int cgp = tid & 63, rg = wave, lc = 8 * cgp;
            int rcol, chan; int kind;
            if (lc < 128) { kind = 0; rcol = 128 * hql + lc; chan = (4 * p + hql) * 128 + lc; }
            else if (lc < 256) { kind = 1; rcol = 512 + 128 * hql + (lc - 128); chan = 1024 + (4 * p + hql) * 128 + (lc - 128); }
            else { kind = 2; rcol = 1024 + 256 * hql + (lc - 256); chan = 2048 + (8 * p + 2 * hql) * 128 + (lc - 256); }
            float w5[5][8], bs[8];
#pragma unroll
            for (int s = 0; s < 5; ++s)
#pragma unroll
                for (int e = 0; e < 8; ++e) w5[s][e] = cw[s * 4096 + chan + e];
#pragma unroll
            for (int e = 0; e < 8; ++e) bs[e] = cb[chan + e];
            {
                const int tl0 = chunk * 64 + 8 * rg - 2;
                u32x4 win[12];
#pragma unroll
                for (int j = 0; j < 12; ++j) { const int tl = tl0 + j; win[j] = (u32x4){0u, 0u, 0u, 0u};
                    if (tl >= 0 && tl < SEQ) win[j] = *(const u32x4*)(RAW + (size_t)(b * SEQ + tl) * 2048 + rcol); }
#pragma unroll
                for (int r = 0; r < 8; ++r) {
                    float o[8];
#pragma unroll
                    for (int e = 0; e < 8; ++e) o[e] = bs[e];
#pragma unroll
                    for (int s5 = 0; s5 < 5; ++s5) { const u32x4 x = win[r + s5];
#pragma unroll
                        for (int q = 0; q < 4; ++q) { o[2 * q] += w5[s5][2 * q] * bflo(x[q]); o[2 * q + 1] += w5[s5][2 * q + 1] * bfhi(x[q]); } }
                    float ss = 0.f;
#pragma unroll
                    for (int e = 0; e < 8; ++e) { o[e] = silu_f(o[e]); ss += o[e] * o[e]; }
                    ss += __shfl_xor(ss, 1); ss += __shfl_xor(ss, 2); ss += __shfl_xor(ss, 4); ss += __shfl_xor(ss, 8);
                    float sc = rsqrtf(ss + EPS); if (kind == 0) sc *= 0.08838834764831845f; if (kind == 2) sc = 1.f;
                    u32x4 w; w.x = pk2(o[0] * sc, o[1] * sc); w.y = pk2(o[2] * sc, o[3] * sc); w.z = pk2(o[4] * sc, o[5] * sc); w.w = pk2(o[6] * sc, o[7] * sc);
                    const int rr = 8 * rg + r; const size_t grow = (size_t)(row0 + rr);
                    if (kind == 0) { *(u32x4*)(QG + grow * 512 + 128 * hql + lc) = w; *(LAS u32x4*)(qs + rr * 136 + lc) = w; }
                    else if (kind == 1) { *(u32x4*)(KG + grow * 512 + 128 * hql + (lc - 128)) = w; *(LAS u32x4*)(ks + rr * 136 + (lc - 128)) = w; }
                    else { *(u32x4*)(VG + grow * 1024 + 256 * hql + (lc - 256)) = w; }
                }
            }
        }
        __syncthreads();
        {
            bf16_t* kt = KT + ((size_t)((b * 4 + hql) * 128 + chunk)) * 8192;
            const int dk = tid & 127, tg = tid >> 7;
            unsigned short v[16];
#pragma unroll
            for (int i = 0; i < 16; ++i) v[i] = ks[(16 * tg + i) * 136 + dk];
            u32x4 w0, w1;
#pragma unroll
            for (int q = 0; q < 4; ++q) { w0[q] = (unsigned)v[2 * q] | ((unsigned)v[2 * q + 1] << 16); w1[q] = (unsigned)v[8 + 2 * q] | ((unsigned)v[8 + 2 * q + 1] << 16); }
            *(u32x4*)(kt + (size_t)dk * 64 + 16 * tg) = w0; *(u32x4*)(kt + (size_t)dk * 64 + 16 * tg + 8) = w1;
        }
        {
            const int mat = wave >> 2, mi = (wave >> 1) & 1, ni = wave & 1, r32 = lane & 31, hi = lane >> 5;
            LAS bf16_t* X = mat ? qs : ks; f32x16 acc = {};
#pragma unroll
            for (int kk = 0; kk < 8; ++kk) {
                const bf16x8 a = *(const LAS bf16x8*)(X + (32 * mi + r32) * 136 + 16 * kk + 8 * hi);
                const bf16x8 bb = *(const LAS bf16x8*)(ks + (32 * ni + r32) * 136 + 16 * kk + 8 * hi);
                acc = __builtin_amdgcn_mfma_f32_32x32x16_bf16(a, bb, acc, 0, 0, 0);
            }
            LAS float* M = mat ? QKs : KKs;
#pragma unroll
            for (int r = 0; r < 16; ++r) M[(32 * mi + crow16(r, hi)) * 65 + 32 * ni + r32] = acc[r];
        }
        __syncthreads();
        {
            const int cw = wave & 3, rh = wave >> 2;
            const int vh = cw >> 1, dir = cw & 1, hloc = 2 * hql + vh, head = 8 * p + hloc;
            const int row = row0 + lane;
            const float av = AB[(size_t)row * 256 + dir * 32 + head], bv = AB[(size_t)row * 256 + dir * 32 + 16 + head];
            const float xx = av + INP(C, 12)[dir * 16 + head];
            const float ex = __expf(xx); const float sp = xx > 20.f ? xx : (xx < -10.f ? ex : __logf(1.f + ex));
            const float g = -__expf(INP(C, 11)[dir * 16 + head]) * sp;
            const float beta = sigm_f(bv);
            float v = dir ? __shfl(g, 63 - lane) : g;
#pragma unroll
            for (int off = 1; off < 64; off <<= 1) { const float t = __shfl_up(v, off); if (lane >= off) v += t; }
            const float gc = dir ? __shfl(v, 63 - lane) : v;
            if (rh == 0) { GC[((size_t)dir * T_TOK + row) * 8 + hloc] = gc; BETA[((size_t)dir * T_TOK + row) * 8 + hloc] = beta; }
            const int c = lane, jo = dir ? 63 - c : c;
            const float gcj = __shfl(gc, jo);
            LAS float* L = Ls + cw * 4096;
            const size_t mbase = ((size_t)((b * 8 + hloc) * 128 + chunk)) * 4096;
#pragma unroll 4
            for (int q = 0; q < 32; ++q) {
                const int ip = 32 * rh + q, io = dir ? 63 - ip : ip;
                const float gci = __shfl(gc, io), bti = __shfl(beta, io);
                const float dec = (c <= ip) ? __expf(gci - gcj) : 0.f;
                const float lv = (c < ip) ? bti * KKs[io * 65 + jo] * dec : 0.f;
                L[ip * 64 + c] = lv;
                const bool wr = dir ? (c < ip) : (c <= ip);
                if (wr) APK[mbase + io * 64 + jo] = (bf16_t)f2bf(QKs[io * 65 + jo] * dec);
            }
            __syncthreads();
            if (wave < 4) {
                float x[64];
#pragma unroll
                for (int i = 0; i < 64; ++i) x[i] = 0.f;
                f32x4 cur[8], nxt[8];
#pragma unroll
                for (int j4 = 0; j4 < 8; ++j4) { cur[j4] = (f32x4){0.f, 0.f, 0.f, 0.f}; nxt[j4] = (f32x4){0.f, 0.f, 0.f, 0.f}; }
                cur[0] = *(const LAS f32x4*)(L + 1 * 64);
                x[0] = (c == 0) ? 1.f : 0.f;
#pragma unroll
                for (int i = 1; i < 64; ++i) {
                    if (i + 1 < 64) {
#pragma unroll
                        for (int j4 = 0; j4 < ((i + 1 + 3) / 4 < 8 ? (i + 1 + 3) / 4 : 8); ++j4) nxt[j4] = *(const LAS f32x4*)(L + (i + 1) * 64 + 4 * j4);
                    }
                    float a0 = (c == i) ? 1.f : 0.f, a1 = 0.f;
#pragma unroll
                    for (int j4 = 0; j4 < (i + 3) / 4; ++j4) {
                        const f32x4 l = (j4 < 8) ? cur[j4 < 8 ? j4 : 0] : *(const LAS f32x4*)(L + i * 64 + 4 * j4);
                        if (4 * j4 + 0 < i) a0 -= l[0] * x[4 * j4 + 0];
                        if (4 * j4 + 1 < i) a1 -= l[1] * x[4 * j4 + 1];
                        if (4 * j4 + 2 < i) a0 -= l[2] * x[4 * j4 + 2];
                        if (4 * j4 + 3 < i) a1 -= l[3] * x[4 * j4 + 3];
                    }
                    x[i] = a0 + a1;
                    asm volatile("" ::: "memory");
#pragma unroll
                    for (int j4 = 0; j4 < 8; ++j4) cur[j4] = nxt[j4];
                }
#pragma unroll
                for (int i = 0; i < 64; ++i) L[i * 64 + c] = x[i];
            }
            __syncthreads();
#pragma unroll 4
            for (int q = 0; q < 32; ++q) { const int i = 32 * rh + q, io = dir ? 63 - i : i; const float xv = L[i * 64 + c]; if (c < i) TPK[mbase + io * 64 + jo] = (bf16_t)f2bf(xv); }
        }
        __syncthreads();
    }
}

constexpr int SC_SLOT = 54272;
constexpr int SC_KT = 2 * SC_SLOT;
constexpr int SC_SB = SC_KT + 16384, SC_RB = SC_SB + 8192;
constexpr int SL_VB = 16384, SL_VSB = 16384 + 4096;
#define SC_BAR() do { asm volatile("s_waitcnt lgkmcnt(0)" ::: "memory"); __builtin_amdgcn_s_barrier(); asm volatile("" ::: "memory"); } while (0)
struct ScanRegs { u32x4 q[4], k[4], kt[4], t[2], a[2], v; float gcv, gl, bt; };
__device__ __forceinline__ void scan_issue(const Ctx& C, ScanRegs& R, int ltid, int cidx, int b, int hql, int vh, int dir, int sl) {
    const int hloc = 2 * hql + vh; unsigned char* ws = C.ws;
    const size_t row0 = (size_t)b * SEQ + cidx * 64;
    const bf16_t* QG = (const bf16_t*)(ws + WS_QG) + row0 * 512 + 128 * hql;
    const bf16_t* KG = (const bf16_t*)(ws + WS_KG) + row0 * 512 + 128 * hql;
    const bf16_t* KT = (const bf16_t*)(ws + WS_KT) + ((size_t)((b * 4 + hql) * 128 + cidx)) * 8192;
    const bf16_t* TP = (const bf16_t*)(ws + WS_TPK) + ((size_t)((b * 8 + hloc) * 128 + cidx)) * 4096;
    const bf16_t* AP = (const bf16_t*)(ws + WS_APK) + ((size_t)((b * 8 + hloc) * 128 + cidx)) * 4096;
    const bf16_t* VG = (const bf16_t*)(ws + WS_VG) + row0 * 1024 + 256 * hql + 128 * vh + 32 * sl;
#pragma unroll
    for (int j = 0; j < 4; ++j) { const int i = ltid + 256 * j, r = i >> 4, ch = i & 15;
        R.q[j] = *(const u32x4*)(QG + (size_t)r * 512 + 8 * ch); R.k[j] = *(const u32x4*)(KG + (size_t)r * 512 + 8 * ch);
        const int r2 = i >> 3, c2 = i & 7; R.kt[j] = *(const u32x4*)(KT + (size_t)r2 * 64 + 8 * c2); }
#pragma unroll
    for (int j = 0; j < 2; ++j) { const int i = ltid + 256 * j, r = i >> 3, ch = i & 7; R.t[j] = *(const u32x4*)(TP + r * 64 + 8 * ch); R.a[j] = *(const u32x4*)(AP + r * 64 + 8 * ch); }
    { const int r = ltid >> 2, ch = ltid & 3; R.v = *(const u32x4*)(VG + (size_t)r * 1024 + 8 * ch); }
    if (ltid < 64) { const float* GC = (const float*)(ws + WS_GC) + ((size_t)dir * T_TOK + row0) * 8 + hloc; const float* BT = (const float*)(ws + WS_BETA) + ((size_t)dir * T_TOK + row0) * 8 + hloc;
        R.gcv = GC[ltid * 8]; R.gl = GC[(dir ? 0 : 63) * 8]; R.bt = BT[ltid * 8]; }
}
__device__ __forceinline__ void scan_write_kt(const ScanRegs& R, LAS unsigned char* lds, int ltid) {
#pragma unroll
    for (int j = 0; j < 4; ++j) { const int i = ltid + 256 * j, r2 = i >> 3, c2 = i & 7; *(LAS u32x4*)(lds + SC_KT + r2 * 128 + ((c2 ^ (r2 & 7)) << 4)) = R.kt[j]; }
}
__device__ __forceinline__ void scan_write_slot(const ScanRegs& R, LAS unsigned char* Lb, int ltid, int dir) {
#pragma unroll
    for (int j = 0; j < 4; ++j) { const int i = ltid + 256 * j, r = i >> 4, ch = i & 15; const int o = r * 256 + ((ch ^ (r & 7)) << 4);
        *(LAS u32x4*)(Lb + o) = R.q[j]; *(LAS u32x4*)(Lb + 16384 + o) = R.k[j]; }
#pragma unroll
    for (int j = 0; j < 2; ++j) { const int i = ltid + 256 * j, r = i >> 3, ch = i & 7; u32x4 t = R.t[j], a = R.a[j];
#pragma unroll
        for (int q = 0; q < 4; ++q) {
            unsigned tl = t[q] & 0xffffu, th = t[q] >> 16, al = a[q] & 0xffffu, ah = a[q] >> 16;
            const int j0 = 8 * ch + 2 * q, j1 = j0 + 1;
            const bool s0 = dir ? (j0 > r) : (j0 < r), s1 = dir ? (j1 > r) : (j1 < r);
            tl = s0 ? tl : (j0 == r ? 0x3f80u : 0u); th = s1 ? th : (j1 == r ? 0x3f80u : 0u);
            al = (s0 || j0 == r) ? al : 0u; ah = (s1 || j1 == r) ? ah : 0u;
            t[q] = tl | (th << 16); a[q] = al | (ah << 16);
        }
        const int o = r * 128 + ((ch ^ (r & 7)) << 4);
        *(LAS u32x4*)(Lb + 32768 + o) = t; *(LAS u32x4*)(Lb + 40960 + o) = a; }
    { const int r = ltid >> 2, ch = ltid & 3; *(LAS u32x4*)(Lb + 49152 + r * 64 + ch * 16) = R.v; }
    if (ltid < 64) { LAS float* sc = (LAS float*)(Lb + 53248);
        sc[ltid] = __expf(R.gcv); sc[64 + ltid] = __expf(R.gl - R.gcv); sc[128 + ltid] = R.bt; if (ltid == 0) sc[192] = __expf(R.gl); }
}
__device__ __forceinline__ void scan_out(f32x16 acc, LAS unsigned char* Lb, bf16_t* obase, int mi, int r32, int hi, int lane) {
    bf16x8 af[4], vf[4];
#pragma unroll
    for (int kk = 0; kk < 4; ++kk) { const int row = 32 * mi + r32; af[kk] = *(const LAS bf16x8*)(Lb + 40960 + row * 128 + (((2 * kk + hi) ^ (row & 7)) << 4));
        vf[kk] = *(const LAS bf16x8*)(Lb + SL_VB + kk * 1024 + lane * 16); }
#pragma unroll
    for (int kk = 0; kk < 4; ++kk) acc = __builtin_amdgcn_mfma_f32_32x32x16_bf16(af[kk], vf[kk], acc, 0, 0, 0);
    bf16_t* op = obase + r32;
#pragma unroll
    for (int r = 0; r < 16; ++r) op[(size_t)(32 * mi + crow16(r, hi)) * 2048] = (bf16_t)f2bf(acc[r]);
}
__device__ __forceinline__ void ph_gdn_scan(const Ctx& C, int p, const XcdBarrier& xbar, bool side) {
    if (C.bid >= 128) {
        ph_gdn_prep(C, p, 1);
        xcd_barrier(xbar);
        if (side) ph_convert_ffn(C, 1, (C.bid - 128) * NWAVES + C.wave, (C.G - 128) * NWAVES);
        return;
    }
    const int group = C.bid & 7, b = group >> 2, hql = group & 3, jj = C.bid >> 3, vh = jj >> 3, dir = (jj >> 2) & 1, sl = jj & 3;
    const int hloc = 2 * hql + vh, lane = C.lane, w = C.wave;
    LAS unsigned char* lds = C.lds;
    bf16_t* OD = (bf16_t*)(C.ws + (dir ? WS_OB : WS_OF));
    if (w >= 4) {
        const int ltid = C.tid - 256;
        ScanRegs R;
        scan_issue(C, R, ltid, dir ? 127 : 0, b, hql, vh, dir, sl);
        scan_write_slot(R, lds, ltid, dir); scan_write_kt(R, lds, ltid);
        { unsigned z0 = 0u; asm volatile("" : "+v"(z0));
          for (int i = ltid; i < 8192 / 16; i += 256) *(LAS u32x4*)(lds + SC_SB + i * 16) = (u32x4){z0, z0, z0, z0}; }
        for (int n = 0; n < 128; ++n) {
            if (n == GDN_KS) {
                xcd_barrier(xbar);
                scan_issue(C, R, ltid, dir ? 127 - n : n, b, hql, vh, dir, sl);
                scan_write_slot(R, lds + (n & 1) * SC_SLOT, ltid, dir);
            }
            SC_BAR();
            if (n > 0) scan_write_kt(R, lds, ltid);
            const bool pre = (n + 1 < 128) && (n + 1 != GDN_KS);
            if (pre) scan_issue(C, R, ltid, dir ? 126 - n : n + 1, b, hql, vh, dir, sl);
            SC_BAR();
            SC_BAR();
            if (pre) scan_write_slot(R, lds + ((n + 1) & 1) * SC_SLOT, ltid, dir);
        }
    } else {
        f32x16 S = {}, oacc = {};
        for (int n = 0; n < 128; ++n) {
            int r32 = lane & 31, hi = lane >> 5; asm volatile("" : "+v"(r32), "+v"(hi));
            LAS unsigned char* Lb = lds + (n & 1) * SC_SLOT;
            const LAS float* sc = (const LAS float*)(Lb + 53248);
            const int cidx = dir ? 127 - n : n;
            if (n == GDN_KS) xcd_barrier(xbar);
            SC_BAR();
            const int mi = w & 1;
            f32x16 acc = {};
            {
                LAS unsigned char* Ab = Lb + (w < 2 ? 16384 : 0);
                bf16x8 af[8], sf[8];
#pragma unroll
                for (int kk = 0; kk < 8; ++kk) { const int row = 32 * mi + r32; af[kk] = *(const LAS bf16x8*)(Ab + row * 256 + (((2 * kk + hi) ^ (row & 7)) << 4));
                    sf[kk] = *(const LAS bf16x8*)(lds + SC_SB + kk * 1024 + lane * 16); }
#pragma unroll
                for (int kk = 0; kk < 8; ++kk) acc = __builtin_amdgcn_mfma_f32_32x32x16_bf16(af[kk], sf[kk], acc, 0, 0, 0);
            }
            if (w < 2) {
#pragma unroll
                for (int g4 = 0; g4 < 4; ++g4) { const int i0 = 32 * mi + 8 * g4 + 4 * hi;
                    const f32x4 eg = *(const LAS f32x4*)(sc + i0), bt = *(const LAS f32x4*)(sc + 128 + i0);
#pragma unroll
                    for (int e = 0; e < 4; ++e) { const float vv = bf2f(*(const LAS bf16_t*)(Lb + 49152 + (i0 + e) * 64 + r32 * 2));
                        acc[4 * g4 + e] = bt[e] * (vv - eg[e] * acc[4 * g4 + e]); } }
                bf16x8 f0, f1; PK4S(acc, 0, f0); PK4S(acc, 8, f1);
                *(LAS bf16x8*)(lds + SC_RB + (2 * mi) * 1024 + lane * 16) = f0; *(LAS bf16x8*)(lds + SC_RB + (2 * mi + 1) * 1024 + lane * 16) = f1;
            }
            SC_BAR();
            if (w < 2) {
                bf16x8 af[4], rf[4];
#pragma unroll
                for (int kk = 0; kk < 4; ++kk) { const int row = 32 * mi + r32; af[kk] = *(const LAS bf16x8*)(Lb + 32768 + row * 128 + (((2 * kk + hi) ^ (row & 7)) << 4));
                    rf[kk] = *(const LAS bf16x8*)(lds + SC_RB + kk * 1024 + lane * 16); }
                f32x16 vn = {};
#pragma unroll
                for (int kk = 0; kk < 4; ++kk) vn = __builtin_amdgcn_mfma_f32_32x32x16_bf16(af[kk], rf[kk], vn, 0, 0, 0);
                bf16x8 f0, f1; PK4S(vn, 0, f0); PK4S(vn, 8, f1);
                *(LAS bf16x8*)(Lb + SL_VB + (2 * mi) * 1024 + lane * 16) = f0; *(LAS bf16x8*)(Lb + SL_VB + (2 * mi + 1) * 1024 + lane * 16) = f1;
#pragma unroll
                for (int g4 = 0; g4 < 4; ++g4) { const int i0 = 32 * mi + 8 * g4 + 4 * hi; const f32x4 ek = *(const LAS f32x4*)(sc + 64 + i0);
#pragma unroll
                    for (int e = 0; e < 4; ++e) vn[4 * g4 + e] *= ek[e]; }
                PK4S(vn, 0, f0); PK4S(vn, 8, f1);
                *(LAS bf16x8*)(Lb + SL_VSB + (2 * mi) * 1024 + lane * 16) = f0; *(LAS bf16x8*)(Lb + SL_VSB + (2 * mi + 1) * 1024 + lane * 16) = f1;
            }
            if (w >= 2) {
#pragma unroll
                for (int g4 = 0; g4 < 4; ++g4) { const int i0 = 32 * mi + 8 * g4 + 4 * hi; const f32x4 eg = *(const LAS f32x4*)(sc + i0);
#pragma unroll
                    for (int e = 0; e < 4; ++e) acc[4 * g4 + e] *= eg[e]; }
                if (n > 0) scan_out(oacc, lds + ((n - 1) & 1) * SC_SLOT, OD + ((size_t)b * SEQ + (dir ? 128 - n : n - 1) * 64) * 2048 + hloc * 128 + sl * 32, mi, r32, hi, lane);
                oacc = acc;
            }
            SC_BAR();
            {
                const float gl = sc[192];
                bf16x8 af[4], vf[4];
#pragma unroll
                for (int kk = 0; kk < 4; ++kk) { const int row = 32 * w + r32; af[kk] = *(const LAS bf16x8*)(lds + SC_KT + row * 128 + (((2 * kk + hi) ^ (row & 7)) << 4));
                    vf[kk] = *(const LAS bf16x8*)(Lb + SL_VSB + kk * 1024 + lane * 16); }
                S = S * gl;
#pragma unroll
                for (int kk = 0; kk < 4; ++kk) S = __builtin_amdgcn_mfma_f32_32x32x16_bf16(af[kk], vf[kk], S, 0, 0, 0);
                bf16x8 f0, f1; PK4S(S, 0, f0); PK4S(S, 8, f1);
                *(LAS bf16x8*)(lds + SC_SB + (2 * w) * 1024 + lane * 16) = f0; *(LAS bf16x8*)(lds + SC_SB + (2 * w + 1) * 1024 + lane * 16) = f1;
            }
        }
        if (w >= 2) { int r32 = lane & 31, hi = lane >> 5; scan_out(oacc, lds + (127 & 1) * SC_SLOT, OD + ((size_t)b * SEQ + (dir ? 0 : 127) * 64) * 2048 + hloc * 128 + sl * 32, w & 1, r32, hi, lane); }
    }
    __syncthreads();
}

constexpr int NPH = 24;

__device__ __forceinline__ void run_gemm_bf16(const Ctx& C, const bf16_t* A, const bf16_t* Bt, int N, int K, bf16_t* O) {
    pg8::Gemm g{A, Bt, T_TOK, N, K}; pg8::StaticOrder S; S.init(T_TOK, N, C.G, C.bid);
    pg8::EpiBf16 E{O, N};
    pg8::gemm_phase<pg8::EpiBf16, pg8::StaticOrder, true, true>(C.lds, g, S, E);
}
__device__ __forceinline__ void run_gemm_res(const Ctx& C, const bf16_t* A, const bf16_t* Bt, int K, const float* base) {
    pg8::Gemm g{A, Bt, T_TOK, DM, K}; pg8::StaticOrder S; S.init(T_TOK, DM, C.G, C.bid);
    pg8::EpiRes E{base, C.out, DM};
    pg8::gemm_phase<pg8::EpiRes, pg8::StaticOrder, true, true>(C.lds, g, S, E);
}

__global__ void __launch_bounds__(NTHR, 2) mega_fwd(const Args args) {
    extern __shared__ __attribute__((aligned(16))) unsigned char lds_raw[];
    cg::grid_group grid = cg::this_grid();
    Ctx C;
    C.out = args.out; C.ws = args.ws; C.lds = (LAS unsigned char*)lds_raw; C.ldsg = (char*)lds_raw;
    C.tid = threadIdx.x; C.lane = C.tid & 63; C.wave = __builtin_amdgcn_readfirstlane(C.tid >> 6); C.G = gridDim.x; C.bid = blockIdx.x;
    volatile LAS unsigned* bst = (volatile LAS unsigned*)((LAS unsigned char*)lds_raw + (LDS_BYTES - 64));
    if (threadIdx.x < 2) bst[threadIdx.x] = 0u;
    __syncthreads();
    XcdBarrier xbar; xbar.bar = nullptr; xbar.x = 0; xbar.st = bst;
    if (args.ph_hi - args.ph_lo > 1) xbar = xcd_barrier_post((unsigned*)(args.ws + WS_BAR), bst);
    for (int ph = args.ph_lo; ph < args.ph_hi; ++ph) {
        {
            __attribute__((address_space(1))) unsigned char* w_ = (__attribute__((address_space(1))) unsigned char*)args.ws; __attribute__((address_space(1))) float* o_ = (__attribute__((address_space(1))) float*)args.out; int t_ = threadIdx.x, g_ = gridDim.x, b_ = blockIdx.x;
            unsigned long long ka_ = (unsigned long long)__builtin_amdgcn_kernarg_segment_ptr();
            asm volatile("" : "+s"(w_), "+s"(o_), "+v"(t_), "+s"(g_), "+s"(b_), "+s"(ka_));
            C.ws = (unsigned char*)w_; C.out = (float*)o_; C.a = (const __attribute__((address_space(4))) Args*)ka_; C.G = g_; C.bid = b_; C.tid = t_; C.lane = t_ & 63; C.wave = __builtin_amdgcn_readfirstlane(t_ >> 6);
        }
        unsigned char* ws = C.ws;
        int kind, layer = 0, pass = 0;
        int sub = 0;
        if (ph == 0) { kind = 0; layer = 0; }
        else if (ph == 1) { kind = 1; sub = 0; }
        else if (ph == 2) kind = 2;
        else if (ph == 3) kind = 3;
        else if (ph == 4) { kind = 4; sub = 0; }
        else if (ph == 5) { kind = 5; layer = 0; }
        else if (ph >= 6 && ph <= 8) { layer = 0; const int q = ph - 6; if (q == 2) { kind = 4; sub = 1; } else if (q == 1) kind = 6; else kind = 12; }
        else if (ph == 9) { kind = 0; layer = 1; }
        else if (ph >= 10 && ph <= 18) { layer = 1;
            if (ph == 10) { kind = 7; sub = 2; pass = 0; } else if (ph == 14) { kind = 13; pass = 0; }
            else { pass = ph >= 15; const int q = pass ? ph - 14 : ph - 10; if (q == 1) kind = 8; else if (q == 2) kind = 9; else if (q == 3) kind = 10; else { kind = 4; sub = 2; } } }
        else if (ph == 19) { kind = 5; layer = 1; }
        else if (ph >= 20 && ph <= 22) { layer = 1; const int q = ph - 20; if (q == 2) { kind = 4; sub = 1; } else if (q == 1) kind = 6; else kind = 12; }
        else kind = 11;

#ifndef PH_MASK
#define PH_MASK 0xFFFF
#endif
#define EN(k) ((PH_MASK >> (k)) & 1)
        const int gw = C.bid * NWAVES + C.wave, NGW = C.G * NWAVES;
        if (kind == 0) { if (EN(0)) {
            if (layer == 0) ph_convert_mixer(C, 0, gw, NGW);
            rms_rows_bf16(layer == 0 ? INP(C, 0) : (const float*)C.out, INP(C, 1) + layer * DM, (bf16_t*)(ws + WS_XN), gw, NGW, C.lane); } }
        else if (kind == 1 || kind == 7) { if (EN(1)) {
            if (kind == 7) ph_ab_small(C);
            const bf16_t* A = (const bf16_t*)(ws + WS_XN); const bf16_t* Bt; int N; bf16_t* O;
            if (sub == 0) { Bt = (const bf16_t*)(ws + WS_W0_IN); N = 2560; O = (bf16_t*)(ws + WS_PROJ); }
            else if (sub == 1) { Bt = (const bf16_t*)(ws + WS_WUP) + (size_t)pass * 2816 * 1024; N = 2816; O = (bf16_t*)(ws + WS_RAWF); }
            else if (sub == 2) { Bt = (const bf16_t*)(ws + WS_WA) + (size_t)pass * 2048 * 1024; N = 2048; O = (bf16_t*)(ws + WS_RAWG); }
            else { Bt = (const bf16_t*)(ws + WS_WZ) + (size_t)pass * 1024 * 1024; N = 1024; O = (bf16_t*)(ws + WS_Z); }
            run_gemm_bf16(C, A, Bt, N, 1024, O);
            if (sub == 0) { int sgw, sngw; if (side_job(C, sgw, sngw)) ph_convert_ffn(C, 0, sgw, sngw); }
        } }
        else if (kind == 13) { if (EN(4)) {
            run_gemm_res(C, (const bf16_t*)(ws + WS_GO), (const bf16_t*)(ws + WS_WO), 1024, C.out);
            run_gemm_bf16(C, (const bf16_t*)(ws + WS_XN), (const bf16_t*)(ws + WS_WA) + (size_t)2048 * 1024, 2048, 1024, (bf16_t*)(ws + WS_RAWG)); } }
        else if (kind == 2) { if (EN(2)) ph_attn_post(C); }
        else if (kind == 3) { if (EN(3)) ph_attention(C); }
        else if (kind == 4) { if (EN(4)) {
            const bf16_t* A; const bf16_t* Bt; int K; const float* base = C.out;
            if (sub == 0) { A = (const bf16_t*)(ws + WS_AO); Bt = (const bf16_t*)(ws + WS_W0_OUT); K = 1024; base = INP(C, 0); }
            else if (sub == 1) { A = (const bf16_t*)(ws + WS_ACT); Bt = (const bf16_t*)(ws + WS_WDOWN); K = 2816; }
            else { A = (const bf16_t*)(ws + WS_GO); Bt = (const bf16_t*)(ws + WS_WO) + (size_t)pass * 1024 * 1024; K = 1024; }
            run_gemm_res(C, A, Bt, K, base);
        } }
        else if (kind == 5) { if (EN(5)) { rms_rows_bf16(C.out, INP(C, 2) + layer * DM, (bf16_t*)(ws + WS_XN), gw, NGW, C.lane); } }
        else if (kind == 6) { if (EN(6)) ph_ffn_fixup(C, layer); }
        else if (kind == 12) { if (EN(6)) {
            pg8::Gemm g{(const bf16_t*)(ws + WS_XN), (const bf16_t*)(ws + WS_WUP), T_TOK, 5632, 1024}; pg8::StaticOrder S; S.init(T_TOK, 5632, C.G, C.bid);
            pg8::EpiFfn E{(bf16_t*)(ws + WS_ACT), (float*)(ws + WS_EDGE), INP(C, 16) + (size_t)layer * 3 * 5632, INP(C, 17) + (size_t)layer * 5632, 0, (LAS float*)(C.lds + 131072)};
            pg8::gemm_phase<pg8::EpiFfn, pg8::StaticOrder, true, true>(C.lds, g, S, E);
            if (layer == 0) { int sgw, sngw; if (side_job(C, sgw, sngw)) ph_convert_mixer(C, 1, sgw, sngw); } } }
        else if (kind == 8) { if (EN(8)) ph_gdn_prep(C, pass, 0); }
        else if (kind == 9) { if (EN(9)) ph_gdn_scan(C, pass, xbar, pass == 1); }
        else if (kind == 10) { if (EN(10)) {
            pg8::Gemm g{(const bf16_t*)(ws + WS_XN), (const bf16_t*)(ws + WS_WZ) + (size_t)pass * 1024 * 1024, T_TOK, 1024, 1024}; pg8::StaticOrder S; S.init(T_TOK, 1024, C.G, C.bid);
            pg8::EpiGate E{(const bf16_t*)(ws + WS_OF), (const bf16_t*)(ws + WS_OB), (bf16_t*)(ws + WS_GO), INP(C, 13), (LAS float*)(C.lds + 131072)};
            pg8::gemm_phase<pg8::EpiGate, pg8::StaticOrder, true, true>(C.lds, g, S, E); } }
        else rms_rows_f32_inplace(C.out, INP(C, 3), gw, NGW, C.lane);

        if (ph + 1 < args.ph_hi) { if (args.ph_hi > 1000) grid.sync(); else xcd_barrier(xbar); }
#ifdef DBG_XSYNC
        if (ph + 1 < args.ph_hi) { xcd_barrier(xbar); xcd_barrier(xbar); }
#endif
    }
}


#ifdef DBG_DUMP_A
__global__ void dbg_dump(const unsigned short* a, const unsigned short* b, float* out) {
    for (size_t i = (size_t)blockIdx.x * blockDim.x + threadIdx.x; i < (size_t)T_TOK * DM; i += (size_t)gridDim.x * blockDim.x) {
        unsigned short x = a[i], y = b[i]; x &= 0x7fffu; y &= 0x7fffu; if (x > 0x7f00u) x = 0; if (y > 0x7f00u) y = 0;
        float f = __uint_as_float(((unsigned)x) << 16) + __uint_as_float(((unsigned)y) << 16); if (!(f < 1e30f)) f = 1e30f; out[i] = f; }
}
#endif
#ifndef MK_MULTI
#define MK_MULTI 0
#endif
extern "C" void kernel_launch(void* const* d_in, const int* in_sizes, int n_in, void* d_out, int out_size, void* d_ws, size_t ws_size, hipStream_t stream) {
    static int grid = 0;
    if (grid == 0) {
        if (n_in != 19 || out_size != T_TOK * DM || ws_size < WS_END) { fprintf(stderr, "kernel_launch: unexpected shapes (n_in %d out %d ws %zu)\n", n_in, out_size, ws_size); grid = -1; return; }
        int dev = 0, cus = 0, per_cu = 0;
        hipGetDevice(&dev); hipDeviceGetAttribute(&cus, hipDeviceAttributeMultiprocessorCount, dev);
        if (hipFuncSetAttribute((const void*)mega_fwd, hipFuncAttributeMaxDynamicSharedMemorySize, LDS_BYTES) != hipSuccess) { fprintf(stderr, "kernel_launch: hipFuncSetAttribute failed\n"); grid = -1; return; }
        if (hipOccupancyMaxActiveBlocksPerMultiprocessor(&per_cu, (const void*)mega_fwd, NTHR, LDS_BYTES) != hipSuccess || per_cu < 1) { fprintf(stderr, "kernel_launch: occupancy query says %d\n", per_cu); per_cu = 1; }
        (void)hipGetLastError();
        grid = cus * (per_cu > 1 ? 1 : per_cu);
    }
    if (grid < 0) return;
    Args a{};
    for (int i = 0; i < 19; ++i) a.in[i] = (const float*)d_in[i];
    a.out = (float*)d_out; a.ws = (unsigned char*)d_ws;
#if MK_MULTI
#ifndef DBG_STOP
#define DBG_STOP NPH
#endif
#ifndef DBG_REP
#define DBG_REP 0
#endif
    for (int ph = 0; ph < DBG_STOP; ++ph) { a.ph_lo = ph; a.ph_hi = ph + 1; const int nrep = ((DBG_REP >> ph) & 1) ? 3 : 1;
        for (int r = 0; r < nrep; ++r) hipLaunchKernelGGL(mega_fwd, dim3(grid), dim3(NTHR), LDS_BYTES, stream, a); }
#ifdef DBG_DUMP_A
    hipLaunchKernelGGL(dbg_dump, dim3(2048), dim3(256), 0, stream, (const unsigned short*)((char*)d_ws + (size_t)DBG_DUMP_A * MiB), (const unsigned short*)((char*)d_ws + (size_t)DBG_DUMP_B * MiB), (float*)d_out);
#endif
#else
    a.ph_lo = 0; a.ph_hi = NPH;
    if (hipMemsetAsync((char*)d_ws + WS_BAR, 0, XCD_BAR_WORDS * 4, stream) != hipSuccess) { fprintf(stderr, "kernel_launch: memset failed\n"); return; }
    void* kargs[] = {&a};
    hipError_t e = hipLaunchCooperativeKernel((const void*)mega_fwd, dim3(grid), dim3(NTHR), kargs, LDS_BYTES, stream);
    if (e != hipSuccess) fprintf(stderr, "cooperative launch failed: %s (grid %d)\n", hipGetErrorString(e), grid);
#endif
}
```

```cpp
#include <hip/hip_runtime.h>
#include <hip/hip_cooperative_groups.h>
#include <hip/hip_bf16.h>
#include <cstdio>
#include <cstdint>
#include <cmath>
namespace cg = cooperative_groups;
#define MK_MULTI 0

__device__ __forceinline__ int mk_tid() { int t = threadIdx.x; asm volatile("" : "+v"(t)); return t; }
namespace pg8 {
#define PG8_LAS __attribute__((address_space(3)))
typedef unsigned short bf16_t;
typedef short bf16x8 __attribute__((ext_vector_type(8)));
typedef float f32x4 __attribute__((ext_vector_type(4)));
typedef unsigned u32x4 __attribute__((ext_vector_type(4)));
constexpr int BM = 256, BK = 64, HALF = 128, HTB = HALF * BK * 2  , STAGE_BYTES = 8 * HTB, NXCD = 8, WGM = 8;

__host__ __device__ __forceinline__ int lds_byte(int r, int c) { const int st = (r >> 4) * 2 + (c >> 5), rr = r & 15, cc = c & 31, ob = rr * 64 + cc * 2; return st * 1024 + (ob ^ (((ob >> 9) & 1) << 5)); }
__host__ __device__ __forceinline__ void stage_rc(int b, int& R, int& C) { const int st = b / 1024, sb = b % 1024, swz = sb ^ (((sb >> 9) & 1) << 5); R = (st >> 1) * 16 + swz / 64; C = (st & 1) * 32 + (swz % 64) / 2; }
__host__ __device__ __forceinline__ int perm32(int rho) { const int n = rho >> 4, i = rho & 15; return 8 * (i >> 2) + 4 * n + (i & 3); }

struct Unit { int pm, pn; };
struct Gemm { const bf16_t* A; const bf16_t* Bt; int M, N, K; };

struct StaticOrder {
    int nM, nN, nwg, G, c;
    __host__ __device__ void init(int M, int N, int G_, int c_) { nM = M / BM; nN = N / BM; nwg = nM * nN; G = G_; c = c_; }
    __host__ __device__ bool next(int i, Unit& u) const {
        const long L = (long)i * G + c; if (L >= nwg) return false;
        int wgid = (int)L; { const int q = nwg / NXCD, r = nwg % NXCD, xcd = wgid % NXCD, off = wgid / NXCD; wgid = (xcd < r ? xcd * (q + 1) : r * (q + 1) + (xcd - r) * q) + off; }
        const int nig = WGM * nN, gid = wgid / nig, fm = gid * WGM, gsz = (nM - fm) < WGM ? (nM - fm) : WGM;
        u.pm = fm + ((wgid % nig) % gsz); u.pn = (wgid % nig) / gsz; return true;
    }
    __device__ __forceinline__ void a_ready(const Unit&) const {}
    __device__ __forceinline__ void done(const Unit&) const {}
};


typedef float f32x2 __attribute__((ext_vector_type(2)));
typedef __bf16 bf16x2_t __attribute__((ext_vector_type(2)));
__device__ __forceinline__ unsigned cvt_pk_bf16(float lo, float hi) { f32x2 v = {lo, hi}; bf16x2_t r = __builtin_convertvector(v, bf16x2_t); return __builtin_bit_cast(unsigned, r); }

struct EpiBf16 {
    static constexpr bool PERM = true, AFTER_DRAIN = false;
    bf16_t* O; int ldc;
    __device__ __forceinline__ void operator()(const f32x4 (&acc)[2][2][4][2], const Unit& u, int wr, int wc, int fr, int fq) const {
        const int row0 = u.pm * BM + wr * 64 + fr; const int col0 = u.pn * BM + wc * 32 + 8 * fq;
#pragma unroll
        for (int ai = 0; ai < 2; ++ai)
#pragma unroll
            for (int m = 0; m < 4; ++m) { bf16_t* rowp = O + (size_t)(row0 + ai * HALF + m * 16) * ldc + col0;
#pragma unroll
                for (int bj = 0; bj < 2; ++bj) { const f32x4 v0 = acc[ai][bj][m][0], v1 = acc[ai][bj][m][1];
                    u32x4 w; w.x = cvt_pk_bf16(v0[0], v0[1]); w.y = cvt_pk_bf16(v0[2], v0[3]); w.z = cvt_pk_bf16(v1[0], v1[1]); w.w = cvt_pk_bf16(v1[2], v1[3]);
                    *(u32x4*)(rowp + bj * HALF) = w; } }
    }
};
struct EpiF32 {
    static constexpr bool PERM = true, AFTER_DRAIN = false;
    float* O; int ldc;
    __device__ __forceinline__ void operator()(const f32x4 (&acc)[2][2][4][2], const Unit& u, int wr, int wc, int fr, int fq) const {
        const int row0 = u.pm * BM + wr * 64 + fr; const int col0 = u.pn * BM + wc * 32 + 8 * fq;
#pragma unroll
        for (int ai = 0; ai < 2; ++ai)
#pragma unroll
            for (int m = 0; m < 4; ++m) { float* rowp = O + (size_t)(row0 + ai * HALF + m * 16) * ldc + col0;
#pragma unroll
                for (int bj = 0; bj < 2; ++bj) { *(f32x4*)(rowp + bj * HALF) = acc[ai][bj][m][0]; *(f32x4*)(rowp + bj * HALF + 4) = acc[ai][bj][m][1]; } }
    }
};
struct EpiRes {
    static constexpr bool PERM = false, AFTER_DRAIN = false;
    const float* base; float* out; int ldc;
    __device__ __forceinline__ void operator()(const f32x4 (&acc)[2][2][4][2], const Unit& u, int wr, int wc, int fr, int fq) const {
        const int row0 = u.pm * BM + wr * 64 + fr; const int col0 = u.pn * BM + wc * 32 + 4 * fq;
#pragma unroll
        for (int ai = 0; ai < 2; ++ai)
#pragma unroll
            for (int m = 0; m < 4; ++m) { const size_t off = (size_t)(row0 + ai * HALF + m * 16) * ldc + col0;
#pragma unroll
                for (int bj = 0; bj < 2; ++bj)
#pragma unroll
                    for (int n = 0; n < 2; ++n) { const f32x4 b = *(const f32x4*)(base + off + bj * HALF + n * 16); *(f32x4*)(out + off + bj * HALF + n * 16) = b + acc[ai][bj][m][n]; } }
    }
};

struct EpiGate {
    static constexpr bool PERM = true, AFTER_DRAIN = false;
    const bf16_t* OF; const bf16_t* OB; bf16_t* GO; const float* gain; PG8_LAS float* tab;
    __device__ __forceinline__ void operator()(const f32x4 (&acc)[2][2][4][2], const Unit& u, int wr, int wc, int fr, int fq) const {
        const int tid = mk_tid();
        {
            const int row = tid >> 1, hd = tid & 1; const size_t off = (size_t)(u.pm * BM + row) * 2048 + u.pn * BM + hd * HALF;
            float ss = 0.f;
#pragma unroll 4
            for (int j = 0; j < 16; ++j) { const u32x4 a = *(const u32x4*)(OF + off + 8 * j), b = *(const u32x4*)(OB + off + 8 * j);
#pragma unroll
                for (int q = 0; q < 4; ++q) { const float lo = __uint_as_float(a[q] << 16) + __uint_as_float(b[q] << 16), hi = __uint_as_float(a[q] & 0xffff0000u) + __uint_as_float(b[q] & 0xffff0000u); ss += lo * lo + hi * hi; } }
            tab[row * 2 + hd] = rsqrtf(ss * (1.f / 128.f) + 1e-6f);
        }
        asm volatile("s_waitcnt lgkmcnt(0)" ::: "memory"); __builtin_amdgcn_s_barrier(); asm volatile("" ::: "memory");
        const int row0 = wr * 64 + fr; const int colw = wc * 32 + 8 * fq;
        f32x4 g0 = *(const f32x4*)(gain + colw), g1 = *(const f32x4*)(gain + colw + 4);
#pragma unroll
        for (int ai = 0; ai < 2; ++ai)
#pragma unroll
            for (int m = 0; m < 4; ++m) { const int rt = row0 + ai * HALF + m * 16;
#pragma unroll
                for (int bj = 0; bj < 2; ++bj) { const size_t off = (size_t)(u.pm * BM + rt) * 1024 + u.pn * BM + bj * HALF + colw, offo = off + (size_t)(u.pm * BM + rt) * 1024;
                    const float rs = tab[rt * 2 + bj];
                    const u32x4 a = *(const u32x4*)(OF + offo), b = *(const u32x4*)(OB + offo);
                    const f32x4 z0 = acc[ai][bj][m][0], z1 = acc[ai][bj][m][1];
                    float o[8];
#pragma unroll
                    for (int q = 0; q < 4; ++q) { o[2 * q] = __uint_as_float(a[q] << 16) + __uint_as_float(b[q] << 16); o[2 * q + 1] = __uint_as_float(a[q] & 0xffff0000u) + __uint_as_float(b[q] & 0xffff0000u); }
#pragma unroll
                    for (int e = 0; e < 4; ++e) { o[e] = o[e] * rs * g0[e] * (z0[e] / (1.f + __expf(-z0[e]))); o[4 + e] = o[4 + e] * rs * g1[e] * (z1[e] / (1.f + __expf(-z1[e]))); }
                    u32x4 w; w.x = cvt_pk_bf16(o[0], o[1]); w.y = cvt_pk_bf16(o[2], o[3]); w.z = cvt_pk_bf16(o[4], o[5]); w.w = cvt_pk_bf16(o[6], o[7]);
                    *(u32x4*)(GO + off) = w; }
                asm volatile("" ::: "memory"); }
        asm volatile("s_waitcnt lgkmcnt(0)" ::: "memory"); __builtin_amdgcn_s_barrier(); asm volatile("" ::: "memory");
    }
};

typedef unsigned u32x2 __attribute__((ext_vector_type(2)));
__device__ __forceinline__ float dpp_ror1(float v)  { return __int_as_float(__builtin_amdgcn_update_dpp(0, __float_as_int(v), 0x121, 0xF, 0xF, false)); }
__device__ __forceinline__ float dpp_ror15(float v) { return __int_as_float(__builtin_amdgcn_update_dpp(0, __float_as_int(v), 0x12F, 0xF, 0xF, false)); }
struct EpiFfn {
    static constexpr bool PERM = true, AFTER_DRAIN = false;
    bf16_t* ACT; float* EDGE; const float* cw; const float* cb; int chan0; PG8_LAS float* bt;
    __device__ __forceinline__ void operator()(const f32x4 (&acc)[2][2][4][2], const Unit& u, int wr, int wc, int fr, int fq) const {
        const int chl = wc * 32 + 8 * fq;
        const int cha = chan0 + u.pn * 128 + chl, chb = 2816 + cha;
        PG8_LAS float* wt = bt + 2048;
        { const int t = mk_tid(); if (t < 256) { const int ch = (t < 128) ? (chan0 + u.pn * 128 + t) : (2816 + chan0 + u.pn * 128 + (t - 128));
            wt[t] = cw[ch]; wt[256 + t] = cw[5632 + ch]; wt[512 + t] = cw[2 * 5632 + ch]; wt[768 + t] = cb[ch]; } }
#pragma unroll
        for (int ai = 0; ai < 2; ++ai) { const int beta = 2 * ai + wr;
#pragma unroll
            for (int bj = 0; bj < 2; ++bj)
#pragma unroll
                for (int n = 0; n < 2; ++n) { const int col = 128 * bj + chl + 4 * n;
                    if (fr == 0)  *(PG8_LAS f32x4*)(bt + (2 * beta) * 256 + col) = acc[ai][bj][0][n];
                    if (fr == 15) *(PG8_LAS f32x4*)(bt + (2 * beta + 1) * 256 + col) = acc[ai][bj][3][n];
                    float* eg = EDGE + (size_t)((u.pm * 22 + u.pn) * 4) * 256 + col;
                    if (beta == 0 && fr < 2)  *(f32x4*)(eg + fr * 256) = acc[ai][bj][0][n];
                    if (beta == 3 && fr >= 14) *(f32x4*)(eg + (fr - 12) * 256) = acc[ai][bj][3][n]; } }
        asm volatile("s_waitcnt lgkmcnt(0)" ::: "memory"); __builtin_amdgcn_s_barrier(); asm volatile("" ::: "memory");
#pragma unroll
        for (int n = 0; n < 2; ++n) {
            f32x4 tp[2][4];
#pragma unroll
            for (int bj = 0; bj < 2; ++bj)
#pragma unroll
                for (int s = 0; s < 4; ++s) tp[bj][s] = *(const PG8_LAS f32x4*)(wt + s * 256 + 128 * bj + chl + 4 * n);
#pragma unroll
            for (int ai = 0; ai < 2; ++ai) { const int beta = 2 * ai + wr;
#pragma unroll
                for (int m = 0; m < 4; ++m) {
                    const int trow = 128 * ai + 64 * wr + 16 * m + fr;
                    f32x4 yy[2];
#pragma unroll
                    for (int bj = 0; bj < 2; ++bj) {
                        const f32x4 cur = acc[ai][bj][m][n]; f32x4 pv, nx;
                        const int col = 128 * bj + chl + 4 * n;
                        f32x4 pe, ne;
                        if (m > 0) { const f32x4 t = acc[ai][bj][m > 0 ? m - 1 : 0][n]; pe = (f32x4){dpp_ror1(t[0]), dpp_ror1(t[1]), dpp_ror1(t[2]), dpp_ror1(t[3])}; }
                        else pe = (beta > 0) ? *(const PG8_LAS f32x4*)(bt + (2 * (beta - 1) + 1) * 256 + col) : (f32x4){0.f, 0.f, 0.f, 0.f};
                        if (m < 3) { const f32x4 t = acc[ai][bj][m < 3 ? m + 1 : 3][n]; ne = (f32x4){dpp_ror15(t[0]), dpp_ror15(t[1]), dpp_ror15(t[2]), dpp_ror15(t[3])}; }
                        else ne = (beta < 3) ? *(const PG8_LAS f32x4*)(bt + (2 * (beta + 1)) * 256 + col) : (f32x4){0.f, 0.f, 0.f, 0.f};
#pragma unroll
                        for (int e = 0; e < 4; ++e) {
                            pv[e] = __int_as_float(__builtin_amdgcn_update_dpp(__float_as_int(pe[e]), __float_as_int(cur[e]), 0x111, 0xF, 0xF, false));
                            nx[e] = __int_as_float(__builtin_amdgcn_update_dpp(__float_as_int(ne[e]), __float_as_int(cur[e]), 0x101, 0xF, 0xF, false)); }
                        yy[bj] = tp[bj][0] * pv + tp[bj][1] * cur + tp[bj][2] * nx + tp[bj][3];
                    }
                    float o[4];
#pragma unroll
                    for (int e = 0; e < 4; ++e) o[e] = yy[0][e] * __builtin_amdgcn_rcpf(1.f + __expf(-yy[0][e])) * yy[1][e];
                    if (trow != 0 && trow != 255) { u32x2 w; w.x = cvt_pk_bf16(o[0], o[1]); w.y = cvt_pk_bf16(o[2], o[3]);
                        *(u32x2*)(ACT + (size_t)(u.pm * BM + trow) * 2816 + cha + 4 * n) = w; }
                } }
        }
        asm volatile("s_waitcnt lgkmcnt(0)" ::: "memory"); __builtin_amdgcn_s_barrier(); asm volatile("" ::: "memory");
    }
};

template <class Epi, class Sched, bool ALIGN_EPI = false, bool SP2 = false>
__device__ __forceinline__ void gemm_phase(PG8_LAS unsigned char* lds, const Gemm g, const Sched& S, const Epi& E) {
    const int tid = mk_tid(), wid = __builtin_amdgcn_readfirstlane(tid >> 6), lane = tid & 63, wr = wid >> 2, wc = wid & 3, fr = lane & 15, fq = lane >> 4;
    const int K = g.K, nt = K / BK;
    unsigned voffA[2], voffB[2];
#pragma unroll
    for (int i = 0; i < 2; ++i) { int R, C; stage_rc(tid * 16 + i * 8192, R, C); const int Rb = Epi::PERM ? ((R & ~31) + perm32(R & 31)) : R;
        voffA[i] = (unsigned)(R * K + C) * 2u; voffB[i] = (unsigned)(Rb * K + C) * 2u; }
    const size_t kstep = (size_t)(BK * 2);
    const size_t hstep = (size_t)HALF * K * 2;
    const size_t tstep = 2 * hstep;
    const unsigned ldsw = (unsigned)wid * 1024u;
    const int aoff = lds_byte(wr * 64 + fr, fq * 8), boff = lds_byte(wc * 32 + fr, fq * 8);
#define PG8_SA(b, h) (((b) * 2 + (h)) * HTB)
#define PG8_SB(b, h) ((4 + (b) * 2 + (h)) * HTB)
#define PG8_STAGE(bufoff, gbase, voff) do { _Pragma("unroll") for (int _i = 0; _i < 2; ++_i) \
        __builtin_amdgcn_global_load_lds((const unsigned*)((const char*)(gbase) + (voff)[_i]), (PG8_LAS unsigned*)(lds + (bufoff) + ldsw + _i * 8192), 16, 0, 0); } while (0)
#define PG8_LDA(dst, b, h) do { _Pragma("unroll") for (int m = 0; m < 4; ++m) _Pragma("unroll") for (int k = 0; k < 2; ++k) dst[m][k] = *(const PG8_LAS bf16x8*)(lds + PG8_SA(b, h) + aoff + m * 2048 + k * 1024); } while (0)
#define PG8_LDB(dst, b, h) do { _Pragma("unroll") for (int n = 0; n < 2; ++n) _Pragma("unroll") for (int k = 0; k < 2; ++k) dst[n][k] = *(const PG8_LAS bf16x8*)(lds + PG8_SB(b, h) + boff + n * 2048 + k * 1024); } while (0)
#define PG8_MMA(ai, bj, At, Bt) do { __builtin_amdgcn_s_setprio(1); _Pragma("unroll") for (int m = 0; m < 4; ++m) _Pragma("unroll") for (int n = 0; n < 2; ++n) _Pragma("unroll") for (int k = 0; k < 2; ++k) \
        acc[ai][bj][m][n] = __builtin_amdgcn_mfma_f32_16x16x32_bf16(Bt[n][k], At[m][k], acc[ai][bj][m][n], 0, 0, 0); __builtin_amdgcn_s_setprio(0); } while (0)
#define PG8_WAIT_V(n) asm volatile("s_waitcnt vmcnt(" #n ")" ::: "memory")
#define PG8_WAIT_L(n) asm volatile("s_waitcnt lgkmcnt(" #n ")" ::: "memory")
#define PG8_BAR __builtin_amdgcn_s_barrier()
#define PG8_SCHED __builtin_amdgcn_sched_barrier(0)
    Unit cur, nxt; int ui = 0;
    if (!S.next(0, cur)) return;
    f32x4 acc[2][2][4][2];
    float zr_ = 0.f; asm volatile("" : "+v"(zr_));
#pragma unroll
    for (int a = 0; a < 2; ++a)
#pragma unroll
        for (int b = 0; b < 2; ++b)
#pragma unroll
            for (int m = 0; m < 4; ++m)
#pragma unroll
                for (int n = 0; n < 2; ++n) acc[a][b][m][n] = (f32x4){zr_, zr_, zr_, zr_};
    bf16x8 At[4][2], B0[2][2], B1[2][2];
    const char* cA = (const char*)g.A + (size_t)cur.pm * tstep; const char* cB = (const char*)g.Bt + (size_t)cur.pn * tstep;
    S.a_ready(cur);
    if constexpr (SP2) {
        PG8_STAGE(PG8_SB(0, 0), cB, voffB); PG8_STAGE(PG8_SB(0, 1), cB + hstep, voffB); PG8_STAGE(PG8_SA(0, 0), cA, voffA); PG8_STAGE(PG8_SA(0, 1), cA + hstep, voffA);
        if (wr == 1) PG8_BAR;
        PG8_WAIT_V(2); PG8_BAR;
        PG8_STAGE(PG8_SB(1, 0), cB + kstep, voffB); PG8_STAGE(PG8_SA(1, 0), cA + kstep, voffA); PG8_STAGE(PG8_SB(1, 1), cB + hstep + kstep, voffB);
        PG8_WAIT_V(6); PG8_BAR;
    } else {
        PG8_STAGE(PG8_SB(0, 0), cB, voffB); PG8_STAGE(PG8_SA(0, 0), cA, voffA); PG8_STAGE(PG8_SB(0, 1), cB + hstep, voffB); PG8_STAGE(PG8_SA(0, 1), cA + hstep, voffA);
        if (wr == 1) PG8_BAR;
        PG8_WAIT_V(4); PG8_BAR;
        PG8_STAGE(PG8_SB(1, 0), cB + kstep, voffB); PG8_STAGE(PG8_SA(1, 0), cA + kstep, voffA); PG8_STAGE(PG8_SB(1, 1), cB + hstep + kstep, voffB);
        PG8_WAIT_V(6); PG8_BAR;
    }
    for (;;) {
        const bool has_next = S.next(ui + 1, nxt);
        const char* nA = has_next ? (const char*)g.A + (size_t)nxt.pm * tstep : cA; const char* nB = has_next ? (const char*)g.Bt + (size_t)nxt.pn * tstep : cB;
        for (int t = 0; t < nt; t += 2) {
            const bool last = (t == nt - 2);
            const char* a1 = cA + (size_t)(t + 1) * kstep;
            const char* a2 = last ? nA : cA + (size_t)(t + 2) * kstep; const char* b2 = last ? nB : cB + (size_t)(t + 2) * kstep;
            const char* a3 = a2 + kstep; const char* b3 = b2 + kstep;
            if (last && has_next) S.a_ready(nxt);
            if constexpr (SP2) {
            PG8_LDB(B0, 0, 0); PG8_LDB(B1, 0, 1); PG8_SCHED; PG8_LDA(At, 0, 0); PG8_STAGE(PG8_SA(1, 1), a1 + hstep, voffA);
            PG8_WAIT_V(8); PG8_WAIT_L(0); PG8_BAR; PG8_MMA(0, 0, At, B0); PG8_MMA(0, 1, At, B1); PG8_BAR; PG8_SCHED;
            PG8_LDA(At, 0, 1); PG8_STAGE(PG8_SB(0, 0), b2, voffB); PG8_STAGE(PG8_SB(0, 1), b2 + hstep, voffB); PG8_STAGE(PG8_SA(0, 0), a2, voffA);
            PG8_WAIT_V(8); PG8_WAIT_L(0); PG8_BAR; PG8_MMA(1, 0, At, B0); PG8_MMA(1, 1, At, B1); PG8_BAR; PG8_SCHED;
            PG8_LDB(B0, 1, 0); PG8_LDB(B1, 1, 1); PG8_SCHED; PG8_LDA(At, 1, 0); PG8_STAGE(PG8_SA(0, 1), a2 + hstep, voffA);
            PG8_WAIT_V(8); PG8_WAIT_L(0); PG8_BAR; PG8_MMA(0, 0, At, B0); PG8_MMA(0, 1, At, B1); PG8_BAR; PG8_SCHED;
            PG8_LDA(At, 1, 1); PG8_STAGE(PG8_SB(1, 0), b3, voffB); PG8_STAGE(PG8_SB(1, 1), b3 + hstep, voffB); PG8_STAGE(PG8_SA(1, 0), a3, voffA);
            PG8_WAIT_V(8); PG8_WAIT_L(0); PG8_BAR; PG8_MMA(1, 0, At, B0); PG8_MMA(1, 1, At, B1); PG8_BAR; PG8_SCHED;
            } else {
            PG8_LDB(B0, 0, 0); PG8_SCHED; PG8_LDA(At, 0, 0); PG8_STAGE(PG8_SA(1, 1), a1 + hstep, voffA);
            PG8_WAIT_L(8); PG8_BAR; PG8_WAIT_L(0); PG8_MMA(0, 0, At, B0); PG8_BAR; PG8_SCHED;
            PG8_LDB(B1, 0, 1); PG8_STAGE(PG8_SB(0, 0), b2, voffB);
            PG8_BAR; PG8_WAIT_L(0); PG8_MMA(0, 1, At, B1); PG8_BAR;
            PG8_LDA(At, 0, 1); PG8_STAGE(PG8_SA(0, 0), a2, voffA);
            PG8_BAR; PG8_WAIT_L(0); PG8_MMA(1, 0, At, B0); PG8_BAR; PG8_SCHED;
            PG8_STAGE(PG8_SB(0, 1), b2 + hstep, voffB);
            PG8_WAIT_V(6); PG8_BAR; PG8_MMA(1, 1, At, B1); PG8_BAR;
            PG8_LDB(B0, 1, 0); PG8_SCHED; PG8_LDA(At, 1, 0); PG8_STAGE(PG8_SA(0, 1), a2 + hstep, voffA);
            PG8_WAIT_L(8); PG8_BAR; PG8_WAIT_L(0); PG8_MMA(0, 0, At, B0); PG8_BAR; PG8_SCHED;
            PG8_LDB(B1, 1, 1); PG8_STAGE(PG8_SB(1, 0), b3, voffB);
            PG8_BAR; PG8_WAIT_L(0); PG8_MMA(0, 1, At, B1); PG8_BAR;
            PG8_LDA(At, 1, 1); PG8_STAGE(PG8_SA(1, 0), a3, voffA);
            PG8_BAR; PG8_WAIT_L(0); PG8_MMA(1, 0, At, B0); PG8_BAR; PG8_SCHED;
            PG8_STAGE(PG8_SB(1, 1), b3 + hstep, voffB);
            PG8_WAIT_V(6); PG8_BAR; PG8_MMA(1, 1, At, B1); PG8_BAR;
            }
        }
        if constexpr (ALIGN_EPI) { if (wr == 0) PG8_BAR; }
        if constexpr (!Epi::AFTER_DRAIN) { E(acc, cur, wr, wc, fr, fq); S.done(cur); }
        if (!has_next) break;
#pragma unroll
        for (int a = 0; a < 2; ++a)
#pragma unroll
            for (int b = 0; b < 2; ++b)
#pragma unroll
                for (int m = 0; m < 4; ++m)
#pragma unroll
                    for (int n = 0; n < 2; ++n) acc[a][b][m][n] = (f32x4){zr_, zr_, zr_, zr_};
        cur = nxt; cA = nA; cB = nB; ++ui;
        if constexpr (ALIGN_EPI) { if (wr == 1) PG8_BAR; }
    }
    PG8_WAIT_V(0);
    if constexpr (!ALIGN_EPI) { if (wr == 0) PG8_BAR; }
    PG8_BAR;
    if constexpr (Epi::AFTER_DRAIN) { E.fused(acc, cur, wr, wc, fr, fq, lds, wid, lane); S.done(cur); }
#undef PG8_SA
#undef PG8_SB
#undef PG8_STAGE
#undef PG8_LDA
#undef PG8_LDB
#undef PG8_MMA
#undef PG8_WAIT_V
#undef PG8_WAIT_L
#undef PG8_BAR
#undef PG8_SCHED
}
}

namespace attn {
using bf16 = __hip_bfloat16;
constexpr int   D = 128, NW = 8, QBLK = 32, KVBLK = 64;
constexpr float SCALE = 0.088388347648318440f;
constexpr float THR = 8.f;
constexpr int SDEPTH = 2;
constexpr int LDQ = 2560, LDK = 2560, LDO = 1024;
constexpr size_t SHM_V = KVBLK * D * 2, SHM_K = KVBLK * D * 2, SHM_ATTN = 2 * SHM_V + 2 * SHM_K + NW * 64 * 4;
using bf16x8 = __attribute__((ext_vector_type(8))) short;
using s16x4  = __attribute__((ext_vector_type(4))) short;
using f32x16 = __attribute__((ext_vector_type(16))) float;
using f32x8  = __attribute__((ext_vector_type(8))) float;
using u32x4  = __attribute__((ext_vector_type(4))) unsigned;
#define KSWZ(row, colB) ((row) * 256 + ((colB) ^ (((row) & 7) << 4)))
#define SBAR() __builtin_amdgcn_sched_barrier(0)
__device__ __forceinline__ int crow(int r, int hi) { return (r & 3) + 8 * (r >> 2) + 4 * hi; }
__device__ __forceinline__ unsigned cvtpk(float lo, float hi) {
  unsigned r; asm volatile("v_cvt_pk_bf16_f32 %0, %1, %2" : "=v"(r) : "v"(lo), "v"(hi)); return r;
}
template <typename TIn> struct Stage;
template <> struct Stage<bf16>  { using T = bf16x8;
  __device__ static __forceinline__ T ld8(const bf16* p) { return *reinterpret_cast<const bf16x8*>(p); }
  __device__ static __forceinline__ bf16x8 tobf(T x) { return x; } };
template <> struct Stage<float> { using T = f32x8;
  __device__ static __forceinline__ T ld8(const float* p) { return *reinterpret_cast<const f32x8*>(p); }
  __device__ static __forceinline__ bf16x8 tobf(T x) {
    u32x4 w = {cvtpk(x[0], x[1]), cvtpk(x[2], x[3]), cvtpk(x[4], x[5]), cvtpk(x[6], x[7])}; return *reinterpret_cast<bf16x8*>(&w); } };

__device__ __forceinline__ void partialSM(f32x16& p0, f32x16& p1, float& m_reg, float& mn, float& alpha) {
  constexpr float C = SCALE * 1.4426950408889634f;
  float pmax = p0[0]; for (int r = 1; r < 16; ++r) pmax = fmaxf(pmax, p0[r]); for (int r = 0; r < 16; ++r) pmax = fmaxf(pmax, p1[r]);
  { auto rr = __builtin_amdgcn_permlane32_swap(__float_as_uint(pmax), __float_as_uint(pmax), false, false);
    pmax = fmaxf(__uint_as_float(rr[0]), __uint_as_float(rr[1])); }
  if (__builtin_expect(__all(pmax - m_reg <= THR / SCALE), 1)) { mn = m_reg; alpha = 1.f; }
  else { mn = fmaxf(m_reg, pmax); alpha = __builtin_amdgcn_exp2f((m_reg - mn) * C); m_reg = mn; }
  float mnC = -mn * C;
  for (int r = 0; r < 16; ++r) p0[r] = fmaf(p0[r], C, mnC); for (int r = 0; r < 16; ++r) p1[r] = fmaf(p1[r], C, mnC);
  for (int r = 0; r < 16; ++r) p0[r] = __builtin_amdgcn_exp2f(p0[r]);
}
__device__ __forceinline__ void finishSM(f32x16& p0, f32x16& p1, float alpha, float& l_reg, bf16x8& pa0, bf16x8& pa1, bf16x8& pa2, bf16x8& pa3) {
  for (int r = 0; r < 16; ++r) p1[r] = __builtin_amdgcn_exp2f(p1[r]);
  float ps = 0; for (int r = 0; r < 16; ++r) ps += p0[r]; for (int r = 0; r < 16; ++r) ps += p1[r];
  { auto rr = __builtin_amdgcn_permlane32_swap(__float_as_uint(ps), __float_as_uint(ps), false, false);
    ps = __uint_as_float(rr[0]) + __uint_as_float(rr[1]); }
  l_reg = l_reg * alpha + ps;
#define PK4(P, BASE, OUT) do { unsigned a0 = cvtpk(P[BASE + 0], P[BASE + 1]), a1 = cvtpk(P[BASE + 2], P[BASE + 3]);   \
    unsigned b0 = cvtpk(P[BASE + 4], P[BASE + 5]), b1 = cvtpk(P[BASE + 6], P[BASE + 7]);                              \
    auto r0 = __builtin_amdgcn_permlane32_swap(a0, b0, false, false); auto r1 = __builtin_amdgcn_permlane32_swap(a1, b1, false, false); \
    u32x4 w = {r0[0], r1[0], r0[1], r1[1]}; OUT = *reinterpret_cast<bf16x8*>(&w); } while (0)
  PK4(p0, 0, pa0); PK4(p0, 8, pa1); PK4(p1, 0, pa2); PK4(p1, 8, pa3);
#undef PK4
}
__device__ __forceinline__ void qkt(f32x16& p0, f32x16& p1, const bf16* Ks, const bf16x8* qr, int r32, int hi) {
  p0 = f32x16{}; p1 = f32x16{};
  for (int d0 = 0; d0 < 8; ++d0) { int cb = (d0 * 16 + hi * 8) * 2;
    bf16x8 b0 = *reinterpret_cast<const bf16x8*>((const char*)Ks + KSWZ(r32, cb));
    bf16x8 b1 = *reinterpret_cast<const bf16x8*>((const char*)Ks + KSWZ(32 + r32, cb));
    p0 = __builtin_amdgcn_mfma_f32_32x32x16_bf16(b0, qr[d0], p0, 0, 0, 0);
    p1 = __builtin_amdgcn_mfma_f32_32x32x16_bf16(b1, qr[d0], p1, 0, 0, 0); }
}
__device__ __forceinline__ int v_st(int k, int c) { const int kk = (k & ~0xC) | ((k & 4) << 1) | ((k & 8) >> 1); return ((kk >> 3) * 4 + (c >> 5)) * 512 + ((kk & 7) * 32 + (c & 31)) * 2; }
__device__ __forceinline__ int v_rd_base(int lane) { return ((lane & 3) << 3) | (((lane >> 2) & 3) << 6) | (((lane >> 4) & 1) << 5) | (((lane >> 5) & 1) << 8); }
constexpr int v_rd_off(int d0, int ks, int half) { return d0 * 512 + ks * 4096 + half * 2048; }
template <int OFF> __device__ __forceinline__ s16x4 tr_read(int vb) {
  s16x4 r; asm volatile("ds_read_b64_tr_b16 %0, %1 offset:%2" : "=&v"(r) : "v"(vb), "i"(OFF) : "memory"); return r;
}
template <int D0> __device__ __forceinline__ void pv_one(f32x16& od, int vb, bf16x8 pa0, bf16x8 pa1, bf16x8 pa2, bf16x8 pa3) {
  const s16x4 l0 = tr_read<v_rd_off(D0, 0, 0)>(vb), h0 = tr_read<v_rd_off(D0, 0, 1)>(vb), l1 = tr_read<v_rd_off(D0, 1, 0)>(vb), h1 = tr_read<v_rd_off(D0, 1, 1)>(vb);
  const s16x4 l2 = tr_read<v_rd_off(D0, 2, 0)>(vb), h2 = tr_read<v_rd_off(D0, 2, 1)>(vb), l3 = tr_read<v_rd_off(D0, 3, 0)>(vb), h3 = tr_read<v_rd_off(D0, 3, 1)>(vb);
  asm volatile("s_waitcnt lgkmcnt(0)" ::: "memory"); SBAR();
#define PK(L, H) (bf16x8){L[0], L[1], L[2], L[3], H[0], H[1], H[2], H[3]}
  od = __builtin_amdgcn_mfma_f32_32x32x16_bf16(pa0, PK(l0, h0), od, 0, 0, 0);
  od = __builtin_amdgcn_mfma_f32_32x32x16_bf16(pa1, PK(l1, h1), od, 0, 0, 0);
  od = __builtin_amdgcn_mfma_f32_32x32x16_bf16(pa2, PK(l2, h2), od, 0, 0, 0);
  od = __builtin_amdgcn_mfma_f32_32x32x16_bf16(pa3, PK(l3, h3), od, 0, 0, 0);
#undef PK
}
__device__ __forceinline__ void pv_d0(f32x16* o, int vb, bf16x8 pa0, bf16x8 pa1, bf16x8 pa2, bf16x8 pa3) {
  pv_one<0>(o[0], vb, pa0, pa1, pa2, pa3); pv_one<1>(o[1], vb, pa0, pa1, pa2, pa3); pv_one<2>(o[2], vb, pa0, pa1, pa2, pa3); pv_one<3>(o[3], vb, pa0, pa1, pa2, pa3);
}

__device__ __forceinline__ void attn_dense_body(const bf16* __restrict__ Qb, const bf16* __restrict__ Kh, const bf16* __restrict__ Vh,
                                                const unsigned short* __restrict__ Gb, unsigned short* __restrict__ Ob, int seq, char* lds,
                                                const float* __restrict__ rtab, const float* __restrict__ qgain, int t0) {
  using TQ = bf16; using St = Stage<bf16>; using SQ = Stage<TQ>;
  const int tid = mk_tid(), wid = __builtin_amdgcn_readfirstlane(tid >> 6), lane = tid & 63, r32 = lane & 31, hi = lane >> 5;
  bf16* V_lds = (bf16*)lds; bf16* K_lds = (bf16*)(lds + 2 * SHM_V);
  float* ws = (float*)(lds + 2 * SHM_V + 2 * SHM_K) + wid * 64; float* li_l = ws; float* al_l = ws + 32;
  float m_reg = -1e30f, l_reg = 0; f32x16 o[4] = {}; bf16x8 qr[8];
  const TQ* Qw = Qb + (long)(wid * QBLK + r32) * LDQ + hi * 8;
  {
    float qf[8][8];
#pragma unroll
    for (int d0 = 0; d0 < 8; ++d0) { const bf16x8 x = SQ::tobf(SQ::ld8(Qw + d0 * 16));
#pragma unroll
      for (int e = 0; e < 8; ++e) qf[d0][e] = __uint_as_float(((unsigned)(unsigned short)x[e]) << 16); }
    float ss = 0.f;
#pragma unroll
    for (int d0 = 0; d0 < 8; ++d0)
#pragma unroll
      for (int e = 0; e < 8; ++e) ss += qf[d0][e] * qf[d0][e];
    ss += __shfl_xor(ss, 32);
    const float rs = rsqrtf(ss * (1.f / 128.f) + 1e-6f);
#pragma unroll
    for (int d0 = 0; d0 < 8; ++d0) { const float* gp = qgain + d0 * 16 + hi * 8;
#pragma unroll
      for (int e = 0; e < 8; ++e) qf[d0][e] *= rs * gp[e]; }
    const int tq = t0 + wid * QBLK + r32, prow = tq >> 6, pcol = tq & 63;
#pragma unroll
    for (int half = 0; half < 2; ++half) { const float* ct = rtab + (half ? 8192 + pcol * 32 : prow * 32) + hi * 8; const float* st = ct + (half ? 2048 : 4096);
#pragma unroll
      for (int dd = 0; dd < 2; ++dd) { const int a = 4 * half + dd, b = a + 2;
#pragma unroll
        for (int e = 0; e < 8; ++e) { const float c = ct[16 * dd + e], sn = st[16 * dd + e], z1 = qf[a][e], z2 = qf[b][e]; qf[a][e] = z1 * c - z2 * sn; qf[b][e] = z1 * sn + z2 * c; } } }
#pragma unroll
    for (int d0 = 0; d0 < 8; ++d0) { u32x4 w;
#pragma unroll
      for (int q = 0; q < 4; ++q) w[q] = cvtpk(qf[d0][2 * q], qf[d0][2 * q + 1]);
      qr[d0] = *reinterpret_cast<bf16x8*>(&w); }
  }
  const int sr = tid >> 4, sc = (tid & 15) * 8, vst0 = v_st(sr, sc), vst1 = v_st(32 + sr, sc);
  const int vb0 = (int)(uintptr_t)V_lds + v_rd_base(lane);
  struct { typename St::T vs0, vs1, ks0, ks1; } sr_[SDEPTH];
#define SLOAD(i, k0) do { sr_[i].vs0 = St::ld8(&Vh[(long)((k0) + sr) * LDK + sc]); sr_[i].vs1 = St::ld8(&Vh[(long)((k0) + 32 + sr) * LDK + sc]); \
    sr_[i].ks0 = St::ld8(&Kh[(long)((k0) + sr) * LDK + sc]); sr_[i].ks1 = St::ld8(&Kh[(long)((k0) + 32 + sr) * LDK + sc]); } while (0)
#define SWRITE(b, i) do { *(bf16x8*)((char*)V_lds + (b) * SHM_V + vst0) = St::tobf(sr_[i].vs0);          \
    *(bf16x8*)((char*)V_lds + (b) * SHM_V + vst1) = St::tobf(sr_[i].vs1); int kc = sc * 2;               \
    *(bf16x8*)((char*)K_lds + (b) * SHM_K + KSWZ(sr, kc)) = St::tobf(sr_[i].ks0);                       \
    *(bf16x8*)((char*)K_lds + (b) * SHM_K + KSWZ(32 + sr, kc)) = St::tobf(sr_[i].ks1); } while (0)
#define SWAIT() do { if constexpr (SDEPTH == 2) asm volatile("s_waitcnt vmcnt(4)" ::: "memory"); else asm volatile("s_waitcnt vmcnt(0)" ::: "memory"); } while (0)
#define RESC(a) do { if (__any((a) < 1.f)) { if (hi == 0) al_l[r32] = (a); asm volatile("s_waitcnt lgkmcnt(0)" ::: "memory"); \
    for (int d = 0; d < 4; ++d) for (int r = 0; r < 16; ++r) o[d][r] *= al_l[crow(r, hi)]; } } while (0)
  f32x16 pA0, pA1, pB0, pB1; float mnA, mnB, alA, alB; bf16x8 pa0, pa1, pa2, pa3; const int NT = seq / KVBLK;
  constexpr int SE = 0, SO = SDEPTH - 1;
  SLOAD(SE, 0); asm volatile("s_waitcnt vmcnt(0)" ::: "memory"); SWRITE(0, SE); __syncthreads();
  qkt(pA0, pA1, K_lds, qr, r32, hi); partialSM(pA0, pA1, m_reg, mnA, alA);
  SLOAD(SO, KVBLK); if constexpr (SDEPTH == 2) { if (2 < NT) SLOAD(SE, 2 * KVBLK); }
  SWAIT(); SWRITE(1, SO); __syncthreads();
  for (int j = 1; j + 1 < NT; j += 2) {
    SBAR(); qkt(pB0, pB1, (bf16*)((char*)K_lds + SHM_K), qr, r32, hi);
    finishSM(pA0, pA1, alA, l_reg, pa0, pa1, pa2, pa3); SBAR();
    SLOAD(SO, (j + SDEPTH) * KVBLK); SBAR();
    pv_d0(o, vb0, pa0, pa1, pa2, pa3); partialSM(pB0, pB1, m_reg, mnB, alB);
    __syncthreads(); SWAIT(); SWRITE(0, SE);
    RESC(alB); __syncthreads();
    SBAR(); qkt(pA0, pA1, K_lds, qr, r32, hi);
    finishSM(pB0, pB1, alB, l_reg, pa0, pa1, pa2, pa3); SBAR();
    if (SDEPTH == 1 || j + 3 < NT) SLOAD(SE, (j + 1 + SDEPTH) * KVBLK); SBAR();
    pv_d0(o, vb0 + (int)SHM_V, pa0, pa1, pa2, pa3); partialSM(pA0, pA1, m_reg, mnA, alA);
    __syncthreads(); SWAIT(); SWRITE(1, SO);
    RESC(alA); __syncthreads();
  }
  SBAR(); qkt(pB0, pB1, (bf16*)((char*)K_lds + SHM_K), qr, r32, hi);
  finishSM(pA0, pA1, alA, l_reg, pa0, pa1, pa2, pa3); SBAR();
  pv_d0(o, vb0, pa0, pa1, pa2, pa3); partialSM(pB0, pB1, m_reg, mnB, alB);
  __syncthreads(); RESC(alB);
  finishSM(pB0, pB1, alB, l_reg, pa0, pa1, pa2, pa3); SBAR();
  pv_d0(o, vb0 + (int)SHM_V, pa0, pa1, pa2, pa3);
  if (hi == 0) li_l[r32] = l_reg; asm volatile("s_waitcnt lgkmcnt(0)" ::: "memory");
  float rli[16];
#pragma unroll
  for (int r = 0; r < 16; ++r) rli[r] = __builtin_amdgcn_rcpf(li_l[crow(r, hi)]);
  unsigned short* Ow = Ob + (long)(wid * QBLK) * LDO; const unsigned short* Gw = Gb + (long)(wid * QBLK) * LDQ;
  int lane_e = lane, r32_e = r32, hi_e = hi; asm volatile("" : "+v"(lane_e), "+v"(r32_e), "+v"(hi_e));
  unsigned short* stg = (unsigned short*)(lds + 69632 + wid * 8704);
#pragma unroll
  for (int r = 0; r < 16; ++r) { int orow = crow(r, hi_e);
#pragma unroll
    for (int d0 = 0; d0 < 4; ++d0) { unsigned u = __float_as_uint(o[d0][r] * rli[r]); u = (u + 0x7fffu + ((u >> 16) & 1u)) >> 16; stg[orow * 136 + d0 * 32 + r32_e] = (unsigned short)u; } }
  asm volatile("s_waitcnt lgkmcnt(0)" ::: "memory");
#pragma unroll 2
  for (int i = 0; i < 8; ++i) { const int idx = i * 64 + lane_e, row = idx >> 4, ch = idx & 15;
    const u32x4 x = *reinterpret_cast<const u32x4*>(stg + row * 136 + 8 * ch);
    const u32x4 g = *reinterpret_cast<const u32x4*>(Gw + (long)row * LDQ + 8 * ch);
    u32x4 w;
#pragma unroll
    for (int q = 0; q < 4; ++q) { const float x0 = __uint_as_float(x[q] << 16), x1 = __uint_as_float(x[q] & 0xffff0000u), g0 = __uint_as_float(g[q] << 16), g1 = __uint_as_float(g[q] & 0xffff0000u);
      const float y0 = x0 / (1.f + __expf(-g0)), y1 = x1 / (1.f + __expf(-g1));
      unsigned u0 = __float_as_uint(y0), u1 = __float_as_uint(y1); u0 = (u0 + 0x7fffu + ((u0 >> 16) & 1u)) >> 16; u1 = (u1 + 0x7fffu + ((u1 >> 16) & 1u)) >> 16; w[q] = u0 | (u1 << 16); }
    *reinterpret_cast<u32x4*>(Ow + (long)row * LDO + 8 * ch) = w; }
  __syncthreads();
#undef SLOAD
#undef SWRITE
#undef SWAIT
#undef RESC
}

#undef KSWZ
#undef SBAR
}

#define LAS __attribute__((address_space(3)))
typedef unsigned short bf16_t;
typedef short bf16x8 __attribute__((ext_vector_type(8)));
typedef float f32x4 __attribute__((ext_vector_type(4)));
typedef float f32x16 __attribute__((ext_vector_type(16)));
typedef unsigned u32x4 __attribute__((ext_vector_type(4)));
typedef unsigned u32x2 __attribute__((ext_vector_type(2)));

constexpr int NWAVES = 8, NTHR = 512;
constexpr int T_TOK = 16384, SEQ = 8192, DM = 1024;
constexpr float EPS = 1e-6f;
constexpr int LDS_BYTES = 147456;
constexpr size_t MiB = 1u << 20;
constexpr size_t WS_BAR = 512 * 1024;
constexpr size_t WS_TAB = 0;
constexpr size_t WS_W0_IN = 1 * MiB, WS_W0_OUT = 6 * MiB;
constexpr size_t WS_WA = 1 * MiB, WS_WZ = 9 * MiB, WS_WAB = 13 * MiB, WS_WO = 14 * MiB;
constexpr size_t WS_WUP = 18 * MiB, WS_WDOWN = 29 * MiB;
constexpr size_t WS_XN = 35 * MiB;
constexpr size_t WS_PROJ = 67 * MiB, WS_AO = 147 * MiB;
constexpr size_t WS_RAWF = 67 * MiB, WS_ACT = 155 * MiB;
constexpr size_t WS_AB = 18 * MiB  , WS_RAWG = 71 * MiB, WS_OF = 71 * MiB, WS_OB = 71 * MiB + 2048;
constexpr size_t WS_QG = 135 * MiB, WS_KG = 151 * MiB, WS_VG = 167 * MiB, WS_KT = 199 * MiB, WS_TPK = 215 * MiB, WS_APK = 231 * MiB;
constexpr size_t WS_EDGE = 249 * MiB  ;
constexpr size_t WS_GC = 247 * MiB, WS_BETA = 248 * MiB, WS_Z = 135 * MiB, WS_GO = 167 * MiB, WS_END = 255 * MiB;

__device__ __forceinline__ unsigned f2bf(float f) { unsigned u = __float_as_uint(f); return (u + 0x7fffu + ((u >> 16) & 1u)) >> 16; }
__device__ __forceinline__ unsigned pk2(float lo, float hi) { return f2bf(lo) | (f2bf(hi) << 16); }
__device__ __forceinline__ float bf2f(unsigned short h) { return __uint_as_float(((unsigned)h) << 16); }
__device__ __forceinline__ float bflo(unsigned w) { return __uint_as_float(w << 16); }
__device__ __forceinline__ float bfhi(unsigned w) { return __uint_as_float(w & 0xffff0000u); }
__device__ __forceinline__ float wave_sum(float v) {
#pragma unroll
    for (int o = 1; o < 64; o <<= 1) v += __shfl_xor(v, o);
    return v;
}
__device__ __forceinline__ float silu_f(float x) { return x * __builtin_amdgcn_rcpf(1.f + __expf(-x)); }
__device__ __forceinline__ float sigm_f(float x) { return __builtin_amdgcn_rcpf(1.f + __expf(-x)); }
#define LDS_WAIT() asm volatile("s_waitcnt lgkmcnt(0)" ::: "memory")

struct Args { const float* in[19]; float* out; unsigned char* ws; int ph_lo, ph_hi; };
struct Ctx {
    const __attribute__((address_space(4))) Args* a; float* out; unsigned char* ws; LAS unsigned char* lds; char* ldsg;
    int tid, lane, wave, G, bid;
};

#define GAS __attribute__((address_space(1)))
#define INP(C, i) ((const float*)(const GAS float*)(C).a->in[i])
__device__ __forceinline__ void transpose_seg(const float* W, int ldw, int k0, int c0, int Kc, int Nc, bf16_t* dst, int ldd, LAS float* scr, int gw, int NGW, int lane) {
    const int nblk = Nc / 32, nitems = (Kc / 64) * nblk;
    for (int it = gw; it < nitems; it += NGW) {
        const int kb = it / nblk, nb = it % nblk, kk0 = 64 * kb, n0 = 32 * nb;
        float wv[32];
#pragma unroll
        for (int i = 0; i < 32; ++i) { const int kk = 2 * i + (lane >> 5); wv[i] = W[(size_t)(k0 + kk0 + kk) * ldw + c0 + n0 + (lane & 31)]; }
#pragma unroll
        for (int i = 0; i < 32; ++i) { const int kk = 2 * i + (lane >> 5); scr[kk * 33 + (lane & 31)] = wv[i]; }
        LDS_WAIT(); asm volatile("" ::: "memory");
        const int c = lane & 7;
#pragma unroll
        for (int j = 0; j < 4; ++j) { const int n = (lane >> 3) + 8 * j; const LAS float* s = scr + (8 * c) * 33 + n;
            u32x4 o; o.x = pk2(s[0 * 33], s[1 * 33]); o.y = pk2(s[2 * 33], s[3 * 33]); o.z = pk2(s[4 * 33], s[5 * 33]); o.w = pk2(s[6 * 33], s[7 * 33]);
            *(u32x4*)(dst + (size_t)(n0 + n) * ldd + kk0 + 8 * c) = o; }
        LDS_WAIT(); asm volatile("" ::: "memory");
    }
}
__device__ __forceinline__ void rms_rows_bf16(const float* src, const float* gain, bf16_t* dst, int gw, int NGW, int lane) {
    f32x4 g[4];
#pragma unroll
    for (int j = 0; j < 4; ++j) g[j] = ((const f32x4*)gain)[lane + 64 * j];
    for (int m = gw; m < T_TOK; m += NGW) {
        const f32x4* xr = (const f32x4*)(src + (size_t)m * DM) + lane; f32x4 v[4]; float s = 0.f;
#pragma unroll
        for (int j = 0; j < 4; ++j) { v[j] = xr[64 * j]; s += (v[j].x * v[j].x + v[j].y * v[j].y) + (v[j].z * v[j].z + v[j].w * v[j].w); }
        const float rs = rsqrtf(wave_sum(s) * (1.f / DM) + EPS);
        u32x2* o8 = (u32x2*)(dst + (size_t)m * DM) + lane;
#pragma unroll
        for (int j = 0; j < 4; ++j) { u32x2 w; w.x = pk2(v[j].x * rs * g[j].x, v[j].y * rs * g[j].y); w.y = pk2(v[j].z * rs * g[j].z, v[j].w * rs * g[j].w); o8[64 * j] = w; }
    }
}
__device__ __forceinline__ void rms_rows_f32_inplace(float* buf, const float* gain, int gw, int NGW, int lane) {
    f32x4 g[4];
#pragma unroll
    for (int j = 0; j < 4; ++j) g[j] = ((const f32x4*)gain)[lane + 64 * j];
    for (int m = gw; m < T_TOK; m += NGW) {
        f32x4* xr = (f32x4*)(buf + (size_t)m * DM) + lane; f32x4 v[4]; float s = 0.f;
#pragma unroll
        for (int j = 0; j < 4; ++j) { v[j] = xr[64 * j]; s += (v[j].x * v[j].x + v[j].y * v[j].y) + (v[j].z * v[j].z + v[j].w * v[j].w); }
        const float rs = rsqrtf(wave_sum(s) * (1.f / DM) + EPS);
#pragma unroll
        for (int j = 0; j < 4; ++j) xr[64 * j] = v[j] * rs * g[j];
    }
}

__device__ __forceinline__ void ph_convert_ffn(const Ctx& C, int layer, int gw, int NGW) {
    LAS float* scr = (LAS float*)(C.lds + C.wave * 16384);
    unsigned char* ws = C.ws;
    const float* wup = INP(C, 15) + (size_t)layer * 1024 * 5632;
    for (int it = gw; it < 44 * 64; it += NGW) {
        const int seg = it >> 6, r = it & 63, ab = seg & 1, j = seg >> 1;
        transpose_seg(wup, 5632, 0, (ab ? 2816 : 0) + 128 * j, 1024, 128, (bf16_t*)(ws + WS_WUP) + (size_t)(256 * j + 128 * ab) * 1024, 1024, scr, r, 64, C.lane);
    }
    transpose_seg(INP(C, 18) + (size_t)layer * 2816 * 1024, 1024, 0, 0, 2816, 1024, (bf16_t*)(ws + WS_WDOWN), 2816, scr, gw, NGW, C.lane);
}
__device__ __forceinline__ void ph_convert_mixer(const Ctx& C, int layer, int gw, int NGW) {
    LAS float* scr = (LAS float*)(C.lds + C.wave * 16384);
    const int gt = gw * 64 + C.lane, NGT = NGW * 64;
    unsigned char* ws = C.ws;
    if (layer == 0) {
        transpose_seg(INP(C, 4), 2560, 0, 0, 1024, 2560, (bf16_t*)(ws + WS_W0_IN), 1024, scr, gw, NGW, C.lane);
        transpose_seg(INP(C, 7), 1024, 0, 0, 1024, 1024, (bf16_t*)(ws + WS_W0_OUT), 1024, scr, gw, NGW, C.lane);
        float* tab = (float*)(ws + WS_TAB);
        for (int i = gt; i < (128 + 64) * 32; i += NGT) {
            const int f = i & 31, pos = i >> 5;
            const float inv = powf(10000.0f, -(float)f * (2.0f / 64.0f));
            const float p = (pos < 128) ? (float)pos : (float)(pos - 128);
            const float ang = p * inv; float sn, cs; sincosf(ang, &sn, &cs);
            if (pos < 128) { tab[pos * 32 + f] = cs; tab[4096 + pos * 32 + f] = sn; }
            else { tab[8192 + (pos - 128) * 32 + f] = cs; tab[8192 + 2048 + (pos - 128) * 32 + f] = sn; }
        }
    } else {
        const float* wi = INP(C, 8);
        for (int p = 0; p < 2; ++p) {
            bf16_t* wa = (bf16_t*)(ws + WS_WA) + (size_t)p * 2048 * 1024;
            transpose_seg(wi, 6208, 0, 512 * p, 1024, 512, wa, 1024, scr, gw, NGW, C.lane);
            transpose_seg(wi, 6208, 0, 1024 + 512 * p, 1024, 512, wa + (size_t)512 * 1024, 1024, scr, gw, NGW, C.lane);
            transpose_seg(wi, 6208, 0, 2048 + 1024 * p, 1024, 1024, wa + (size_t)1024 * 1024, 1024, scr, gw, NGW, C.lane);
            transpose_seg(wi, 6208, 0, 4096 + 1024 * p, 1024, 1024, (bf16_t*)(ws + WS_WZ) + (size_t)p * 1024 * 1024, 1024, scr, gw, NGW, C.lane);
            transpose_seg(INP(C, 14), 1024, 1024 * p, 0, 1024, 1024, (bf16_t*)(ws + WS_WO) + (size_t)p * 1024 * 1024, 1024, scr, gw, NGW, C.lane);
        }
        transpose_seg(wi, 6208, 0, 6144, 1024, 64, (bf16_t*)(ws + WS_WAB), 1024, scr, gw, NGW, C.lane);
        { u32x4* z = (u32x4*)((bf16_t*)(ws + WS_WAB) + (size_t)64 * 1024);
          unsigned z0 = 0u; asm volatile("" : "+v"(z0));
          for (int i = gt; i < 192 * 1024 / 8; i += NGT) z[i] = (u32x4){z0, z0, z0, z0}; }
    }
}
__device__ __forceinline__ bool side_job(const Ctx& C, int& gw, int& NGW) {
    const int h = C.G >> 1;
    if (C.G < 16) { gw = C.bid * NWAVES + C.wave; NGW = C.G * NWAVES; return true; }
    if (C.bid < h) return false;
    gw = (C.bid - h) * NWAVES + C.wave; NGW = (C.G - h) * NWAVES; return true;
}

__device__ __forceinline__ void ph_attn_post(const Ctx& C) {
    const int gw = C.bid * NWAVES + C.wave, NGW = C.G * NWAVES, lane = C.lane;
    bf16_t* P = (bf16_t*)(C.ws + WS_PROJ); const float* tab = (const float*)(C.ws + WS_TAB);
    const int f = lane & 31, i1 = (lane < 32) ? f : 64 + f, i2 = i1 + 32;
    const float gq1 = INP(C, 5)[i1], gq2 = INP(C, 5)[i2], gk1 = INP(C, 6)[i1], gk2 = INP(C, 6)[i2];
    for (int it0 = gw; it0 < T_TOK * 2; it0 += 4 * NGW) {
        bf16_t* pp[4]; float x1[4], x2[4]; int hh4[4], t4[4];
#pragma unroll
        for (int u = 0; u < 4; ++u) { const int it = it0 + u * NGW; const int row = it >> 1, hh = 8 + (it & 1);
            const int col0 = hh < 8 ? hh * 128 : 1024 + (hh - 8) * 128;
            pp[u] = P + (size_t)row * 2560 + col0; hh4[u] = hh; t4[u] = row & (SEQ - 1);
            x1[u] = bf2f(pp[u][i1]); x2[u] = bf2f(pp[u][i2]); }
#pragma unroll
        for (int u = 0; u < 4; ++u) {
            const float rs = rsqrtf(wave_sum(x1[u] * x1[u] + x2[u] * x2[u]) * (1.f / 128.f) + EPS);
            const float y1 = x1[u] * rs * (hh4[u] < 8 ? gq1 : gk1), y2 = x2[u] * rs * (hh4[u] < 8 ? gq2 : gk2);
            float cs, sn;
            if (lane < 32) { const int pos = t4[u] >> 6; cs = tab[pos * 32 + f]; sn = tab[4096 + pos * 32 + f]; }
            else { const int pos = t4[u] & 63; cs = tab[8192 + pos * 32 + f]; sn = tab[8192 + 2048 + pos * 32 + f]; }
            x1[u] = y1 * cs - y2 * sn; x2[u] = y1 * sn + y2 * cs;
        }
#pragma unroll
        for (int u = 0; u < 4; ++u) { pp[u][i1] = (bf16_t)f2bf(x1[u]); pp[u][i2] = (bf16_t)f2bf(x2[u]); }
    }
}

__device__ __forceinline__ void ph_attention(const Ctx& C) {
    const bf16_t* P = (const bf16_t*)(C.ws + WS_PROJ); bf16_t* AO = (bf16_t*)(C.ws + WS_AO);
    for (int u = C.bid; u < 512; u += C.G) {
        const int qb = u & 31, h = (u >> 5) & 7, b = u >> 8;
        const size_t row0 = (size_t)b * SEQ + qb * 256, rowb = (size_t)b * SEQ;
        attn::attn_dense_body((const attn::bf16*)(P + row0 * 2560 + h * 128), (const attn::bf16*)(P + rowb * 2560 + 1024 + (h >> 2) * 128),
                              (const attn::bf16*)(P + rowb * 2560 + 1280 + (h >> 2) * 128), P + row0 * 2560 + 1536 + h * 128, AO + row0 * 1024 + h * 128, SEQ, C.ldsg,
                              (const float*)(C.ws + WS_TAB), INP(C, 5), qb * 256);
    }
}

__device__ __forceinline__ void ph_ffn_gate(const Ctx& C, int layer, int p) {
    const bf16_t* R = (const bf16_t*)(C.ws + WS_RAWF); bf16_t* A = (bf16_t*)(C.ws + WS_ACT);
    const float* cw = INP(C, 16) + (size_t)layer * 3 * 5632; const float* cb = INP(C, 17) + (size_t)layer * 5632;
    for (int task = C.bid * NTHR + C.tid; task < 1024 * 176; task += C.G * NTHR) {
        const int cg = task % 176, rb = task / 176, r0 = rb * 16, t0 = r0 & (SEQ - 1);
        const int ca = 1408 * p + 8 * cg, cbn = 2816 + ca;
        float wa[3][8], wb[3][8], ba[8], bb[8];
#pragma unroll
        for (int s = 0; s < 3; ++s)
#pragma unroll
            for (int e = 0; e < 8; ++e) { wa[s][e] = cw[s * 5632 + ca + e]; wb[s][e] = cw[s * 5632 + cbn + e]; }
#pragma unroll
        for (int e = 0; e < 8; ++e) { ba[e] = cb[ca + e]; bb[e] = cb[cbn + e]; }
        const bf16_t* ra = R + (size_t)r0 * 2816 + 8 * cg; const bf16_t* rbp = ra + 1408;
        const u32x4 zero = {0u, 0u, 0u, 0u};
        u32x4 a0 = (t0 > 0) ? *(const u32x4*)(ra - 2816) : zero, b0 = (t0 > 0) ? *(const u32x4*)(rbp - 2816) : zero;
        u32x4 a1 = *(const u32x4*)ra, b1 = *(const u32x4*)rbp;
#pragma unroll 4
        for (int r = 0; r < 16; ++r) {
            const bool has = (t0 + r + 1) < SEQ;
            const u32x4 a2 = has ? *(const u32x4*)(ra + (size_t)(r + 1) * 2816) : zero, b2 = has ? *(const u32x4*)(rbp + (size_t)(r + 1) * 2816) : zero;
            float o[8];
#pragma unroll
            for (int q = 0; q < 4; ++q) {
                const float ua0 = wa[0][2 * q] * bflo(a0[q]) + wa[1][2 * q] * bflo(a1[q]) + wa[2][2 * q] * bflo(a2[q]) + ba[2 * q];
                const float ua1 = wa[0][2 * q + 1] * bfhi(a0[q]) + wa[1][2 * q + 1] * bfhi(a1[q]) + wa[2][2 * q + 1] * bfhi(a2[q]) + ba[2 * q + 1];
                const float ub0 = wb[0][2 * q] * bflo(b0[q]) + wb[1][2 * q] * bflo(b1[q]) + wb[2][2 * q] * bflo(b2[q]) + bb[2 * q];
                const float ub1 = wb[0][2 * q + 1] * bfhi(b0[q]) + wb[1][2 * q + 1] * bfhi(b1[q]) + wb[2][2 * q + 1] * bfhi(b2[q]) + bb[2 * q + 1];
                o[2 * q] = silu_f(ua0) * ub0; o[2 * q + 1] = silu_f(ua1) * ub1;
            }
            u32x4 w; w.x = pk2(o[0], o[1]); w.y = pk2(o[2], o[3]); w.z = pk2(o[4], o[5]); w.w = pk2(o[6], o[7]);
            *(u32x4*)(A + (size_t)(r0 + r) * 2816 + ca) = w;
            a0 = a1; a1 = a2; b0 = b1; b1 = b2;
        }
    }
}


__device__ __forceinline__ void ph_ffn_fixup(const Ctx& C, int layer) {
    const float* E = (const float*)(C.ws + WS_EDGE); bf16_t* A = (bf16_t*)(C.ws + WS_ACT);
    const float* cw = INP(C, 16) + (size_t)layer * 3 * 5632; const float* cb = INP(C, 17) + (size_t)layer * 5632;
    for (int it = C.bid * NTHR + C.tid; it < 64 * 2 * 22 * 16; it += C.G * NTHR) {
        const int cg = it & 15, j = (it >> 4) % 22, rest = (it >> 4) / 22, which = rest & 1, pm = rest >> 1;
        const int chl = 8 * cg, cha = 128 * j + chl, chb = 2816 + cha;
        const float* e0 = E + (size_t)((pm * 22 + j) * 4) * 256;
        const float *pr, *cu, *nx; bool zp = false, zn = false;
        if (which == 0) { zp = (pm & 31) == 0; pr = E + (size_t)(((pm > 0 ? pm - 1 : 0) * 22 + j) * 4 + 3) * 256; cu = e0; nx = e0 + 256; }
        else { pr = e0 + 2 * 256; cu = e0 + 3 * 256; zn = (pm & 31) == 31; nx = E + (size_t)(((pm < 63 ? pm + 1 : 63) * 22 + j) * 4) * 256; }
        float o[8];
#pragma unroll
        for (int e = 0; e < 8; ++e) {
            const float pa = zp ? 0.f : pr[chl + e], ca = cu[chl + e], na = zn ? 0.f : nx[chl + e];
            const float pb = zp ? 0.f : pr[128 + chl + e], cbv = cu[128 + chl + e], nb = zn ? 0.f : nx[128 + chl + e];
            const float ya = cw[cha + e] * pa + cw[5632 + cha + e] * ca + cw[2 * 5632 + cha + e] * na + cb[cha + e];
            const float yb = cw[chb + e] * pb + cw[5632 + chb + e] * cbv + cw[2 * 5632 + chb + e] * nb + cb[chb + e];
            o[e] = silu_f(ya) * yb;
        }
        u32x4 w; w.x = pk2(o[0], o[1]); w.y = pk2(o[2], o[3]); w.z = pk2(o[4], o[5]); w.w = pk2(o[6], o[7]);
        *(u32x4*)(A + (size_t)(pm * 256 + (which ? 255 : 0)) * 2816 + cha) = w;
    }
}

__device__ __forceinline__ void ph_gdn_gate(const Ctx& C) {
    const int gw = C.bid * NWAVES + C.wave, NGW = C.G * NWAVES, lane = C.lane;
    const unsigned* OF = (const unsigned*)(C.ws + WS_OF); const unsigned* OB = (const unsigned*)(C.ws + WS_OB);
    const unsigned* Z = (const unsigned*)(C.ws + WS_Z); unsigned* GO = (unsigned*)(C.ws + WS_GO);
    const float g0 = INP(C, 13)[2 * lane], g1 = INP(C, 13)[2 * lane + 1];
    for (int it0 = gw; it0 < T_TOK * 8; it0 += 4 * NGW) {
        unsigned a[4], b[4], z[4];
#pragma unroll
        for (int u = 0; u < 4; ++u) { const size_t idx = (size_t)(it0 + u * NGW) * 64 + lane; a[u] = OF[idx]; b[u] = OB[idx]; z[u] = Z[idx]; }
#pragma unroll
        for (int u = 0; u < 4; ++u) {
            const float o0 = bflo(a[u]) + bflo(b[u]), o1 = bfhi(a[u]) + bfhi(b[u]);
            const float rs = rsqrtf(wave_sum(o0 * o0 + o1 * o1) * (1.f / 128.f) + EPS);
            const float z0 = bflo(z[u]), z1 = bfhi(z[u]);
            GO[(size_t)(it0 + u * NGW) * 64 + lane] = pk2(o0 * rs * g0 * silu_f(z0), o1 * rs * g1 * silu_f(z1));
        }
    }
}

#define XB_TMO      128
#define XB_XCNT(j)  (256  + 64 * (j))
#define XB_XSUB(j)  (1280 + 64 * (j))
#define XB_XGEN(j)  (2304 + 64 * (j))
#define XB_TOP      3328
#define XB_TOPGEN   3392
#define XCD_BAR_WORDS 3456
#define XB_SPIN_CAP (1u << 18)

__device__ __forceinline__ unsigned xb_ld(unsigned* p)              { return __hip_atomic_load(p, __ATOMIC_RELAXED, __HIP_MEMORY_SCOPE_AGENT); }
__device__ __forceinline__ unsigned xb_add(unsigned* p, unsigned v) { return __hip_atomic_fetch_add(p, v, __ATOMIC_RELAXED, __HIP_MEMORY_SCOPE_AGENT); }
__device__ __forceinline__ unsigned xb_xcc_id() { return (unsigned)__builtin_amdgcn_s_getreg((3 << 11) | 20) & 0xFu; }
#define XB_SPIN(cond, bar) do { unsigned _sp = 0; while (cond) { __builtin_amdgcn_s_sleep(1); \
    if ((++_sp & 255u) == 0u) { if (xb_ld(&(bar)[XB_TMO])) break; if (_sp > XB_SPIN_CAP) { atomicAdd(&(bar)[XB_TMO], 1u); break; } } } } while (0)

struct XcdBarrier {
    unsigned* bar; unsigned x;
    volatile LAS unsigned* st;
};

__device__ __forceinline__ XcdBarrier xcd_barrier_post(unsigned* bar, volatile LAS unsigned* st) {
    XcdBarrier b; b.bar = bar; b.x = xb_xcc_id(); b.st = st;
    if (threadIdx.x == 0) (void)xb_add(&bar[XB_XCNT(b.x)], 1u);
    return b;
}
__device__ __forceinline__ void xcd_barrier_complete(unsigned* bar, unsigned x, unsigned& nloc, unsigned& nx) {
    const unsigned G = gridDim.x * gridDim.y * gridDim.z;
    unsigned sum, cnt, mine, sp = 0u;
    for (;;) {
        sum = 0u; cnt = 0u; mine = 0u;
#pragma unroll
        for (unsigned j = 0; j < 16; ++j) { const unsigned c = xb_ld(&bar[XB_XCNT(j)]); sum += c; cnt += (c > 0u) ? 1u : 0u; mine = (j == x) ? c : mine; }
        if (sum == G) break;
        __builtin_amdgcn_s_sleep(1);
        if ((++sp & 255u) == 0u) { if (xb_ld(&bar[XB_TMO])) break; if (sp > XB_SPIN_CAP) { atomicAdd(&bar[XB_TMO], 1u); break; } }
    }
    nloc = mine > 0u ? mine : 1u; nx = cnt > 0u ? cnt : 1u;
}

__device__ __forceinline__ void xcd_barrier(const XcdBarrier& b) {
    asm volatile("s_waitcnt vmcnt(0)" ::: "memory");
    __syncthreads();
    if (threadIdx.x == 0) {
        unsigned* bar = b.bar;
        __builtin_amdgcn_s_waitcnt(0);
        unsigned nloc = b.st[0], nx = b.st[1];
        if (nloc == 0u) { xcd_barrier_complete(bar, b.x, nloc, nx); b.st[0] = nloc; b.st[1] = nx; }
        const unsigned old = xb_add(&bar[XB_XSUB(b.x)], 1u);
        const unsigned gen = old / nloc;
        if (old + 1u == (gen + 1u) * nloc) {
            __builtin_amdgcn_fence(__ATOMIC_RELEASE, "agent");
            asm volatile("s_waitcnt vmcnt(0)" ::: "memory");
            const unsigned og = xb_add(&bar[XB_TOP], 1u);
            const unsigned tg = og / nx;
            if (og + 1u == (tg + 1u) * nx) xb_add(&bar[XB_TOPGEN], 1u);
            else XB_SPIN(xb_ld(&bar[XB_TOPGEN]) == tg, bar);
            __builtin_amdgcn_fence(__ATOMIC_ACQUIRE, "agent");
            xb_add(&bar[XB_XGEN(b.x)], 1u);
            asm volatile("s_waitcnt vmcnt(0)" ::: "memory");
        } else {
            XB_SPIN(xb_ld(&bar[XB_XGEN(b.x)]) == gen, bar);
            __builtin_amdgcn_fence(__ATOMIC_ACQUIRE, "agent");
            asm volatile("s_waitcnt vmcnt(0)" ::: "memory");
        }
    }
    __syncthreads();
}

__device__ __forceinline__ int crow16(int r, int hi) { return (r & 3) + 8 * (r >> 2) + 4 * hi; }
__device__ __forceinline__ unsigned cvtpk2(float lo, float hi) { return pg8::cvt_pk_bf16(lo, hi); }
#define PK4S(P, BASE, OUT) do { unsigned a0_ = cvtpk2(P[BASE + 0], P[BASE + 1]), a1_ = cvtpk2(P[BASE + 2], P[BASE + 3]);   \
    unsigned b0_ = cvtpk2(P[BASE + 4], P[BASE + 5]), b1_ = cvtpk2(P[BASE + 6], P[BASE + 7]);                              \
    auto r0_ = __builtin_amdgcn_permlane32_swap(a0_, b0_, false, false); auto r1_ = __builtin_amdgcn_permlane32_swap(a1_, b1_, false, false); \
    u32x4 w_ = {r0_[0], r1_[0], r0_[1], r1_[1]}; OUT = *reinterpret_cast<bf16x8*>(&w_); } while (0)

__device__ __forceinline__ void ph_ab_small(const Ctx& C) {
    const bf16_t* XN = (const bf16_t*)(C.ws + WS_XN); const bf16_t* WB = (const bf16_t*)(C.ws + WS_WAB); float* AB = (float*)(C.ws + WS_AB);
    const int lane = C.lane, w = C.wave, mt = w & 1, nt = (w >> 1) & 1, kh = w >> 2, r32 = lane & 31, hi = lane >> 5;
    LAS float* red = (LAS float*)C.lds;
    for (int slab = C.bid; slab < T_TOK / 64; slab += C.G) {
        const bf16_t* ap = XN + (size_t)(slab * 64 + 32 * mt + r32) * 1024 + 512 * kh + 8 * hi;
        const bf16_t* bp = WB + (size_t)(32 * nt + r32) * 1024 + 512 * kh + 8 * hi;
        f32x16 acc = {};
#pragma unroll 8
        for (int ks = 0; ks < 32; ++ks) {
            const bf16x8 a = *(const bf16x8*)(ap + 16 * ks), b = *(const bf16x8*)(bp + 16 * ks);
            acc = __builtin_amdgcn_mfma_f32_32x32x16_bf16(a, b, acc, 0, 0, 0);
        }
        if (kh == 1) {
#pragma unroll
            for (int r = 0; r < 16; ++r) red[((w & 3) * 16 + r) * 64 + lane] = acc[r];
        }
        __syncthreads();
        if (kh == 0) {
#pragma unroll
            for (int r = 0; r < 16; ++r) AB[(size_t)(slab * 64 + 32 * mt + crow16(r, hi)) * 256 + 32 * nt + r32] = acc[r] + red[((w & 3) * 16 + r) * 64 + lane];
        }
        __syncthreads();
    }
}
constexpr int GDN_KS = 47;
__device__ __forceinline__ void ph_gdn_prep(const Ctx& C, int p, int mode) {
    const int tid = C.tid, lane = C.lane, wave = C.wave;
    unsigned char* ws = C.ws;
    const bf16_t* RAW = (const bf16_t*)(ws + WS_RAWG);
    bf16_t* QG = (bf16_t*)(ws + WS_QG); bf16_t* KG = (bf16_t*)(ws + WS_KG); bf16_t* VG = (bf16_t*)(ws + WS_VG); bf16_t* KT = (bf16_t*)(ws + WS_KT);
    bf16_t* TPK = (bf16_t*)(ws + WS_TPK); bf16_t* APK = (bf16_t*)(ws + WS_APK);
    float* GC = (float*)(ws + WS_GC); float* BETA = (float*)(ws + WS_BETA); const float* AB = (const float*)(ws + WS_AB);
    const float* cw = INP(C, 9); const float* cb = INP(C, 10);
    LAS bf16_t* qs = (LAS bf16_t*)(C.lds); LAS bf16_t* ks = (LAS bf16_t*)(C.lds + 17408);
    LAS float* KKs = (LAS float*)(C.lds + 34816); LAS float* QKs = (LAS float*)(C.lds + 51456);
    LAS float* Ls = (LAS float*)(C.lds + 68096);
    const int per = mode ? (126 - 2 * GDN_KS) : 2 * (GDN_KS + 1), ntask = 8 * per;
    for (int task = mode ? C.bid - 128 : C.bid; task < ntask; task += mode ? C.G - 128 : C.G) {
        const int ci = task % per, grp = task / per, hql = grp & 3, b = grp >> 2;
        const int chunk = mode ? GDN_KS + 1 + ci : (ci <= GDN_KS ? ci : 126 - 2 * GDN_KS + ci);
        const int row0 = b * SEQ + chunk * 64;
#ifndef PREP_REP_A
#define PREP_REP_A 1
#endif
#ifndef PREP_REP_C
#define PREP_REP_C 1
#endif
#pragma unroll 1
        for (int repa = 0; repa < PREP_REP_A; ++repa) {
            const int cgp = tid & 63, rg = wave, lc = 8 * cgp;
            int rcol, chan; int kind;
            if (lc < 128) { kind = 0; rcol = 128 * hql + lc; chan = (4 * p + hql) * 128 + lc; }
            else if (lc < 256) { kind = 1; rcol = 512 + 128 * hql + (lc - 128); chan = 1024 + (4 * p + hql) * 128 + (lc - 128); }
            else { kind = 2; rcol = 1024 + 256 * hql + (lc - 256); chan = 2048 + (8 * p + 2 * hql) * 128 + (lc - 256); }
            float w5[5][8], bs[8];
#pragma unroll
            for (int s = 0; s < 5; ++s)
#pragma unroll
                for (int e = 0; e < 8; ++e) w5[s][e] = cw[s * 4096 + chan + e];
#pragma unroll
            for (int e = 0; e < 8; ++e) bs[e] = cb[chan + e];
            {
                const int tl0 = chunk * 64 + 8 * rg - 2;
                u32x4 win[12];
#pragma unroll
                for (int j = 0; j < 12; ++j) { const int tl = tl0 + j; win[j] = (u32x4){0u, 0u, 0u, 0u};
                    if (tl >= 0 && tl < SEQ) win[j] = *(const u32x4*)(RAW + (size_t)(b * SEQ + tl) * 2048 + rcol); }
#pragma unroll
                for (int r = 0; r < 8; ++r) {
                    float o[8];
#pragma unroll
                    for (int e = 0; e < 8; ++e) o[e] = bs[e];
#pragma unroll
                    for (int s5 = 0; s5 < 5; ++s5) { const u32x4 x = win[r + s5];
#pragma unroll
                        for (int q = 0; q < 4; ++q) { o[2 * q] += w5[s5][2 * q] * bflo(x[q]); o[2 * q + 1] += w5[s5][2 * q + 1] * bfhi(x[q]); } }
                    float ss = 0.f;
#pragma unroll
                    for (int e = 0; e < 8; ++e) { o[e] = silu_f(o[e]); ss += o[e] * o[e]; }
                    ss += __shfl_xor(ss, 1); ss += __shfl_xor(ss, 2); ss += __shfl_xor(ss, 4); ss += __shfl_xor(ss, 8);
                    float sc = rsqrtf(ss + EPS); if (kind == 0) sc *= 0.08838834764831845f; if (kind == 2) sc = 1.f;
                    u32x4 w; w.x = pk2(o[0] * sc, o[1] * sc); w.y = pk2(o[2] * sc, o[3] * sc); w.z = pk2(o[4] * sc, o[5] * sc); w.w = pk2(o[6] * sc, o[7] * sc);
                    const int rr = 8 * rg + r; const size_t grow = (size_t)(row0 + rr);
                    if (kind == 0) { *(u32x4*)(QG + grow * 512 + 128 * hql + lc) = w; *(LAS u32x4*)(qs + rr * 136 + lc) = w; }
                    else if (kind == 1) { *(u32x4*)(KG + grow * 512 + 128 * hql + (lc - 128)) = w; *(LAS u32x4*)(ks + rr * 136 + (lc - 128)) = w; }
                    else { *(u32x4*)(VG + grow * 1024 + 256 * hql + (lc - 256)) = w; }
                }
            }
        }
        __syncthreads();
        {
            bf16_t* kt = KT + ((size_t)((b * 4 + hql) * 128 + chunk)) * 8192;
            const int dk = tid & 127, tg = tid >> 7;
            unsigned short v[16];
#pragma unroll
            for (int i = 0; i < 16; ++i) v[i] = ks[(16 * tg + i) * 136 + dk];
            u32x4 w0, w1;
#pragma unroll
            for (int q = 0; q < 4; ++q) { w0[q] = (unsigned)v[2 * q] | ((unsigned)v[2 * q + 1] << 16); w1[q] = (unsigned)v[8 + 2 * q] | ((unsigned)v[8 + 2 * q + 1] << 16); }
            *(u32x4*)(kt + (size_t)dk * 64 + 16 * tg) = w0; *(u32x4*)(kt + (size_t)dk * 64 + 16 * tg + 8) = w1;
        }
        {
            const int mat = wave >> 2, mi = (wave >> 1) & 1, ni = wave & 1, r32 = lane & 31, hi = lane >> 5;
            LAS bf16_t* X = mat ? qs : ks; f32x16 acc = {};
#pragma unroll
            for (int kk = 0; kk < 8; ++kk) {
                const bf16x8 a = *(const LAS bf16x8*)(X + (32 * mi + r32) * 136 + 16 * kk + 8 * hi);
                const bf16x8 bb = *(const LAS bf16x8*)(ks + (32 * ni + r32) * 136 + 16 * kk + 8 * hi);
                acc = __builtin_amdgcn_mfma_f32_32x32x16_bf16(a, bb, acc, 0, 0, 0);
            }
            LAS float* M = mat ? QKs : KKs;
#pragma unroll
            for (int r = 0; r < 16; ++r) M[(32 * mi + crow16(r, hi)) * 65 + 32 * ni + r32] = acc[r];
        }
        __syncthreads();
        {
            const int cw = wave & 3, rh = wave >> 2;
            const int vh = cw >> 1, dir = cw & 1, hloc = 2 * hql + vh, head = 8 * p + hloc;
            const int row = row0 + lane;
            const float av = AB[(size_t)row * 256 + dir * 32 + head], bv = AB[(size_t)row * 256 + dir * 32 + 16 + head];
            const float xx = av + INP(C, 12)[dir * 16 + head];
            const float ex = __expf(xx); const float sp = xx > 20.f ? xx : (xx < -10.f ? ex : __logf(1.f + ex));
            const float g = -__expf(INP(C, 11)[dir * 16 + head]) * sp;
            const float beta = sigm_f(bv);
            float v = dir ? __shfl(g, 63 - lane) : g;
#pragma unroll
            for (int off = 1; off < 64; off <<= 1) { const float t = __shfl_up(v, off); if (lane >= off) v += t; }
            const float gc = dir ? __shfl(v, 63 - lane) : v;
            if (rh == 0) { GC[((size_t)dir * T_TOK + row) * 8 + hloc] = gc; BETA[((size_t)dir * T_TOK + row) * 8 + hloc] = beta; }
            const int c = lane, jo = dir ? 63 - c : c;
            const float gcj = __shfl(gc, jo);
            LAS float* L = Ls + cw * 4096;
            const size_t mbase = ((size_t)((b * 8 + hloc) * 128 + chunk)) * 4096;
#pragma unroll 4
            for (int q = 0; q < 32; ++q) {
                const int ip = 32 * rh + q, io = dir ? 63 - ip : ip;
                const float gci = __shfl(gc, io), bti = __shfl(beta, io);
                const float dec = (c <= ip) ? __expf(gci - gcj) : 0.f;
                const float lv = (c < ip) ? bti * KKs[io * 65 + jo] * dec : 0.f;
                L[ip * 64 + c] = lv;
                const bool wr = dir ? (c < ip) : (c <= ip);
                if (wr) APK[mbase + io * 64 + jo] = (bf16_t)f2bf(QKs[io * 65 + jo] * dec);
            }
            __syncthreads();
            if (wave < 4) {
                float x[64];
#pragma unroll
                for (int i = 0; i < 64; ++i) x[i] = 0.f;
                f32x4 cur[8], nxt[8];
#pragma unroll
                for (int j4 = 0; j4 < 8; ++j4) { cur[j4] = (f32x4){0.f, 0.f, 0.f, 0.f}; nxt[j4] = (f32x4){0.f, 0.f, 0.f, 0.f}; }
                cur[0] = *(const LAS f32x4*)(L + 1 * 64);
                x[0] = (c == 0) ? 1.f : 0.f;
#pragma unroll
                for (int i = 1; i < 64; ++i) {
                    if (i + 1 < 64) {
#pragma unroll
                        for (int j4 = 0; j4 < ((i + 1 + 3) / 4 < 8 ? (i + 1 + 3) / 4 : 8); ++j4) nxt[j4] = *(const LAS f32x4*)(L + (i + 1) * 64 + 4 * j4);
                    }
                    float a0 = (c == i) ? 1.f : 0.f, a1 = 0.f;
#pragma unroll
                    for (int j4 = 0; j4 < (i + 3) / 4; ++j4) {
                        const f32x4 l = (j4 < 8) ? cur[j4 < 8 ? j4 : 0] : *(const LAS f32x4*)(L + i * 64 + 4 * j4);
                        if (4 * j4 + 0 < i) a0 -= l[0] * x[4 * j4 + 0];
                        if (4 * j4 + 1 < i) a1 -= l[1] * x[4 * j4 + 1];
                        if (4 * j4 + 2 < i) a0 -= l[2] * x[4 * j4 + 2];
                        if (4 * j4 + 3 < i) a1 -= l[3] * x[4 * j4 + 3];
                    }
                    x[i] = a0 + a1;
                    asm volatile("" ::: "memory");
#pragma unroll
                    for (int j4 = 0; j4 < 8; ++j4) cur[j4] = nxt[j4];
                }
#pragma unroll
                for (int i = 0; i < 64; ++i) L[i * 64 + c] = x[i];
            }
            __syncthreads();
#pragma unroll 4
            for (int q = 0; q < 32; ++q) { const int i = 32 * rh + q, io = dir ? 63 - i : i; const float xv = L[i * 64 + c]; if (c < i) TPK[mbase + io * 64 + jo] = (bf16_t)f2bf(xv); }
        }
        __syncthreads();
    }
}

constexpr int SC_SLOT = 54272;
constexpr int SC_KT = 2 * SC_SLOT;
constexpr int SC_SB = SC_KT + 16384, SC_RB = SC_SB + 8192;
constexpr int SL_VB = 16384, SL_VSB = 16384 + 4096;
#define SC_BAR() do { asm volatile("s_waitcnt lgkmcnt(0)" ::: "memory"); __builtin_amdgcn_s_barrier(); asm volatile("" ::: "memory"); } while (0)
struct ScanRegs { u32x4 q[4], k[4], kt[4], t[2], a[2], v; float gcv, gl, bt; };
__device__ __forceinline__ void scan_issue(const Ctx& C, ScanRegs& R, int ltid, int cidx, int b, int hql, int vh, int dir, int sl) {
    const int hloc = 2 * hql + vh; unsigned char* ws = C.ws;
    const size_t row0 = (size_t)b * SEQ + cidx * 64;
    const bf16_t* QG = (const bf16_t*)(ws + WS_QG) + row0 * 512 + 128 * hql;
    const bf16_t* KG = (const bf16_t*)(ws + WS_KG) + row0 * 512 + 128 * hql;
    const bf16_t* KT = (const bf16_t*)(ws + WS_KT) + ((size_t)((b * 4 + hql) * 128 + cidx)) * 8192;
    const bf16_t* TP = (const bf16_t*)(ws + WS_TPK) + ((size_t)((b * 8 + hloc) * 128 + cidx)) * 4096;
    const bf16_t* AP = (const bf16_t*)(ws + WS_APK) + ((size_t)((b * 8 + hloc) * 128 + cidx)) * 4096;
    const bf16_t* VG = (const bf16_t*)(ws + WS_VG) + row0 * 1024 + 256 * hql + 128 * vh + 32 * sl;
#pragma unroll
    for (int j = 0; j < 4; ++j) { const int i = ltid + 256 * j, r = i >> 4, ch = i & 15;
        R.q[j] = *(const u32x4*)(QG + (size_t)r * 512 + 8 * ch); R.k[j] = *(const u32x4*)(KG + (size_t)r * 512 + 8 * ch);
        const int r2 = i >> 3, c2 = i & 7; R.kt[j] = *(const u32x4*)(KT + (size_t)r2 * 64 + 8 * c2); }
#pragma unroll
    for (int j = 0; j < 2; ++j) { const int i = ltid + 256 * j, r = i >> 3, ch = i & 7; R.t[j] = *(const u32x4*)(TP + r * 64 + 8 * ch); R.a[j] = *(const u32x4*)(AP + r * 64 + 8 * ch); }
    { const int r = ltid >> 2, ch = ltid & 3; R.v = *(const u32x4*)(VG + (size_t)r * 1024 + 8 * ch); }
    if (ltid < 64) { const float* GC = (const float*)(ws + WS_GC) + ((size_t)dir * T_TOK + row0) * 8 + hloc; const float* BT = (const float*)(ws + WS_BETA) + ((size_t)dir * T_TOK + row0) * 8 + hloc;
        R.gcv = GC[ltid * 8]; R.gl = GC[(dir ? 0 : 63) * 8]; R.bt = BT[ltid * 8]; }
}
__device__ __forceinline__ void scan_write_kt(const ScanRegs& R, LAS unsigned char* lds, int ltid) {
#pragma unroll
    for (int j = 0; j < 4; ++j) { const int i = ltid + 256 * j, r2 = i >> 3, c2 = i & 7; *(LAS u32x4*)(lds + SC_KT + r2 * 128 + ((c2 ^ (r2 & 7)) << 4)) = R.kt[j]; }
}
__device__ __forceinline__ void scan_write_slot(const ScanRegs& R, LAS unsigned char* Lb, int ltid, int dir) {
#pragma unroll
    for (int j = 0; j < 4; ++j) { const int i = ltid + 256 * j, r = i >> 4, ch = i & 15; const int o = r * 256 + ((ch ^ (r & 7)) << 4);
        *(LAS u32x4*)(Lb + o) = R.q[j]; *(LAS u32x4*)(Lb + 16384 + o) = R.k[j]; }
#pragma unroll
    for (int j = 0; j < 2; ++j) { const int i = ltid + 256 * j, r = i >> 3, ch = i & 7; u32x4 t = R.t[j], a = R.a[j];
#pragma unroll
        for (int q = 0; q < 4; ++q) {
            unsigned tl = t[q] & 0xffffu, th = t[q] >> 16, al = a[q] & 0xffffu, ah = a[q] >> 16;
            const int j0 = 8 * ch + 2 * q, j1 = j0 + 1;
            const bool s0 = dir ? (j0 > r) : (j0 < r), s1 = dir ? (j1 > r) : (j1 < r);
            tl = s0 ? tl : (j0 == r ? 0x3f80u : 0u); th = s1 ? th : (j1 == r ? 0x3f80u : 0u);
            al = (s0 || j0 == r) ? al : 0u; ah = (s1 || j1 == r) ? ah : 0u;
            t[q] = tl | (th << 16); a[q] = al | (ah << 16);
        }
        const int o = r * 128 + ((ch ^ (r & 7)) << 4);
        *(LAS u32x4*)(Lb + 32768 + o) = t; *(LAS u32x4*)(Lb + 40960 + o) = a; }
    { const int r = ltid >> 2, ch = ltid & 3; *(LAS u32x4*)(Lb + 49152 + r * 64 + ch * 16) = R.v; }
    if (ltid < 64) { LAS float* sc = (LAS float*)(Lb + 53248);
        sc[ltid] = __expf(R.gcv); sc[64 + ltid] = __expf(R.gl - R.gcv); sc[128 + ltid] = R.bt; if (ltid == 0) sc[192] = __expf(R.gl); }
}
__device__ __forceinline__ void scan_out(f32x16 acc, LAS unsigned char* Lb, bf16_t* obase, int mi, int r32, int hi, int lane) {
    bf16x8 af[4], vf[4];
#pragma unroll
    for (int kk = 0; kk < 4; ++kk) { const int row = 32 * mi + r32; af[kk] = *(const LAS bf16x8*)(Lb + 40960 + row * 128 + (((2 * kk + hi) ^ (row & 7)) << 4));
        vf[kk] = *(const LAS bf16x8*)(Lb + SL_VB + kk * 1024 + lane * 16); }
#pragma unroll
    for (int kk = 0; kk < 4; ++kk) acc = __builtin_amdgcn_mfma_f32_32x32x16_bf16(af[kk], vf[kk], acc, 0, 0, 0);
    bf16_t* op = obase + r32;
#pragma unroll
    for (int r = 0; r < 16; ++r) op[(size_t)(32 * mi + crow16(r, hi)) * 2048] = (bf16_t)f2bf(acc[r]);
}
__device__ __forceinline__ void ph_gdn_scan(const Ctx& C, int p, const XcdBarrier& xbar, bool side) {
    if (C.bid >= 128) {
        ph_gdn_prep(C, p, 1);
        xcd_barrier(xbar);
        if (side) ph_convert_ffn(C, 1, (C.bid - 128) * NWAVES + C.wave, (C.G - 128) * NWAVES);
        return;
    }
    const int group = C.bid & 7, b = group >> 2, hql = group & 3, jj = C.bid >> 3, vh = jj >> 3, dir = (jj >> 2) & 1, sl = jj & 3;
    const int hloc = 2 * hql + vh, lane = C.lane, w = C.wave;
    LAS unsigned char* lds = C.lds;
    bf16_t* OD = (bf16_t*)(C.ws + (dir ? WS_OB : WS_OF));
    if (w >= 4) {
        const int ltid = C.tid - 256;
        ScanRegs R;
        scan_issue(C, R, ltid, dir ? 127 : 0, b, hql, vh, dir, sl);
        scan_write_slot(R, lds, ltid, dir); scan_write_kt(R, lds, ltid);
        { unsigned z0 = 0u; asm volatile("" : "+v"(z0));
          for (int i = ltid; i < 8192 / 16; i += 256) *(LAS u32x4*)(lds + SC_SB + i * 16) = (u32x4){z0, z0, z0, z0}; }
        for (int n = 0; n < 128; ++n) {
            if (n == GDN_KS) {
                xcd_barrier(xbar);
                scan_issue(C, R, ltid, dir ? 127 - n : n, b, hql, vh, dir, sl);
                scan_write_slot(R, lds + (n & 1) * SC_SLOT, ltid, dir);
            }
            SC_BAR();
            if (n > 0) scan_write_kt(R, lds, ltid);
            const bool pre = (n + 1 < 128) && (n + 1 != GDN_KS);
            if (pre) scan_issue(C, R, ltid, dir ? 126 - n : n + 1, b, hql, vh, dir, sl);
            SC_BAR();
            SC_BAR();
            if (pre) scan_write_slot(R, lds + ((n + 1) & 1) * SC_SLOT, ltid, dir);
        }
    } else {
        f32x16 S = {}, oacc = {};
        for (int n = 0; n < 128; ++n) {
            int r32 = lane & 31, hi = lane >> 5; asm volatile("" : "+v"(r32), "+v"(hi));
            LAS unsigned char* Lb = lds + (n & 1) * SC_SLOT;
            const LAS float* sc = (const LAS float*)(Lb + 53248);
            const int cidx = dir ? 127 - n : n;
            if (n == GDN_KS) xcd_barrier(xbar);
            SC_BAR();
            const int mi = w & 1;
            f32x16 acc = {};
            {
                LAS unsigned char* Ab = Lb + (w < 2 ? 16384 : 0);
                bf16x8 af[8], sf[8];
#pragma unroll
                for (int kk = 0; kk < 8; ++kk) { const int row = 32 * mi + r32; af[kk] = *(const LAS bf16x8*)(Ab + row * 256 + (((2 * kk + hi) ^ (row & 7)) << 4));
                    sf[kk] = *(const LAS bf16x8*)(lds + SC_SB + kk * 1024 + lane * 16); }
#pragma unroll
                for (int kk = 0; kk < 8; ++kk) acc = __builtin_amdgcn_mfma_f32_32x32x16_bf16(af[kk], sf[kk], acc, 0, 0, 0);
            }
            if (w < 2) {
#pragma unroll
                for (int g4 = 0; g4 < 4; ++g4) { const int i0 = 32 * mi + 8 * g4 + 4 * hi;
                    const f32x4 eg = *(const LAS f32x4*)(sc + i0), bt = *(const LAS f32x4*)(sc + 128 + i0);
#pragma unroll
                    for (int e = 0; e < 4; ++e) { const float vv = bf2f(*(const LAS bf16_t*)(Lb + 49152 + (i0 + e) * 64 + r32 * 2));
                        acc[4 * g4 + e] = bt[e] * (vv - eg[e] * acc[4 * g4 + e]); } }
                bf16x8 f0, f1; PK4S(acc, 0, f0); PK4S(acc, 8, f1);
                *(LAS bf16x8*)(lds + SC_RB + (2 * mi) * 1024 + lane * 16) = f0; *(LAS bf16x8*)(lds + SC_RB + (2 * mi + 1) * 1024 + lane * 16) = f1;
            }
            SC_BAR();
            if (w < 2) {
                bf16x8 af[4], rf[4];
#pragma unroll
                for (int kk = 0; kk < 4; ++kk) { const int row = 32 * mi + r32; af[kk] = *(const LAS bf16x8*)(Lb + 32768 + row * 128 + (((2 * kk + hi) ^ (row & 7)) << 4));
                    rf[kk] = *(const LAS bf16x8*)(lds + SC_RB + kk * 1024 + lane * 16); }
                f32x16 vn = {};
#pragma unroll
                for (int kk = 0; kk < 4; ++kk) vn = __builtin_amdgcn_mfma_f32_32x32x16_bf16(af[kk], rf[kk], vn, 0, 0, 0);
                bf16x8 f0, f1; PK4S(vn, 0, f0); PK4S(vn, 8, f1);
                *(LAS bf16x8*)(Lb + SL_VB + (2 * mi) * 1024 + lane * 16) = f0; *(LAS bf16x8*)(Lb + SL_VB + (2 * mi + 1) * 1024 + lane * 16) = f1;
#pragma unroll
                for (int g4 = 0; g4 < 4; ++g4) { const int i0 = 32 * mi + 8 * g4 + 4 * hi; const f32x4 ek = *(const LAS f32x4*)(sc + 64 + i0);
#pragma unroll
                    for (int e = 0; e < 4; ++e) vn[4 * g4 + e] *= ek[e]; }
                PK4S(vn, 0, f0); PK4S(vn, 8, f1);
                *(LAS bf16x8*)(Lb + SL_VSB + (2 * mi) * 1024 + lane * 16) = f0; *(LAS bf16x8*)(Lb + SL_VSB + (2 * mi + 1) * 1024 + lane * 16) = f1;
            }
            if (w >= 2) {
#pragma unroll
                for (int g4 = 0; g4 < 4; ++g4) { const int i0 = 32 * mi + 8 * g4 + 4 * hi; const f32x4 eg = *(const LAS f32x4*)(sc + i0);
#pragma unroll
                    for (int e = 0; e < 4; ++e) acc[4 * g4 + e] *= eg[e]; }
                if (n > 0) scan_out(oacc, lds + ((n - 1) & 1) * SC_SLOT, OD + ((size_t)b * SEQ + (dir ? 128 - n : n - 1) * 64) * 2048 + hloc * 128 + sl * 32, mi, r32, hi, lane);
                oacc = acc;
            }
            SC_BAR();
            {
                const float gl = sc[192];
                bf16x8 af[4], vf[4];
#pragma unroll
                for (int kk = 0; kk < 4; ++kk) { const int row = 32 * w + r32; af[kk] = *(const LAS bf16x8*)(lds + SC_KT + row * 128 + (((2 * kk + hi) ^ (row & 7)) << 4));
                    vf[kk] = *(const LAS bf16x8*)(Lb + SL_VSB + kk * 1024 + lane * 16); }
                S = S * gl;
#pragma unroll
                for (int kk = 0; kk < 4; ++kk) S = __builtin_amdgcn_mfma_f32_32x32x16_bf16(af[kk], vf[kk], S, 0, 0, 0);
                bf16x8 f0, f1; PK4S(S, 0, f0); PK4S(S, 8, f1);
                *(LAS bf16x8*)(lds + SC_SB + (2 * w) * 1024 + lane * 16) = f0; *(LAS bf16x8*)(lds + SC_SB + (2 * w + 1) * 1024 + lane * 16) = f1;
            }
        }
        if (w >= 2) { int r32 = lane & 31, hi = lane >> 5; scan_out(oacc, lds + (127 & 1) * SC_SLOT, OD + ((size_t)b * SEQ + (dir ? 0 : 127) * 64) * 2048 + hloc * 128 + sl * 32, w & 1, r32, hi, lane); }
    }
    __syncthreads();
}

constexpr int NPH = 24;

__device__ __forceinline__ void run_gemm_bf16(const Ctx& C, const bf16_t* A, const bf16_t* Bt, int N, int K, bf16_t* O) {
    pg8::Gemm g{A, Bt, T_TOK, N, K}; pg8::StaticOrder S; S.init(T_TOK, N, C.G, C.bid);
    pg8::EpiBf16 E{O, N};
    pg8::gemm_phase<pg8::EpiBf16, pg8::StaticOrder, true, true>(C.lds, g, S, E);
}
__device__ __forceinline__ void run_gemm_res(const Ctx& C, const bf16_t* A, const bf16_t* Bt, int K, const float* base) {
    pg8::Gemm g{A, Bt, T_TOK, DM, K}; pg8::StaticOrder S; S.init(T_TOK, DM, C.G, C.bid);
    pg8::EpiRes E{base, C.out, DM};
    pg8::gemm_phase<pg8::EpiRes, pg8::StaticOrder, true, true>(C.lds, g, S, E);
}

__global__ void __launch_bounds__(NTHR, 2) mega_fwd(const Args args) {
    extern __shared__ __attribute__((aligned(16))) unsigned char lds_raw[];
    cg::grid_group grid = cg::this_grid();
    Ctx C;
    C.out = args.out; C.ws = args.ws; C.lds = (LAS unsigned char*)lds_raw; C.ldsg = (char*)lds_raw;
    C.tid = threadIdx.x; C.lane = C.tid & 63; C.wave = __builtin_amdgcn_readfirstlane(C.tid >> 6); C.G = gridDim.x; C.bid = blockIdx.x;
    volatile LAS unsigned* bst = (volatile LAS unsigned*)((LAS unsigned char*)lds_raw + (LDS_BYTES - 64));
    if (threadIdx.x < 2) bst[threadIdx.x] = 0u;
    __syncthreads();
    XcdBarrier xbar; xbar.bar = nullptr; xbar.x = 0; xbar.st = bst;
    if (args.ph_hi - args.ph_lo > 1) xbar = xcd_barrier_post((unsigned*)(args.ws + WS_BAR), bst);
    for (int ph = args.ph_lo; ph < args.ph_hi; ++ph) {
        {
            __attribute__((address_space(1))) unsigned char* w_ = (__attribute__((address_space(1))) unsigned char*)args.ws; __attribute__((address_space(1))) float* o_ = (__attribute__((address_space(1))) float*)args.out; int t_ = threadIdx.x, g_ = gridDim.x, b_ = blockIdx.x;
            unsigned long long ka_ = (unsigned long long)__builtin_amdgcn_kernarg_segment_ptr();
            asm volatile("" : "+s"(w_), "+s"(o_), "+v"(t_), "+s"(g_), "+s"(b_), "+s"(ka_));
            C.ws = (unsigned char*)w_; C.out = (float*)o_; C.a = (const __attribute__((address_space(4))) Args*)ka_; C.G = g_; C.bid = b_; C.tid = t_; C.lane = t_ & 63; C.wave = __builtin_amdgcn_readfirstlane(t_ >> 6);
        }
        unsigned char* ws = C.ws;
        int kind, layer = 0, pass = 0;
        int sub = 0;
        if (ph == 0) { kind = 0; layer = 0; }
        else if (ph == 1) { kind = 1; sub = 0; }
        else if (ph == 2) kind = 2;
        else if (ph == 3) kind = 3;
        else if (ph == 4) { kind = 4; sub = 0; }
        else if (ph == 5) { kind = 5; layer = 0; }
        else if (ph >= 6 && ph <= 8) { layer = 0; const int q = ph - 6; if (q == 2) { kind = 4; sub = 1; } else if (q == 1) kind = 6; else kind = 12; }
        else if (ph == 9) { kind = 0; layer = 1; }
        else if (ph >= 10 && ph <= 18) { layer = 1;
            if (ph == 10) { kind = 7; sub = 2; pass = 0; } else if (ph == 14) { kind = 13; pass = 0; }
            else { pass = ph >= 15; const int q = pass ? ph - 14 : ph - 10; if (q == 1) kind = 8; else if (q == 2) kind = 9; else if (q == 3) kind = 10; else { kind = 4; sub = 2; } } }
        else if (ph == 19) { kind = 5; layer = 1; }
        else if (ph >= 20 && ph <= 22) { layer = 1; const int q = ph - 20; if (q == 2) { kind = 4; sub = 1; } else if (q == 1) kind = 6; else kind = 12; }
        else kind = 11;

#ifndef PH_MASK
#define PH_MASK 0xFFFF
#endif
#define EN(k) ((PH_MASK >> (k)) & 1)
        const int gw = C.bid * NWAVES + C.wave, NGW = C.G * NWAVES;
        if (kind == 0) { if (EN(0)) {
            if (layer == 0) ph_convert_mixer(C, 0, gw, NGW);
            rms_rows_bf16(layer == 0 ? INP(C, 0) : (const float*)C.out, INP(C, 1) + layer * DM, (bf16_t*)(ws + WS_XN), gw, NGW, C.lane); } }
        else if (kind == 1 || kind == 7) { if (EN(1)) {
            if (kind == 7) ph_ab_small(C);
            const bf16_t* A = (const bf16_t*)(ws + WS_XN); const bf16_t* Bt; int N; bf16_t* O;
            if (sub == 0) { Bt = (const bf16_t*)(ws + WS_W0_IN); N = 2560; O = (bf16_t*)(ws + WS_PROJ); }
            else if (sub == 1) { Bt = (const bf16_t*)(ws + WS_WUP) + (size_t)pass * 2816 * 1024; N = 2816; O = (bf16_t*)(ws + WS_RAWF); }
            else if (sub == 2) { Bt = (const bf16_t*)(ws + WS_WA) + (size_t)pass * 2048 * 1024; N = 2048; O = (bf16_t*)(ws + WS_RAWG); }
            else { Bt = (const bf16_t*)(ws + WS_WZ) + (size_t)pass * 1024 * 1024; N = 1024; O = (bf16_t*)(ws + WS_Z); }
            run_gemm_bf16(C, A, Bt, N, 1024, O);
            if (sub == 0) { int sgw, sngw; if (side_job(C, sgw, sngw)) ph_convert_ffn(C, 0, sgw, sngw); }
        } }
        else if (kind == 13) { if (EN(4)) {
            run_gemm_res(C, (const bf16_t*)(ws + WS_GO), (const bf16_t*)(ws + WS_WO), 1024, C.out);
            run_gemm_bf16(C, (const bf16_t*)(ws + WS_XN), (const bf16_t*)(ws + WS_WA) + (size_t)2048 * 1024, 2048, 1024, (bf16_t*)(ws + WS_RAWG)); } }
        else if (kind == 2) { if (EN(2)) ph_attn_post(C); }
        else if (kind == 3) { if (EN(3)) ph_attention(C); }
        else if (kind == 4) { if (EN(4)) {
            const bf16_t* A; const bf16_t* Bt; int K; const float* base = C.out;
            if (sub == 0) { A = (const bf16_t*)(ws + WS_AO); Bt = (const bf16_t*)(ws + WS_W0_OUT); K = 1024; base = INP(C, 0); }
            else if (sub == 1) { A = (const bf16_t*)(ws + WS_ACT); Bt = (const bf16_t*)(ws + WS_WDOWN); K = 2816; }
            else { A = (const bf16_t*)(ws + WS_GO); Bt = (const bf16_t*)(ws + WS_WO) + (size_t)pass * 1024 * 1024; K = 1024; }
            run_gemm_res(C, A, Bt, K, base);
        } }
        else if (kind == 5) { if (EN(5)) { rms_rows_bf16(C.out, INP(C, 2) + layer * DM, (bf16_t*)(ws + WS_XN), gw, NGW, C.lane); } }
        else if (kind == 6) { if (EN(6)) ph_ffn_fixup(C, layer); }
        else if (kind == 12) { if (EN(6)) {
            pg8::Gemm g{(const bf16_t*)(ws + WS_XN), (const bf16_t*)(ws + WS_WUP), T_TOK, 5632, 1024}; pg8::StaticOrder S; S.init(T_TOK, 5632, C.G, C.bid);
            pg8::EpiFfn E{(bf16_t*)(ws + WS_ACT), (float*)(ws + WS_EDGE), INP(C, 16) + (size_t)layer * 3 * 5632, INP(C, 17) + (size_t)layer * 5632, 0, (LAS float*)(C.lds + 131072)};
            pg8::gemm_phase<pg8::EpiFfn, pg8::StaticOrder, true, true>(C.lds, g, S, E);
            if (layer == 0) { int sgw, sngw; if (side_job(C, sgw, sngw)) ph_convert_mixer(C, 1, sgw, sngw); } } }
        else if (kind == 8) { if (EN(8)) ph_gdn_prep(C, pass, 0); }
        else if (kind == 9) { if (EN(9)) ph_gdn_scan(C, pass, xbar, pass == 1); }
        else if (kind == 10) { if (EN(10)) {
            pg8::Gemm g{(const bf16_t*)(ws + WS_XN), (const bf16_t*)(ws + WS_WZ) + (size_t)pass * 1024 * 1024, T_TOK, 1024, 1024}; pg8::StaticOrder S; S.init(T_TOK, 1024, C.G, C.bid);
            pg8::EpiGate E{(const bf16_t*)(ws + WS_OF), (const bf16_t*)(ws + WS_OB), (bf16_t*)(ws + WS_GO), INP(C, 13), (LAS float*)(C.lds + 131072)};
            pg8::gemm_phase<pg8::EpiGate, pg8::StaticOrder, true, true>(C.lds, g, S, E); } }
        else rms_rows_f32_inplace(C.out, INP(C, 3), gw, NGW, C.lane);

        if (ph + 1 < args.ph_hi) { if (args.ph_hi > 1000) grid.sync(); else xcd_barrier(xbar); }
#ifdef DBG_XSYNC
        if (ph + 1 < args.ph_hi) { xcd_barrier(xbar); xcd_barrier(xbar); }
#endif
    }
}


#ifdef DBG_DUMP_A
__global__ void dbg_dump(const unsigned short* a, const unsigned short* b, float* out) {
    for (size_t i = (size_t)blockIdx.x * blockDim.x + threadIdx.x; i < (size_t)T_TOK * DM; i += (size_t)gridDim.x * blockDim.x) {
        unsigned short x = a[i], y = b[i]; x &= 0x7fffu; y &= 0x7fffu; if (x > 0x7f00u) x = 0; if (y > 0x7f00u) y = 0;
        float f = __uint_as_float(((unsigned)x) << 16) + __uint_as_float(((unsigned)y) << 16); if (!(f < 1e30f)) f = 1e30f; out[i] = f; }
}
#endif
#ifndef MK_MULTI
#define MK_MULTI 0
#endif
extern "C" void kernel_launch(void* const* d_in, const int* in_sizes, int n_in, void* d_out, int out_size, void* d_ws, size_t ws_size, hipStream_t stream) {
    static int grid = 0;
    if (grid == 0) {
        if (n_in != 19 || out_size != T_TOK * DM || ws_size < WS_END) { fprintf(stderr, "kernel_launch: unexpected shapes (n_in %d out %d ws %zu)\n", n_in, out_size, ws_size); grid = -1; return; }
        int dev = 0, cus = 0, per_cu = 0;
        hipGetDevice(&dev); hipDeviceGetAttribute(&cus, hipDeviceAttributeMultiprocessorCount, dev);
        if (hipFuncSetAttribute((const void*)mega_fwd, hipFuncAttributeMaxDynamicSharedMemorySize, LDS_BYTES) != hipSuccess) { fprintf(stderr, "kernel_launch: hipFuncSetAttribute failed\n"); grid = -1; return; }
        if (hipOccupancyMaxActiveBlocksPerMultiprocessor(&per_cu, (const void*)mega_fwd, NTHR, LDS_BYTES) != hipSuccess || per_cu < 1) { fprintf(stderr, "kernel_launch: occupancy query says %d\n", per_cu); per_cu = 1; }
        (void)hipGetLastError();
        grid = cus * (per_cu > 1 ? 1 : per_cu);
    }
    if (grid < 0) return;
    Args a{};
    for (int i = 0; i < 19; ++i) a.in[i] = (const float*)d_in[i];
    a.out = (float*)d_out; a.ws = (unsigned char*)d_ws;
#if MK_MULTI
#ifndef DBG_STOP
#define DBG_STOP NPH
#endif
#ifndef DBG_REP
#define DBG_REP 0
#endif
    for (int ph = 0; ph < DBG_STOP; ++ph) { a.ph_lo = ph; a.ph_hi = ph + 1; const int nrep = ((DBG_REP >> ph) & 1) ? 3 : 1;
        for (int r = 0; r < nrep; ++r) hipLaunchKernelGGL(mega_fwd, dim3(grid), dim3(NTHR), LDS_BYTES, stream, a); }
#ifdef DBG_DUMP_A
    hipLaunchKernelGGL(dbg_dump, dim3(2048), dim3(256), 0, stream, (const unsigned short*)((char*)d_ws + (size_t)DBG_DUMP_A * MiB), (const unsigned short*)((char*)d_ws + (size_t)DBG_DUMP_B * MiB), (float*)d_out);
#endif
#else
    a.ph_lo = 0; a.ph_hi = NPH;
    if (hipMemsetAsync((char*)d_ws + WS_BAR, 0, XCD_BAR_WORDS * 4, stream) != hipSuccess) { fprintf(stderr, "kernel_launch: memset failed\n"); return; }
    void* kargs[] = {&a};
    hipError_t e = hipLaunchCooperativeKernel((const void*)mega_fwd, dim3(grid), dim3(NTHR), kargs, LDS_BYTES, stream);
    if (e != hipSuccess) fprintf(stderr, "cooperative launch failed: %s (grid %d)\n", hipGetErrorString(e), grid);
#endif
}
```
